# Optimizing an MI355X kernel written in HIP

```python
import math
import jax, jax.numpy as jnp
from jax import lax
import numpy as np

D_MODEL = 2048
BATCH = 2
SEQ = 4096
DEPTH = 1

CHUNK = 64

D_MIX = D_MODEL
D_LRU = D_MIX // 2
D_CONV = D_MIX - D_LRU
LRU_HEADS = 16
LRU_HEAD_DIM = D_LRU // LRU_HEADS
LRU_C = 8.0
LRU_CONV_W = 4
CONF_GROUPS = 16
CONF_CONV_W = 31
N_GROUPS = 4
EXPERTS_PER_GROUP = 8
TOP_K = 2
D_EXPERT = D_MODEL // 4
LN_EPS = 1e-5
DN_ALPHA = (2 * DEPTH) ** 0.25
DN_BETA = (8 * DEPTH) ** -0.25

kernel_name = "hymba_rglru_conformer_hiermoe_deepnorm"


def layer_norm(x, g, b):
    xf = x.astype(jnp.float32)
    mu = jnp.mean(xf, axis=-1, keepdims=True)
    var = jnp.mean(jnp.square(xf - mu), axis=-1, keepdims=True)
    y = (xf - mu) * lax.rsqrt(var + LN_EPS) * g.astype(jnp.float32) + b.astype(jnp.float32)
    return y.astype(x.dtype)


def causal_depthwise_conv(x, w, b):
    k, c = w.shape
    y = lax.conv_general_dilated(
        x, w[:, None, :].astype(x.dtype), window_strides=(1,), padding=[(k - 1, 0)],
        dimension_numbers=("NWC", "WIO", "NWC"), feature_group_count=c)
    return y + b.astype(x.dtype)


def rg_lru(x, w_a, b_a, w_x, b_x, lam):
    bsz, t, c = x.shape
    xh = x.reshape(bsz, t, LRU_HEADS, LRU_HEAD_DIM)
    r = jax.nn.sigmoid(jnp.einsum("bthi,hij->bthj", xh, w_a).reshape(bsz, t, c) + b_a)
    i = jax.nn.sigmoid(jnp.einsum("bthi,hij->bthj", xh, w_x).reshape(bsz, t, c) + b_x)
    log_a = -LRU_C * r.astype(jnp.float32) * jax.nn.softplus(-lam.astype(jnp.float32))
    a = jnp.exp(log_a)
    u = jnp.sqrt(-jnp.expm1(2.0 * log_a)) * (i * x).astype(jnp.float32)

    def combine(left, right):
        a1, b1 = left
        a2, b2 = right
        return a1 * a2, a2 * b1 + b2

    _, h = lax.associative_scan(combine, (a, u), axis=1)
    return h.astype(x.dtype)


def hier_moe(x, wg, bg, we, be, w_gate, w_up, w_down):
    bsz, t, _ = x.shape
    lg = (jnp.einsum("btd,dg->btg", x, wg) + bg).astype(jnp.float32)
    pg = jax.nn.softmax(lg, axis=-1)
    pg_top, g_sel = lax.top_k(pg, 1)
    le = (jnp.einsum("btd,de->bte", x, we) + be).astype(jnp.float32)
    le = le.reshape(bsz, t, N_GROUPS, EXPERTS_PER_GROUP)
    le_sel = jnp.take_along_axis(le, g_sel[..., None], axis=2)[:, :, 0]
    top_v, top_i = lax.top_k(le_sel, TOP_K)
    q = jax.nn.softmax(top_v, axis=-1) * pg_top
    w_e = jnp.sum(jax.nn.one_hot(top_i, EXPERTS_PER_GROUP, dtype=jnp.float32) * q[..., None], axis=-2)
    w_full = jax.nn.one_hot(g_sel[..., 0], N_GROUPS, dtype=jnp.float32)[..., None] * w_e[:, :, None, :]
    w_full = w_full.astype(x.dtype)
    y = jnp.zeros_like(x)
    for g in range(N_GROUPS):
        h = jax.nn.silu(jnp.einsum("btd,edf->btef", x, w_gate[g])) * jnp.einsum("btd,edf->btef", x, w_up[g])
        y = y + jnp.einsum("btef,efd->btd", h * w_full[:, :, g, :, None], w_down[g])
    return y


def setup_inputs(seed: int = 0) -> dict:
    key = jax.random.key(seed)
    ks = jax.random.split(key, 32)
    f32 = jnp.float32
    L = DEPTH
    G, E, F = N_GROUPS, EXPERTS_PER_GROUP, D_EXPERT

    def nrm(k, shape, scale):
        return jax.random.normal(k, shape, f32) * scale

    u = jax.random.uniform(ks[10], (L, D_LRU), f32, 0.9, 0.999)
    s = u ** (1.0 / LRU_C)
    return {
        "x": nrm(ks[0], (BATCH, SEQ, D_MODEL), 1.0),
        "ln_in_g": 1.0 + nrm(ks[1], (D_MODEL,), 0.02),
        "ln_in_b": nrm(ks[2], (D_MODEL,), 0.02),
        "w_in": nrm(ks[3], (L, D_MODEL, 2 * D_LRU + 2 * D_CONV), D_MODEL ** -0.5),
        "lru_conv_w": nrm(ks[4], (L, LRU_CONV_W, D_LRU), LRU_CONV_W ** -0.5),
        "lru_conv_b": nrm(ks[5], (L, D_LRU), 0.02),
        "lru_w_a": nrm(ks[6], (L, LRU_HEADS, LRU_HEAD_DIM, LRU_HEAD_DIM), LRU_HEAD_DIM ** -0.5),
        "lru_b_a": nrm(ks[7], (L, D_LRU), 0.02),
        "lru_w_x": nrm(ks[8], (L, LRU_HEADS, LRU_HEAD_DIM, LRU_HEAD_DIM), LRU_HEAD_DIM ** -0.5),
        "lru_b_x": nrm(ks[9], (L, D_LRU), 0.02),
        "lru_lambda": jnp.log(s) - jnp.log1p(-s),
        "conf_conv_w": nrm(ks[11], (L, CONF_CONV_W, D_CONV), CONF_CONV_W ** -0.5),
        "conf_conv_b": nrm(ks[12], (L, D_CONV), 0.02),
        "conf_ln_g": 1.0 + nrm(ks[13], (L, D_CONV), 0.02),
        "conf_ln_b": nrm(ks[14], (L, D_CONV), 0.02),
        "w_out": nrm(ks[15], (L, D_MIX, D_MODEL), D_MIX ** -0.5 * DN_BETA),
        "ln1_g": 1.0 + nrm(ks[16], (L, D_MODEL), 0.02),
        "ln1_b": nrm(ks[17], (L, D_MODEL), 0.02),
        "router_group_w": nrm(ks[18], (L, D_MODEL, G), D_MODEL ** -0.5),
        "router_group_b": nrm(ks[19], (L, G), 0.01),
        "router_expert_w": nrm(ks[20], (L, D_MODEL, G * E), D_MODEL ** -0.5),
        "router_expert_b": nrm(ks[21], (L, G * E), 0.01),
        "exp_w_gate": nrm(ks[22], (L, G, E, D_MODEL, F), D_MODEL ** -0.5),
        "exp_w_up": nrm(ks[23], (L, G, E, D_MODEL, F), D_MODEL ** -0.5),
        "exp_w_down": nrm(ks[24], (L, G, E, F, D_MODEL), F ** -0.5 * DN_BETA),
        "ln2_g": 1.0 + nrm(ks[25], (L, D_MODEL), 0.02),
        "ln2_b": nrm(ks[26], (L, D_MODEL), 0.02),
    }


def reference(x, ln_in_g, ln_in_b, w_in, lru_conv_w, lru_conv_b, lru_w_a, lru_b_a,
              lru_w_x, lru_b_x, lru_lambda, conf_conv_w, conf_conv_b, conf_ln_g, conf_ln_b,
              w_out, ln1_g, ln1_b, router_group_w, router_group_b, router_expert_w,
              router_expert_b, exp_w_gate, exp_w_up, exp_w_down, ln2_g, ln2_b):
    h = layer_norm(x, ln_in_g, ln_in_b)
    for l in range(DEPTH):
        z = jnp.einsum("btd,dc->btc", h, w_in[l])
        lru_x = z[..., :D_LRU]
        lru_g = z[..., D_LRU:2 * D_LRU]
        conf_v = z[..., 2 * D_LRU:2 * D_LRU + D_CONV]
        conf_g = z[..., 2 * D_LRU + D_CONV:]
        a_in = causal_depthwise_conv(lru_x, lru_conv_w[l], lru_conv_b[l])
        a_out = jax.nn.gelu(lru_g, approximate=True) * rg_lru(
            a_in, lru_w_a[l], lru_b_a[l], lru_w_x[l], lru_b_x[l], lru_lambda[l])
        b_in = conf_v * jax.nn.sigmoid(conf_g)
        b_c = causal_depthwise_conv(b_in, conf_conv_w[l], conf_conv_b[l])
        b_out = jax.nn.silu(layer_norm(b_c, conf_ln_g[l], conf_ln_b[l]))
        mix = jnp.einsum("btc,cd->btd", jnp.concatenate([a_out, b_out], axis=-1), w_out[l])
        h = layer_norm(DN_ALPHA * h + mix, ln1_g[l], ln1_b[l])
        ffn = hier_moe(h, router_group_w[l], router_group_b[l], router_expert_w[l],
                       router_expert_b[l], exp_w_gate[l], exp_w_up[l], exp_w_down[l])
        h = layer_norm(DN_ALPHA * h + ffn, ln2_g[l], ln2_b[l])
    return h
```

```cpp
#include <hip/hip_runtime.h>
#include <cstdio>
#include <cstdint>

constexpr int D = 2048, SEQ = 4096, M = 8192;
constexpr int DL = 1024, DC = 1024, NH = 16, HDIM = 64;
constexpr int NGRP = 4, NEXPG = 8, NEXP = 32, FF = 512;
constexpr int NZ = 3072;
constexpr float LN_EPS = 1e-5f;
constexpr float ALPHA = 1.189207115002721f;
constexpr int SLOT_ROWS = 24576;

typedef unsigned short bf16_t;
typedef float f32x4 __attribute__((ext_vector_type(4)));
typedef float f32x2 __attribute__((ext_vector_type(2)));
typedef short bf16x8 __attribute__((ext_vector_type(8)));
typedef unsigned u32x4 __attribute__((ext_vector_type(4)));
typedef unsigned u32x2 __attribute__((ext_vector_type(2)));

constexpr size_t MiB = 1u << 20;
constexpr size_t WS_CTL = 0, CTL_ZERO_BYTES = 1 * MiB;
constexpr size_t WS_STAT0 = 1 * MiB;
constexpr size_t WS_STAT1 = 1 * MiB + 65536;
constexpr size_t WS_ROUTE = 1 * MiB + 131072;
constexpr size_t WS_LIST = 2 * MiB;
constexpr size_t WS_QL = 3 * MiB;
constexpr size_t WS_BT1 = 8 * MiB;
constexpr size_t WS_BT2 = 24 * MiB;
constexpr size_t WS_BTU = 32 * MiB;
constexpr size_t WS_BTD = 160 * MiB;
constexpr size_t WS_Y1 = 224 * MiB;
constexpr size_t WS_H0 = 288 * MiB;
constexpr size_t WS_ZP = 320 * MiB;
constexpr size_t WS_MIX = 368 * MiB;
constexpr size_t WS_H1 = 288 * MiB;
constexpr size_t WS_HH = 320 * MiB;
constexpr size_t WS_YF = 344 * MiB;
constexpr size_t WS_ZRAW = 368 * MiB;
constexpr size_t WS_AIN = 400 * MiB;
constexpr size_t WS_ADEC = 440 * MiB;
constexpr size_t WS_U = 472 * MiB;
constexpr size_t WS_NEED = 504 * MiB;
constexpr int CW_CNT = 1024;

struct Args { const float* in[27]; float* out; unsigned char* ws; int ph_lo, ph_hi; };

__device__ __forceinline__ float bf2f(bf16_t v) { return __uint_as_float((unsigned)v << 16); }
__device__ __forceinline__ unsigned f2bf(float f) { unsigned u = __float_as_uint(f); return (u + 0x7fffu + ((u >> 16) & 1u)) >> 16; }
__device__ __forceinline__ float sigmoidf_(float x) { return 1.0f / (1.0f + __expf(-x)); }
__device__ __forceinline__ float gelu_tanh(float x) { const float u = 0.7978845608028654f * (x + 0.044715f * x * x * x); return x * sigmoidf_(2.0f * u); }
__device__ __forceinline__ float silu_(float x) { return x * sigmoidf_(x); }

__device__ __forceinline__ float block_sum256(float v, float* red) {
    red[threadIdx.x] = v; __syncthreads();
    for (int s = 128; s > 0; s >>= 1) { if ((int)threadIdx.x < s) red[threadIdx.x] += red[threadIdx.x + s]; __syncthreads(); }
    const float r = red[0]; __syncthreads(); return r;
}
__global__ void __launch_bounds__(256) nv_ln_in(const float* x, const float* g, const float* b, bf16_t* H0, float* stat) {
    __shared__ float red[256];
    const int m = blockIdx.x; const float* xr = x + (size_t)m * D;
    float s = 0.f; for (int c = threadIdx.x; c < D; c += 256) s += xr[c];
    const float mean = block_sum256(s, red) * (1.0f / D);
    float q = 0.f; for (int c = threadIdx.x; c < D; c += 256) { const float d = xr[c] - mean; q += d * d; }
    const float rstd = 1.0f / sqrtf(block_sum256(q, red) * (1.0f / D) + LN_EPS);
    for (int c = threadIdx.x; c < D; c += 256) H0[(size_t)m * D + c] = (bf16_t)f2bf((xr[c] - mean) * rstd * g[c] + b[c]);
    if (threadIdx.x == 0) { stat[2 * m] = mean; stat[2 * m + 1] = rstd; }
}
__host__ __device__ __forceinline__ int dst_row(int n, int mode) {
    if (mode == 0) return n;
    if (mode == 1) { if (n < 2048) return n; if (n < 3072) { const int s = n - 2048; return 2048 + 256 * (s >> 7) + (s & 127); } const int s = n - 3072; return 2048 + 256 * (s >> 7) + 128 + (s & 127); }
    if (mode == 2) return 256 * (n >> 7) + (n & 127);
    return 256 * (n >> 7) + 128 + (n & 127);
}
__global__ void __launch_bounds__(256) nv_transpose(const float* W, int K, int N, bf16_t* WT, int mode) {
    const size_t idx = (size_t)blockIdx.x * 256 + threadIdx.x; if (idx >= (size_t)K * N) return;
    const int n = (int)(idx % N), k = (int)(idx / N);
    WT[(size_t)dst_row(n, mode) * K + k] = (bf16_t)f2bf(W[idx]);
}
__global__ void __launch_bounds__(256) nv_gemm(const bf16_t* A, const float* B, float* C, int Mr, int N, int K) {
    __shared__ float As[16][65], Bs[16][65];
    const int tx = threadIdx.x & 15, ty = threadIdx.x >> 4, m0 = blockIdx.y * 64, n0 = blockIdx.x * 64;
    float acc[4][4] = {};
    for (int k0 = 0; k0 < K; k0 += 16) {
        for (int i = threadIdx.x; i < 64 * 16; i += 256) { const int r = i >> 4, kk = i & 15; As[kk][r] = bf2f(A[(size_t)(m0 + r) * K + k0 + kk]); }
        for (int i = threadIdx.x; i < 64 * 16; i += 256) { const int kk = i >> 6, c = i & 63; Bs[kk][c] = B[(size_t)(k0 + kk) * N + n0 + c]; }
        __syncthreads();
#pragma unroll
        for (int kk = 0; kk < 16; ++kk) {
            float a[4], b[4];
#pragma unroll
            for (int i = 0; i < 4; ++i) { a[i] = As[kk][ty * 4 + i]; b[i] = Bs[kk][tx * 4 + i]; }
#pragma unroll
            for (int i = 0; i < 4; ++i)
#pragma unroll
                for (int j = 0; j < 4; ++j) acc[i][j] += a[i] * b[j];
        }
        __syncthreads();
    }
    for (int i = 0; i < 4; ++i) for (int j = 0; j < 4; ++j) C[(size_t)(m0 + ty * 4 + i) * N + n0 + tx * 4 + j] = acc[i][j];
}
__global__ void __launch_bounds__(256) nv_zprime(const float* zraw, bf16_t* ZP) {
    const size_t idx = (size_t)blockIdx.x * 256 + threadIdx.x; if (idx >= (size_t)M * NZ) return;
    const int c = (int)(idx % NZ); const size_t m = idx / NZ; const float* zr = zraw + m * 4096;
    float v;
    if (c < 1024) v = zr[c]; else if (c < 2048) v = gelu_tanh(zr[c]); else v = zr[c] * sigmoidf_(zr[c + 1024]);
    ZP[idx] = (bf16_t)f2bf(v);
}
__global__ void __launch_bounds__(256) nv_lru1(const bf16_t* ZP, const float* w4, const float* b4, float* AIN) {
    const size_t idx = (size_t)blockIdx.x * 256 + threadIdx.x; if (idx >= (size_t)M * DL) return;
    const int c = (int)(idx % DL); const int m = (int)(idx / DL), t = m % SEQ;
    float s = b4[c];
    for (int j = 0; j < 4; ++j) { const int tt = t - 3 + j; if (tt >= 0) s += w4[j * DL + c] * bf2f(ZP[(size_t)(m - 3 + j) * NZ + c]); }
    AIN[idx] = s;
}
__global__ void __launch_bounds__(256) nv_lru2(const float* AIN, const float* wa, const float* ba, const float* wx, const float* bx, const float* lam, float* ADEC, float* U) {
    const size_t idx = (size_t)blockIdx.x * 256 + threadIdx.x; if (idx >= (size_t)M * DL) return;
    const int c = (int)(idx % DL); const size_t m = idx / DL; const int h = c >> 6, j = c & 63;
    const float* ar = AIN + m * DL + h * 64;
    float sr = ba[c], si = bx[c];
    for (int i = 0; i < 64; ++i) { const float a = ar[i]; sr += a * wa[(size_t)(h * 64 + i) * 64 + j]; si += a * wx[(size_t)(h * 64 + i) * 64 + j]; }
    const float r = sigmoidf_(sr), ig = sigmoidf_(si);
    const float l = lam[c]; const float sp = (-l > 20.f) ? -l : log1pf(expf(-l));
    const float log_a = -8.0f * r * sp; const float a = expf(log_a);
    ADEC[idx] = a; U[idx] = sqrtf(-expm1f(2.0f * log_a)) * (ig * ar[j]);
}
__global__ void __launch_bounds__(256) nv_lru3(const float* ADEC, const float* U, const bf16_t* ZP, bf16_t* MIX) {
    const int idx = blockIdx.x * 256 + threadIdx.x; if (idx >= 2 * DL) return;
    const int b = idx / DL, c = idx % DL; float h = 0.f;
    for (int t = 0; t < SEQ; ++t) { const size_t m = (size_t)b * SEQ + t; h = ADEC[m * DL + c] * h + U[m * DL + c]; MIX[m * D + c] = (bf16_t)f2bf(bf2f(ZP[m * NZ + 1024 + c]) * h); }
}
__global__ void __launch_bounds__(256) nv_conv31(const bf16_t* ZP, const float* w, const float* bias, const float* g, const float* b, bf16_t* MIX) {
    __shared__ float red[256];
    const int m = blockIdx.x, t = m % SEQ; float v[4]; float s = 0.f;
    for (int i = 0; i < 4; ++i) { const int c = threadIdx.x + 256 * i; float a = bias[c];
        for (int j = 0; j < 31; ++j) { const int tt = t - 30 + j; if (tt >= 0) a += w[j * DC + c] * bf2f(ZP[(size_t)(m - 30 + j) * NZ + 2048 + c]); }
        v[i] = a; s += a; }
    const float mean = block_sum256(s, red) * (1.0f / DC); float q = 0.f;
    for (int i = 0; i < 4; ++i) { const float d = v[i] - mean; q += d * d; }
    const float rstd = 1.0f / sqrtf(block_sum256(q, red) * (1.0f / DC) + LN_EPS);
    for (int i = 0; i < 4; ++i) { const int c = threadIdx.x + 256 * i; MIX[(size_t)m * D + 1024 + c] = (bf16_t)f2bf(silu_((v[i] - mean) * rstd * g[c] + b[c])); }
}
__global__ void __launch_bounds__(256) nv_y1(float* Y1, const float* x, const float* stat0, const float* g, const float* b) {
    const size_t idx = (size_t)blockIdx.x * 256 + threadIdx.x; if (idx >= (size_t)M * D) return;
    const int c = (int)(idx % D); const size_t m = idx / D;
    Y1[idx] += ALPHA * ((x[idx] - stat0[2 * m]) * stat0[2 * m + 1] * g[c] + b[c]);
}
__global__ void __launch_bounds__(256) nv_router(const float* Y1, const float* g1, const float* b1, const float* wg, const float* bg, const float* we, const float* be,
                                                 bf16_t* H1, float* stat1, unsigned* route, unsigned* cnt, int* list, float* ql) {
    __shared__ float red[256]; __shared__ float lg[36];
    const int m = blockIdx.x; const float* yr = Y1 + (size_t)m * D;
    float s = 0.f; for (int c = threadIdx.x; c < D; c += 256) s += yr[c];
    const float mean = block_sum256(s, red) * (1.0f / D);
    float q = 0.f; for (int c = threadIdx.x; c < D; c += 256) { const float d = yr[c] - mean; q += d * d; }
    const float rstd = 1.0f / sqrtf(block_sum256(q, red) * (1.0f / D) + LN_EPS);
    float hv[8];
    for (int i = 0; i < 8; ++i) { const int c = threadIdx.x + 256 * i; hv[i] = (yr[c] - mean) * rstd * g1[c] + b1[c]; H1[(size_t)m * D + c] = (bf16_t)f2bf(hv[i]); }
    for (int o = 0; o < 36; ++o) { float p = 0.f;
        for (int i = 0; i < 8; ++i) { const int c = threadIdx.x + 256 * i; p += hv[i] * (o < 4 ? wg[c * 4 + o] : we[c * 32 + (o - 4)]); }
        p = block_sum256(p, red); if (threadIdx.x == 0) lg[o] = p + (o < 4 ? bg[o] : be[o - 4]); }
    __syncthreads();
    if (threadIdx.x == 0) {
        stat1[2 * m] = mean; stat1[2 * m + 1] = rstd;
        int gs = 0; for (int j = 1; j < 4; ++j) if (lg[j] > lg[gs]) gs = j;
        float den = 0.f; for (int j = 0; j < 4; ++j) den += expf(lg[j] - lg[gs]);
        const float pg = 1.0f / den;
        const float* le = lg + 4 + 8 * gs; int i0 = 0; for (int j = 1; j < 8; ++j) if (le[j] > le[i0]) i0 = j;
        int i1 = (i0 == 0) ? 1 : 0; for (int j = 0; j < 8; ++j) if (j != i0 && le[j] > le[i1]) i1 = j;
        const float ex = expf(le[i1] - le[i0]); const float q0 = pg / (1.0f + ex), q1 = pg * ex / (1.0f + ex);
        const int e0 = gs * 8 + i0, e1 = gs * 8 + i1;
        const unsigned p0 = atomicAdd(&cnt[e0], 1u), p1 = atomicAdd(&cnt[e1], 1u);
        list[e0 * 8192 + p0] = m; ql[e0 * 8192 + p0] = q0; list[e1 * 8192 + p1] = m; ql[e1 * 8192 + p1] = q1;
        unsigned* r = route + (size_t)m * 8; r[0] = e0; r[1] = e1; r[2] = __float_as_uint(q0); r[3] = __float_as_uint(q1); r[4] = p0; r[5] = p1;
    }
}
__device__ __forceinline__ int slot_off(const unsigned* cnt, int e) { int o = 0; for (int j = 0; j < e; ++j) o += ((int)cnt[j] + 255) & ~255; return o; }
__global__ void __launch_bounds__(512) nv_moe_up(const bf16_t* H1, const unsigned* route, const unsigned* cnt, const float* wgate, const float* wup, bf16_t* HH) {
    __shared__ float xs[D];
    const int m = blockIdx.x >> 1, k = blockIdx.x & 1; const unsigned* r = route + (size_t)m * 8;
    const int e = (int)r[k]; const float q = __uint_as_float(r[2 + k]); const int slot = slot_off(cnt, e) + (int)r[4 + k];
    for (int c = threadIdx.x; c < D; c += 512) xs[c] = bf2f(H1[(size_t)m * D + c]);
    __syncthreads();
    const int f = threadIdx.x; const float* wgp = wgate + (size_t)e * D * FF + f; const float* wup_ = wup + (size_t)e * D * FF + f;
    float g = 0.f, u = 0.f;
    for (int d = 0; d < D; ++d) { g += xs[d] * wgp[(size_t)d * FF]; u += xs[d] * wup_[(size_t)d * FF]; }
    HH[(size_t)slot * FF + f] = (bf16_t)f2bf(silu_(g) * u * q);
}
__global__ void __launch_bounds__(512) nv_moe_down(const bf16_t* HH, const unsigned* route, const unsigned* cnt, const float* wdown, bf16_t* YF) {
    __shared__ float hs[FF];
    const int m = blockIdx.x >> 1, k = blockIdx.x & 1; const unsigned* r = route + (size_t)m * 8;
    const int e = (int)r[k]; const int slot = slot_off(cnt, e) + (int)r[4 + k];
    hs[threadIdx.x] = bf2f(HH[(size_t)slot * FF + threadIdx.x]);
    __syncthreads();
    const float* wd = wdown + (size_t)e * FF * D;
    for (int i = 0; i < 4; ++i) { const int d = threadIdx.x + 512 * i; float y = 0.f;
        for (int f = 0; f < FF; ++f) y += hs[f] * wd[(size_t)f * D + d];
        YF[(size_t)slot * D + d] = (bf16_t)f2bf(y); }
}
__global__ void __launch_bounds__(256) nv_final(const float* Y1, const float* stat1, const float* g1, const float* b1, const unsigned* route, const unsigned* cnt, const bf16_t* YF,
                                                const float* g2, const float* b2, float* out) {
    __shared__ float red[256];
    const int m = blockIdx.x; const unsigned* r = route + (size_t)m * 8;
    const int s0 = slot_off(cnt, (int)r[0]) + (int)r[4], s1 = slot_off(cnt, (int)r[1]) + (int)r[5];
    const float mean1 = stat1[2 * m], rstd1 = stat1[2 * m + 1];
    float v[8]; float s = 0.f;
    for (int i = 0; i < 8; ++i) { const int c = threadIdx.x + 256 * i;
        const float h1 = (Y1[(size_t)m * D + c] - mean1) * rstd1 * g1[c] + b1[c];
        v[i] = ALPHA * h1 + (bf2f(YF[(size_t)s0 * D + c]) + bf2f(YF[(size_t)s1 * D + c])); s += v[i]; }
    const float mean = block_sum256(s, red) * (1.0f / D); float q = 0.f;
    for (int i = 0; i < 8; ++i) { const float d = v[i] - mean; q += d * d; }
    const float rstd = 1.0f / sqrtf(block_sum256(q, red) * (1.0f / D) + LN_EPS);
    for (int i = 0; i < 8; ++i) { const int c = threadIdx.x + 256 * i; out[(size_t)m * D + c] = (v[i] - mean) * rstd * g2[c] + b2[c]; }
}


#define LAS __attribute__((address_space(3)))
#define GAS __attribute__((address_space(1)))
namespace pg8 {
constexpr int BM = 256, BK = 64, HALF = 128, HTB = HALF * BK * 2, STAGE_BYTES = 8 * HTB, NXCD = 8, WGM = 8;
__host__ __device__ __forceinline__ int lds_byte(int r, int c) { const int st = (r >> 4) * 2 + (c >> 5), rr = r & 15, cc = c & 31, ob = rr * 64 + cc * 2; return st * 1024 + (ob ^ (((ob >> 9) & 1) << 5)); }
__host__ __device__ __forceinline__ void stage_rc(int b, int& R, int& C) { const int st = b / 1024, sb = b % 1024, swz = sb ^ (((sb >> 9) & 1) << 5); R = (st >> 1) * 16 + swz / 64; C = (st & 1) * 32 + (swz % 64) / 2; }
__host__ __device__ __forceinline__ int perm32(int rho) { const int n = rho >> 4, i = rho & 15; return 8 * (i >> 2) + 4 * n + (i & 3); }

struct Unit { const char* a; const char* b; int pm, pn, e, mt; };

__device__ __forceinline__ unsigned cvt_pk_bf16(float lo, float hi) { unsigned r; asm volatile("v_cvt_pk_bf16_f32 %0, %1, %2" : "=v"(r) : "v"(lo), "v"(hi)); return r; }

struct DenseOrder {
    const char* A; const char* Bt; int K, nM, nN, nwg, G, c;
    __device__ void init(const void* A_, const void* Bt_, int Mr, int N, int K_, int G_, int c_) { A = (const char*)A_; Bt = (const char*)Bt_; K = K_; nM = Mr / BM; nN = N / BM; nwg = nM * nN; G = G_; c = c_; }
    __device__ bool next(int i, Unit& u) const {
        const long L = (long)i * G + c; if (L >= nwg) return false;
        int wgid = (int)L; { const int q = nwg / NXCD, r = nwg % NXCD, xcd = wgid % NXCD, off = wgid / NXCD; wgid = (xcd < r ? xcd * (q + 1) : r * (q + 1) + (xcd - r) * q) + off; }
        const int nig = WGM * nN, gid = wgid / nig, fm = gid * WGM, gsz = (nM - fm) < WGM ? (nM - fm) : WGM;
        u.pm = fm + ((wgid % nig) % gsz); u.pn = (wgid % nig) / gsz; u.e = 0; u.mt = 0;
        u.a = A + (size_t)u.pm * BM * K * 2; u.b = Bt + (size_t)u.pn * BM * K * 2; return true;
    }
    __device__ __forceinline__ void gather(const Unit&, const int (&)[2], const int (&)[2], unsigned (&)[2][2]) const {}
};

template <class Epi, class Sched, bool GATHER, bool ALIGN_EPI, bool SP2>
__device__ __forceinline__ void gemm_phase(LAS unsigned char* lds, const int K, const Sched& S, const Epi& E) {
    const int tid = threadIdx.x, wid = __builtin_amdgcn_readfirstlane(tid >> 6), lane = tid & 63, wr = wid >> 2, wc = wid & 3, fr = lane & 15, fq = lane >> 4;
    const int nt = K / BK;
    unsigned voffA[2], voffB[2]; int stR[2], stC[2];
#pragma unroll
    for (int i = 0; i < 2; ++i) { int R, C; stage_rc(tid * 16 + i * 8192, R, C); const int Rb = Epi::PERM ? ((R & ~31) + perm32(R & 31)) : R;
        voffA[i] = (unsigned)(R * K + C) * 2u; voffB[i] = (unsigned)(Rb * K + C) * 2u; stR[i] = R; stC[i] = C; }
    unsigned voffG[2][2] = {{0u, 0u}, {0u, 0u}}, voffGn[2][2] = {{0u, 0u}, {0u, 0u}};
    const size_t kstep = (size_t)(BK * 2);
    const size_t hstep = (size_t)HALF * K * 2;
    const unsigned ldsw = (unsigned)wid * 1024u;
    const int aoff = lds_byte(wr * 64 + fr, fq * 8), boff = lds_byte(wc * 32 + fr, fq * 8);
#define PG8_SA(b, h) (((b) * 2 + (h)) * HTB)
#define PG8_SB(b, h) ((4 + (b) * 2 + (h)) * HTB)
#define PG8_STAGE(bufoff, gbase, voff) do { _Pragma("unroll") for (int _i = 0; _i < 2; ++_i) \
        __builtin_amdgcn_global_load_lds((const unsigned*)((const char*)(gbase) + (voff)[_i]), (LAS unsigned*)(lds + (bufoff) + ldsw + _i * 8192), 16, 0, 0); } while (0)
#define PG8_STAGE_A(bufoff, gk, h, og) do { if constexpr (GATHER) { PG8_STAGE(bufoff, gk, (og)[h]); } else { PG8_STAGE(bufoff, (gk) + (h) * hstep, voffA); } } while (0)
#define PG8_LDA(dst, b, h) do { _Pragma("unroll") for (int m = 0; m < 4; ++m) _Pragma("unroll") for (int k = 0; k < 2; ++k) dst[m][k] = *(const LAS bf16x8*)(lds + PG8_SA(b, h) + aoff + m * 2048 + k * 1024); } while (0)
#define PG8_LDB(dst, b, h) do { _Pragma("unroll") for (int n = 0; n < 2; ++n) _Pragma("unroll") for (int k = 0; k < 2; ++k) dst[n][k] = *(const LAS bf16x8*)(lds + PG8_SB(b, h) + boff + n * 2048 + k * 1024); } while (0)
#define PG8_MMA(ai, bj, At, Bt) do { __builtin_amdgcn_s_setprio(1); _Pragma("unroll") for (int m = 0; m < 4; ++m) _Pragma("unroll") for (int n = 0; n < 2; ++n) _Pragma("unroll") for (int k = 0; k < 2; ++k) \
        acc[ai][bj][m][n] = __builtin_amdgcn_mfma_f32_16x16x32_bf16(Bt[n][k], At[m][k], acc[ai][bj][m][n], 0, 0, 0); __builtin_amdgcn_s_setprio(0); } while (0)
#define PG8_WAIT_V(n) asm volatile("s_waitcnt vmcnt(" #n ")" ::: "memory")
#define PG8_WAIT_L(n) asm volatile("s_waitcnt lgkmcnt(" #n ")" ::: "memory")
#define PG8_BAR __builtin_amdgcn_s_barrier()
#define PG8_SCHED __builtin_amdgcn_sched_barrier(0)
    Unit cur, nxt; int ui = 0;
    if (!S.next(0, cur)) return;
    f32x4 acc[2][2][4][2];
#pragma unroll
    for (int a = 0; a < 2; ++a)
#pragma unroll
        for (int b = 0; b < 2; ++b)
#pragma unroll
            for (int m = 0; m < 4; ++m)
#pragma unroll
                for (int n = 0; n < 2; ++n) acc[a][b][m][n] = (f32x4){0.f, 0.f, 0.f, 0.f};
    bf16x8 At[4][2], B0[2][2], B1[2][2];
    const char* cA = cur.a; const char* cB = cur.b;
    if constexpr (GATHER) { S.gather(cur, stR, stC, voffG); asm volatile("s_waitcnt vmcnt(0)" ::: "memory"); }
    if constexpr (SP2) {
        PG8_STAGE(PG8_SB(0, 0), cB, voffB); PG8_STAGE(PG8_SB(0, 1), cB + hstep, voffB); PG8_STAGE_A(PG8_SA(0, 0), cA, 0, voffG); PG8_STAGE_A(PG8_SA(0, 1), cA, 1, voffG);
        if (wr == 1) PG8_BAR;
        PG8_WAIT_V(2); PG8_BAR;
        PG8_STAGE(PG8_SB(1, 0), cB + kstep, voffB); PG8_STAGE_A(PG8_SA(1, 0), cA + kstep, 0, voffG); PG8_STAGE(PG8_SB(1, 1), cB + hstep + kstep, voffB);
        PG8_WAIT_V(6); PG8_BAR;
    } else {
        PG8_STAGE(PG8_SB(0, 0), cB, voffB); PG8_STAGE_A(PG8_SA(0, 0), cA, 0, voffG); PG8_STAGE(PG8_SB(0, 1), cB + hstep, voffB); PG8_STAGE_A(PG8_SA(0, 1), cA, 1, voffG);
        if (wr == 1) PG8_BAR;
        PG8_WAIT_V(4); PG8_BAR;
        PG8_STAGE(PG8_SB(1, 0), cB + kstep, voffB); PG8_STAGE_A(PG8_SA(1, 0), cA + kstep, 0, voffG); PG8_STAGE(PG8_SB(1, 1), cB + hstep + kstep, voffB);
        PG8_WAIT_V(6); PG8_BAR;
    }
    for (;;) {
        const bool has_next = S.next(ui + 1, nxt);
        const char* nA = has_next ? nxt.a : cA; const char* nB = has_next ? nxt.b : cB;
        if constexpr (GATHER) { if (has_next) S.gather(nxt, stR, stC, voffGn); else {
#pragma unroll
            for (int h = 0; h < 2; ++h)
#pragma unroll
                for (int i = 0; i < 2; ++i) voffGn[h][i] = voffG[h][i]; } }
        for (int t = 0; t < nt; t += 2) {
            const bool last = (t == nt - 2);
            const char* a1 = cA + (size_t)(t + 1) * kstep;
            const char* a2 = last ? nA : cA + (size_t)(t + 2) * kstep; const char* b2 = last ? nB : cB + (size_t)(t + 2) * kstep;
            const char* a3 = a2 + kstep; const char* b3 = b2 + kstep;
            unsigned og2[2][2];
            if constexpr (GATHER) {
#pragma unroll
                for (int h = 0; h < 2; ++h)
#pragma unroll
                    for (int i = 0; i < 2; ++i) og2[h][i] = last ? voffGn[h][i] : voffG[h][i]; }
            if constexpr (SP2) {
            PG8_LDB(B0, 0, 0); PG8_LDB(B1, 0, 1); PG8_SCHED; PG8_LDA(At, 0, 0); PG8_STAGE_A(PG8_SA(1, 1), a1, 1, voffG);
            PG8_WAIT_V(8); PG8_WAIT_L(0); PG8_BAR; PG8_MMA(0, 0, At, B0); PG8_MMA(0, 1, At, B1); PG8_BAR; PG8_SCHED;
            PG8_LDA(At, 0, 1); PG8_STAGE(PG8_SB(0, 0), b2, voffB); PG8_STAGE(PG8_SB(0, 1), b2 + hstep, voffB); PG8_STAGE_A(PG8_SA(0, 0), a2, 0, og2);
            PG8_WAIT_V(8); PG8_WAIT_L(0); PG8_BAR; PG8_MMA(1, 0, At, B0); PG8_MMA(1, 1, At, B1); PG8_BAR; PG8_SCHED;
            PG8_LDB(B0, 1, 0); PG8_LDB(B1, 1, 1); PG8_SCHED; PG8_LDA(At, 1, 0); PG8_STAGE_A(PG8_SA(0, 1), a2, 1, og2);
            PG8_WAIT_V(8); PG8_WAIT_L(0); PG8_BAR; PG8_MMA(0, 0, At, B0); PG8_MMA(0, 1, At, B1); PG8_BAR; PG8_SCHED;
            PG8_LDA(At, 1, 1); PG8_STAGE(PG8_SB(1, 0), b3, voffB); PG8_STAGE(PG8_SB(1, 1), b3 + hstep, voffB); PG8_STAGE_A(PG8_SA(1, 0), a3, 0, og2);
            PG8_WAIT_V(8); PG8_WAIT_L(0); PG8_BAR; PG8_MMA(1, 0, At, B0); PG8_MMA(1, 1, At, B1); PG8_BAR; PG8_SCHED;
            } else {
            PG8_LDB(B0, 0, 0); PG8_SCHED; PG8_LDA(At, 0, 0); PG8_STAGE_A(PG8_SA(1, 1), a1, 1, voffG);
            PG8_WAIT_L(8); PG8_BAR; PG8_WAIT_L(0); PG8_MMA(0, 0, At, B0); PG8_BAR; PG8_SCHED;
            PG8_LDB(B1, 0, 1); PG8_STAGE(PG8_SB(0, 0), b2, voffB);
            PG8_BAR; PG8_WAIT_L(0); PG8_MMA(0, 1, At, B1); PG8_BAR;
            PG8_LDA(At, 0, 1); PG8_STAGE_A(PG8_SA(0, 0), a2, 0, og2);
            PG8_BAR; PG8_WAIT_L(0); PG8_MMA(1, 0, At, B0); PG8_BAR; PG8_SCHED;
            PG8_STAGE(PG8_SB(0, 1), b2 + hstep, voffB);
            PG8_WAIT_V(6); PG8_BAR; PG8_MMA(1, 1, At, B1); PG8_BAR;
            PG8_LDB(B0, 1, 0); PG8_SCHED; PG8_LDA(At, 1, 0); PG8_STAGE_A(PG8_SA(0, 1), a2, 1, og2);
            PG8_WAIT_L(8); PG8_BAR; PG8_WAIT_L(0); PG8_MMA(0, 0, At, B0); PG8_BAR; PG8_SCHED;
            PG8_LDB(B1, 1, 1); PG8_STAGE(PG8_SB(1, 0), b3, voffB);
            PG8_BAR; PG8_WAIT_L(0); PG8_MMA(0, 1, At, B1); PG8_BAR;
            PG8_LDA(At, 1, 1); PG8_STAGE_A(PG8_SA(1, 0), a3, 0, og2);
            PG8_BAR; PG8_WAIT_L(0); PG8_MMA(1, 0, At, B0); PG8_BAR; PG8_SCHED;
            PG8_STAGE(PG8_SB(1, 1), b3 + hstep, voffB);
            PG8_WAIT_V(6); PG8_BAR; PG8_MMA(1, 1, At, B1); PG8_BAR;
            }
        }
        if constexpr (ALIGN_EPI) { if (wr == 0) PG8_BAR; }
        E(acc, cur, wr, wc, fr, fq);
        if (!has_next) break;
#pragma unroll
        for (int a = 0; a < 2; ++a)
#pragma unroll
            for (int b = 0; b < 2; ++b)
#pragma unroll
                for (int m = 0; m < 4; ++m)
#pragma unroll
                    for (int n = 0; n < 2; ++n) acc[a][b][m][n] = (f32x4){0.f, 0.f, 0.f, 0.f};
        cur = nxt; cA = nA; cB = nB; ++ui;
        if constexpr (GATHER) {
#pragma unroll
            for (int h = 0; h < 2; ++h)
#pragma unroll
                for (int i = 0; i < 2; ++i) voffG[h][i] = voffGn[h][i]; }
        if constexpr (ALIGN_EPI) { if (wr == 1) PG8_BAR; }
    }
    PG8_WAIT_V(0);
    if constexpr (!ALIGN_EPI) { if (wr == 0) PG8_BAR; }
    PG8_BAR;
    (void)stR; (void)stC;
#undef PG8_SA
#undef PG8_SB
#undef PG8_STAGE
#undef PG8_STAGE_A
#undef PG8_LDA
#undef PG8_LDB
#undef PG8_MMA
#undef PG8_WAIT_V
#undef PG8_WAIT_L
#undef PG8_BAR
#undef PG8_SCHED
}
}
#ifndef MK_SP2
#define MK_SP2 true
#endif
#ifndef MK_ALIGN
#define MK_ALIGN true
#endif

constexpr int NWAVES = 8;
constexpr int RING_BYTES = 131072;
constexpr int MISC_OFF = RING_BYTES;
constexpr int LDS_BYTES = 147456;
constexpr int CW_BAR = 4096;
constexpr size_t WS_WRT = 4 * MiB;

typedef GAS unsigned gu32;
#define RLX_AGENT __ATOMIC_RELAXED, __HIP_MEMORY_SCOPE_AGENT
#define LDS_WAIT() asm volatile("s_waitcnt lgkmcnt(0)" ::: "memory")
#define VM_WAIT() asm volatile("s_waitcnt vmcnt(0)" ::: "memory")
__device__ __forceinline__ unsigned pk2(float lo, float hi) { return f2bf(lo) | (f2bf(hi) << 16); }

#define XB_TMO      128
#define XB_XCNT(j)  (256  + 64 * (j))
#define XB_XSUB(j)  (1280 + 64 * (j))
#define XB_XGEN(j)  (2304 + 64 * (j))
#define XB_TOP      3328
#define XB_TOPGEN   3392
#define XCD_BAR_WORDS 3456
#define XB_SPIN_CAP (1u << 18)
__device__ __forceinline__ unsigned xb_ld(unsigned* p)              { return __hip_atomic_load(p, __ATOMIC_RELAXED, __HIP_MEMORY_SCOPE_AGENT); }
__device__ __forceinline__ unsigned xb_add(unsigned* p, unsigned v) { return __hip_atomic_fetch_add(p, v, __ATOMIC_RELAXED, __HIP_MEMORY_SCOPE_AGENT); }
__device__ __forceinline__ unsigned xb_xcc_id() { return (unsigned)__builtin_amdgcn_s_getreg((3 << 11) | 20) & 0xFu; }
#define XB_SPIN(cond, bar) do { unsigned _sp = 0; while (cond) { __builtin_amdgcn_s_sleep(1); \
    if ((++_sp & 255u) == 0u) { if (xb_ld(&(bar)[XB_TMO])) break; if (_sp > XB_SPIN_CAP) { atomicAdd(&(bar)[XB_TMO], 1u); break; } } } } while (0)
struct XcdBarrier { unsigned* bar; unsigned x; volatile LAS unsigned* st; };
__device__ __forceinline__ XcdBarrier xcd_barrier_post(unsigned* bar, volatile LAS unsigned* st) {
    XcdBarrier b; b.bar = bar; b.x = xb_xcc_id(); b.st = st;
    if (threadIdx.x == 0) (void)xb_add(&bar[XB_XCNT(b.x)], 1u);
    return b;
}
__device__ __forceinline__ void xcd_barrier_complete(unsigned* bar, unsigned x, unsigned& nloc, unsigned& nx) {
    const unsigned G = gridDim.x * gridDim.y * gridDim.z;
    unsigned sum, cnt, mine, sp = 0u;
    for (;;) {
        sum = 0u; cnt = 0u; mine = 0u;
#pragma unroll
        for (unsigned j = 0; j < 16; ++j) { const unsigned c = xb_ld(&bar[XB_XCNT(j)]); sum += c; cnt += (c > 0u) ? 1u : 0u; mine = (j == x) ? c : mine; }
        if (sum == G) break;
        __builtin_amdgcn_s_sleep(1);
        if ((++sp & 255u) == 0u) { if (xb_ld(&bar[XB_TMO])) break; if (sp > XB_SPIN_CAP) { atomicAdd(&bar[XB_TMO], 1u); break; } }
    }
    nloc = mine > 0u ? mine : 1u; nx = cnt > 0u ? cnt : 1u;
}
__device__ __forceinline__ void xcd_barrier(const XcdBarrier& b) {
    asm volatile("s_waitcnt vmcnt(0)" ::: "memory");
    __syncthreads();
    if (threadIdx.x == 0) {
        unsigned* bar = b.bar;
        __builtin_amdgcn_s_waitcnt(0);
        unsigned nloc = b.st[0], nx = b.st[1];
        if (nloc == 0u) { xcd_barrier_complete(bar, b.x, nloc, nx); b.st[0] = nloc; b.st[1] = nx; }
        const unsigned old = xb_add(&bar[XB_XSUB(b.x)], 1u);
        const unsigned gen = old / nloc;
        if (old + 1u == (gen + 1u) * nloc) {
            __builtin_amdgcn_fence(__ATOMIC_RELEASE, "agent");
            asm volatile("s_waitcnt vmcnt(0)" ::: "memory");
            const unsigned og = xb_add(&bar[XB_TOP], 1u);
            const unsigned tg = og / nx;
            if (og + 1u == (tg + 1u) * nx) xb_add(&bar[XB_TOPGEN], 1u);
            else XB_SPIN(xb_ld(&bar[XB_TOPGEN]) == tg, bar);
            __builtin_amdgcn_fence(__ATOMIC_ACQUIRE, "agent");
            xb_add(&bar[XB_XGEN(b.x)], 1u);
            asm volatile("s_waitcnt vmcnt(0)" ::: "memory");
        } else {
            XB_SPIN(xb_ld(&bar[XB_XGEN(b.x)]) == gen, bar);
            __builtin_amdgcn_fence(__ATOMIC_ACQUIRE, "agent");
            asm volatile("s_waitcnt vmcnt(0)" ::: "memory");
        }
    }
    __syncthreads();
}

struct Frame {
    LAS unsigned char* lds; volatile LAS unsigned* MISC;
    int tid, lane, wave, vcu, G;
    const float* const* in; float* out; unsigned char* ws;
};
__device__ __forceinline__ float wave_sum(float v) {
#pragma unroll
    for (int o = 1; o < 64; o <<= 1) v += __shfl_xor(v, o);
    return v;
}

__device__ __forceinline__ void p0_transpose_item(const float* W, int K, int N, bf16_t* WT, int mode, LAS float* scr, int item, int lane) {
    const int nblk = N / 32, kb = item / nblk, nb = item % nblk, k0 = 64 * kb, n0 = 32 * nb;
#pragma unroll 8
    for (int i = 0; i < 32; ++i) { const int kk = 2 * i + (lane >> 5); scr[kk * 33 + (lane & 31)] = W[(size_t)(k0 + kk) * N + n0 + (lane & 31)]; }
    LDS_WAIT(); asm volatile("" ::: "memory");
    const int c = lane & 7; const int d0 = dst_row(n0, mode);
#pragma unroll
    for (int j = 0; j < 4; ++j) { const int n = (lane >> 3) + 8 * j; const LAS float* s = scr + (8 * c) * 33 + n;
        u32x4 o; o.x = pk2(s[0 * 33], s[1 * 33]); o.y = pk2(s[2 * 33], s[3 * 33]); o.z = pk2(s[4 * 33], s[5 * 33]); o.w = pk2(s[6 * 33], s[7 * 33]);
        *(u32x4*)(WT + (size_t)(d0 + n) * K + k0 + 8 * c) = o; }
    LDS_WAIT(); asm volatile("" ::: "memory");
}
__device__ __forceinline__ void p0_prologue(Frame& F) {
    LAS float* scr = (LAS float*)(F.lds + F.wave * 16384);
    const int gw = F.vcu * NWAVES + F.wave, NGW = F.G * NWAVES, lane = F.lane;
    unsigned char* ws = F.ws;
    { const float* g = F.in[1]; const float* b = F.in[2]; bf16_t* H0 = (bf16_t*)(ws + WS_H0); float* stat = (float*)(ws + WS_STAT0);
      for (int m = gw; m < M; m += NGW) {
        const f32x4* xr = (const f32x4*)(F.in[0] + (size_t)m * D) + lane;
        f32x4 v[8]; float s = 0.f;
#pragma unroll
        for (int j = 0; j < 8; ++j) { v[j] = xr[64 * j]; s += (v[j].x + v[j].y) + (v[j].z + v[j].w); }
        const float mean = wave_sum(s) * (1.f / D); float s2 = 0.f;
#pragma unroll
        for (int j = 0; j < 8; ++j) { v[j] = v[j] - mean; s2 += (v[j].x * v[j].x + v[j].y * v[j].y) + (v[j].z * v[j].z + v[j].w * v[j].w); }
        const float rstd = 1.f / sqrtf(wave_sum(s2) * (1.f / D) + LN_EPS);
        u32x2* o8 = (u32x2*)(H0 + (size_t)m * D) + lane;
#pragma unroll
        for (int j = 0; j < 8; ++j) { const f32x4 g4 = ((const f32x4*)g)[lane + 64 * j], b4 = ((const f32x4*)b)[lane + 64 * j]; const f32x4 h = v[j] * rstd * g4 + b4;
            u32x2 w; w.x = pk2(h.x, h.y); w.y = pk2(h.z, h.w); o8[64 * j] = w; }
        if (lane == 0) { stat[2 * m] = mean; stat[2 * m + 1] = rstd; }
      } }
    { float* wrt = (float*)(ws + WS_WRT);
      for (int i = gw * 64 + lane; i < 48 * D; i += NGW * 64) { const int o = i / D, k = i % D; wrt[i] = o < 4 ? F.in[18][k * 4 + o] : (o < 36 ? F.in[20][k * 32 + (o - 4)] : 0.f); } }
    constexpr int I_IN = (D / 64) * (4096 / 32), I_OUT = (D / 64) * (D / 32), I_G = (D / 64) * (FF / 32), I_D = (FF / 64) * (D / 32), I_E = 2 * I_G + I_D;
    constexpr int NITEMS = I_IN + I_OUT + NEXP * I_E;
    for (int it = gw; it < NITEMS; it += NGW) {
        int r = it;
        if (r < I_IN) { p0_transpose_item(F.in[3], D, 4096, (bf16_t*)(ws + WS_BT1), 1, scr, r, lane); continue; } r -= I_IN;
        if (r < I_OUT) { p0_transpose_item(F.in[15], D, D, (bf16_t*)(ws + WS_BT2), 0, scr, r, lane); continue; } r -= I_OUT;
        const int e = r / I_E; r -= e * I_E;
        bf16_t* btu = (bf16_t*)(ws + WS_BTU) + (size_t)e * 1024 * D; bf16_t* btd = (bf16_t*)(ws + WS_BTD) + (size_t)e * D * FF;
        if (r < I_G) { p0_transpose_item(F.in[22] + (size_t)e * D * FF, D, FF, btu, 2, scr, r, lane); continue; } r -= I_G;
        if (r < I_G) { p0_transpose_item(F.in[23] + (size_t)e * D * FF, D, FF, btu, 3, scr, r, lane); continue; } r -= I_G;
        p0_transpose_item(F.in[24] + (size_t)e * FF * D, FF, D, btd, 0, scr, r, lane);
    }
}

struct EpiZ {
    static constexpr bool PERM = true;
    bf16_t* Z;
    __device__ __forceinline__ void operator()(const f32x4 (&acc)[2][2][4][2], const pg8::Unit& u, int wr, int wc, int fr, int fq) const {
        const int row0 = u.pm * 256 + wr * 64 + fr;
        if (u.pn < 8) {
            const int col0 = u.pn * 256 + wc * 32 + 8 * fq; const bool act = u.pn >= 4;
#pragma unroll
            for (int ai = 0; ai < 2; ++ai)
#pragma unroll
                for (int m = 0; m < 4; ++m) { bf16_t* rowp = Z + (size_t)(row0 + ai * 128 + m * 16) * NZ + col0;
#pragma unroll
                    for (int bj = 0; bj < 2; ++bj) { f32x4 v0 = acc[ai][bj][m][0], v1 = acc[ai][bj][m][1];
                        if (act) {
#pragma unroll
                            for (int j = 0; j < 4; ++j) { v0[j] = gelu_tanh(v0[j]); v1[j] = gelu_tanh(v1[j]); } }
                        u32x4 w; w.x = pg8::cvt_pk_bf16(v0[0], v0[1]); w.y = pg8::cvt_pk_bf16(v0[2], v0[3]); w.z = pg8::cvt_pk_bf16(v1[0], v1[1]); w.w = pg8::cvt_pk_bf16(v1[2], v1[3]);
                        *(u32x4*)(rowp + bj * 128) = w; } }
        } else {
            const int col0 = 2048 + 128 * (u.pn - 8) + wc * 32 + 8 * fq;
#pragma unroll
            for (int ai = 0; ai < 2; ++ai)
#pragma unroll
                for (int m = 0; m < 4; ++m) { bf16_t* rowp = Z + (size_t)(row0 + ai * 128 + m * 16) * NZ + col0;
                    f32x4 v0 = acc[ai][0][m][0], v1 = acc[ai][0][m][1]; const f32x4 g0 = acc[ai][1][m][0], g1 = acc[ai][1][m][1];
#pragma unroll
                    for (int j = 0; j < 4; ++j) { v0[j] = v0[j] * sigmoidf_(g0[j]); v1[j] = v1[j] * sigmoidf_(g1[j]); }
                    u32x4 w; w.x = pg8::cvt_pk_bf16(v0[0], v0[1]); w.y = pg8::cvt_pk_bf16(v0[2], v0[3]); w.z = pg8::cvt_pk_bf16(v1[0], v1[1]); w.w = pg8::cvt_pk_bf16(v1[2], v1[3]);
                    *(u32x4*)rowp = w; }
        }
    }
};
struct EpiY1 {
    static constexpr bool PERM = false;
    float* Y1; const float* x; const float* stat0; const float* g; const float* b;
    __device__ __forceinline__ void operator()(const f32x4 (&acc)[2][2][4][2], const pg8::Unit& u, int wr, int wc, int fr, int fq) const {
        const int row0 = u.pm * 256 + wr * 64 + fr, col0 = u.pn * 256 + wc * 32 + 4 * fq;
        f32x4 gv[2][2], bv[2][2];
#pragma unroll
        for (int bj = 0; bj < 2; ++bj)
#pragma unroll
            for (int n = 0; n < 2; ++n) { gv[bj][n] = *(const f32x4*)(g + col0 + bj * 128 + n * 16) * ALPHA; bv[bj][n] = *(const f32x4*)(b + col0 + bj * 128 + n * 16) * ALPHA; }
#pragma unroll
        for (int ai = 0; ai < 2; ++ai)
#pragma unroll
            for (int m = 0; m < 4; ++m) { const int r = row0 + ai * 128 + m * 16; const float mean = stat0[2 * r], rstd = stat0[2 * r + 1]; const size_t off = (size_t)r * D + col0;
#pragma unroll
                for (int bj = 0; bj < 2; ++bj)
#pragma unroll
                    for (int n = 0; n < 2; ++n) { const f32x4 xv = *(const f32x4*)(x + off + bj * 128 + n * 16);
                        *(f32x4*)(Y1 + off + bj * 128 + n * 16) = acc[ai][bj][m][n] + ((xv - mean) * rstd) * gv[bj][n] + bv[bj][n]; }
                asm volatile("" ::: "memory"); }
    }
};


template <int SH> __device__ __forceinline__ float row_shr(float v, float ident) {
    return __int_as_float(__builtin_amdgcn_update_dpp(__float_as_int(ident), __float_as_int(v), 0x110 + SH, 0xF, 0xF, false)); }
__device__ __forceinline__ float bcast15(float v) { return __int_as_float(__builtin_amdgcn_ds_swizzle(__float_as_int(v), 0x1F0)); }
__device__ __forceinline__ float bflo(unsigned x) { return __uint_as_float(x << 16); }
__device__ __forceinline__ float bfhi(unsigned x) { return __uint_as_float(x & 0xffff0000u); }
#define SCAN_STEP(SH) do { const float pp = row_shr<SH>(p, 1.0f), hp = row_shr<SH>(h, 0.0f); h = p * hp + h; p = p * pp; } while (0)
__device__ __forceinline__ void lru_unit(Frame& F, int unit) {
    const int b = unit >> 7, hd = (unit >> 3) & 15, s = unit & 7;
    const int lane = F.lane, wave = F.wave, fr = lane & 15, fq = lane >> 4;
    const float* w4 = F.in[4]; const float* b4 = F.in[5]; const float* wa = F.in[6]; const float* ba = F.in[7]; const float* wx = F.in[8]; const float* bx = F.in[9]; const float* lam = F.in[10];
    const bf16_t* ZP = (const bf16_t*)(F.ws + WS_ZP); bf16_t* MIX = (bf16_t*)(F.ws + WS_MIX);
    bf16x8 Afr[8];
    {
        const int gsel = (fr >> 1) & 1, ch = 2 * (fr >> 2) + (fr & 1);
        const float* Wg = (gsel ? wx : wa) + (size_t)hd * 4096 + 8 * s + ch;
#pragma unroll
        for (int ks = 0; ks < 8; ++ks) { const int j = ks >> 1, cb = 32 * (ks & 1) + 8 * fq; float v[8];
#pragma unroll
            for (int jj = 0; jj < 8; ++jj) { const int c = cb + jj; v[jj] = w4[j * DL + 64 * hd + c] * Wg[c * 64]; }
            u32x4 w; w.x = pk2(v[0], v[1]); w.y = pk2(v[2], v[3]); w.z = pk2(v[4], v[5]); w.w = pk2(v[6], v[7]);
            Afr[ks] = __builtin_bit_cast(bf16x8, w); }
    }
    float gb[4];
#pragma unroll
    for (int reg = 0; reg < 4; ++reg) { const int gsel = reg >> 1, ch = 2 * fq + (reg & 1); const float* Wg = (gsel ? wx : wa) + (size_t)hd * 4096 + 8 * s + ch;
        float a = (gsel ? bx : ba)[64 * hd + 8 * s + ch];
        for (int c = 0; c < 64; ++c) a += b4[64 * hd + c] * Wg[c * 64];
        gb[reg] = a; }
    float sp8[2], w4c[4][2], b4c[2];
#pragma unroll
    for (int e = 0; e < 2; ++e) { const int cch = 64 * hd + 8 * s + 2 * fq + e; const float l = lam[cch]; sp8[e] = 8.0f * ((-l > 20.f) ? -l : log1pf(expf(-l))); b4c[e] = b4[cch];
#pragma unroll
        for (int j = 0; j < 4; ++j) w4c[j][e] = w4[j * DL + cch]; }
    float carryH[2] = {0.f, 0.f};
    LAS float* tot = (LAS float*)F.lds;
    const int colx = 64 * hd + 8 * s + 2 * fq;
    for (int ck = 0; ck < 8; ++ck) {
        const int tb = 512 * ck + 64 * wave;
        f32x4 Dm[4];
#pragma unroll
        for (int m = 0; m < 4; ++m) { Dm[m] = (f32x4){0.f, 0.f, 0.f, 0.f};
#pragma unroll
            for (int ks = 0; ks < 8; ++ks) { const int t = tb + 16 * m + fr - 3 + (ks >> 1);
                bf16x8 bfr = (bf16x8){0, 0, 0, 0, 0, 0, 0, 0};
                if (t >= 0) bfr = *(const bf16x8*)(ZP + ((size_t)b * SEQ + t) * NZ + 64 * hd + 32 * (ks & 1) + 8 * fq);
                Dm[m] = __builtin_amdgcn_mfma_f32_16x16x32_bf16(Afr[ks], bfr, Dm[m], 0, 0, 0); } }
        float P[4][2], Hh[4][2], gg[4][2];
#pragma unroll
        for (int m = 0; m < 4; ++m) { const int t = tb + 16 * m + fr; const size_t row = (size_t)b * SEQ + t;
            float ain[2] = {b4c[0], b4c[1]};
#pragma unroll
            for (int j = 0; j < 4; ++j) { const int tt = t - 3 + j; unsigned xw = 0u; if (tt >= 0) xw = *(const unsigned*)(ZP + (row - 3 + j) * NZ + colx);
                ain[0] += w4c[j][0] * bflo(xw); ain[1] += w4c[j][1] * bfhi(xw); }
            const unsigned gw_ = *(const unsigned*)(ZP + row * NZ + 1024 + colx); gg[m][0] = bflo(gw_); gg[m][1] = bfhi(gw_);
#pragma unroll
            for (int e = 0; e < 2; ++e) { const float r = sigmoidf_(Dm[m][e] + gb[e]), ig = sigmoidf_(Dm[m][2 + e] + gb[2 + e]);
                const float la = -r * sp8[e], a = __expf(la), x2 = 2.0f * la;
                const float om = (x2 > -0.25f) ? -x2 * (1.0f + x2 * (0.5f + x2 * (0.16666667f + x2 * (0.041666668f + x2 * 0.0083333338f)))) : 1.0f - a * a;
                P[m][e] = a; Hh[m][e] = sqrtf(om) * (ig * ain[e]); } }
        float cP[2] = {1.f, 1.f}, cH[2] = {0.f, 0.f};
#pragma unroll
        for (int m = 0; m < 4; ++m)
#pragma unroll
            for (int e = 0; e < 2; ++e) { float p = P[m][e], h = Hh[m][e];
                SCAN_STEP(1); SCAN_STEP(2); SCAN_STEP(4); SCAN_STEP(8);
                h = h + p * cH[e]; p = p * cP[e];
                P[m][e] = p; Hh[m][e] = h; cH[e] = bcast15(h); cP[e] = bcast15(p); }
        const int buf = ck & 1;
        if (fr == 0) {
#pragma unroll
            for (int e = 0; e < 2; ++e) { tot[((buf * 8 + wave) * 8 + 2 * fq + e) * 2 + 0] = cP[e]; tot[((buf * 8 + wave) * 8 + 2 * fq + e) * 2 + 1] = cH[e]; } }
        LDS_WAIT(); __syncthreads();
        float hin[2] = {carryH[0], carryH[1]}, hmine[2] = {0.f, 0.f};
        for (int w2 = 0; w2 < 8; ++w2) {
#pragma unroll
            for (int e = 0; e < 2; ++e) { if (w2 == wave) hmine[e] = hin[e];
                const float tp = tot[((buf * 8 + w2) * 8 + 2 * fq + e) * 2 + 0], th = tot[((buf * 8 + w2) * 8 + 2 * fq + e) * 2 + 1]; hin[e] = tp * hin[e] + th; } }
        carryH[0] = hin[0]; carryH[1] = hin[1];
#pragma unroll
        for (int m = 0; m < 4; ++m) { const size_t row = (size_t)b * SEQ + tb + 16 * m + fr;
            const float o0 = gg[m][0] * (Hh[m][0] + P[m][0] * hmine[0]), o1 = gg[m][1] * (Hh[m][1] + P[m][1] * hmine[1]);
            *(unsigned*)(MIX + row * D + colx) = pk2(o0, o1); }
    }
    __syncthreads();
}
#undef SCAN_STEP
__device__ __forceinline__ void conv31_unit(Frame& F, int unit) {
    constexpr int CT = 16;
    const int tid = F.tid, lane = F.lane, wave = F.wave, m0 = unit * 32, c2 = 2 * tid;
    const __amdgpu_buffer_rsrc_t rw = __builtin_amdgcn_make_buffer_rsrc((void*)F.in[11], 0, 31 * DC * 4, 0x00020000);
    const __amdgpu_buffer_rsrc_t rz = __builtin_amdgcn_make_buffer_rsrc((void*)(F.ws + WS_ZP), 0, M * NZ * 2, 0x00020000);
    bf16_t* MIX = (bf16_t*)(F.ws + WS_MIX);
    const f32x2 bs = *(const f32x2*)(F.in[12] + c2), g2 = *(const f32x2*)(F.in[13] + c2), b2 = *(const f32x2*)(F.in[14] + c2);
    LAS float* red = (LAS float*)(F.lds + 4096);
    LAS float* tot2 = (LAS float*)(F.lds + 4096 + 1024);
    f32x2 wj[31];
#pragma unroll
    for (int j = 0; j < 31; ++j) { const u32x2 t = __builtin_amdgcn_raw_buffer_load_b64(rw, c2 * 4, j * DC * 4, 0); wj[j] = __builtin_bit_cast(f32x2, t); }
#pragma unroll 1
    for (int pass = 0; pass < 32 / CT; ++pass) {
        const int tok0 = m0 + CT * pass, t0 = tok0 % SEQ;
        unsigned xin[CT + 30];
#pragma unroll
        for (int i = 0; i < CT + 30; ++i) { const int tt = t0 - 30 + i; const int row = tt >= 0 ? tok0 - 30 + i : tok0;
            const unsigned v = __builtin_amdgcn_raw_buffer_load_b32(rz, (2048 + c2) * 2, row * (NZ * 2), 0); xin[i] = tt >= 0 ? v : 0u; }
        float a0[CT], a1[CT];
#pragma unroll
        for (int o = 0; o < CT; ++o) { float x0 = bs.x, x1 = bs.y;
#pragma unroll
            for (int j = 0; j < 31; ++j) { x0 += wj[j].x * bflo(xin[o + j]); x1 += wj[j].y * bfhi(xin[o + j]); }
            a0[o] = x0; a1[o] = x1; }
#pragma unroll
        for (int o = 0; o < CT; ++o) { const float sm = wave_sum(a0[o] + a1[o]), sq = wave_sum(a0[o] * a0[o] + a1[o] * a1[o]);
            if (lane == 0) { red[(wave * CT + o) * 2] = sm; red[(wave * CT + o) * 2 + 1] = sq; } }
        LDS_WAIT(); __syncthreads();
        if (tid < 2 * CT) { float t = 0.f;
#pragma unroll
            for (int w2 = 0; w2 < 8; ++w2) t += red[w2 * 2 * CT + tid];
            tot2[tid] = t; }
        LDS_WAIT(); __syncthreads();
#pragma unroll
        for (int o = 0; o < CT; ++o) { const float mean = tot2[2 * o] * (1.0f / DC), var = tot2[2 * o + 1] * (1.0f / DC) - mean * mean, rstd = 1.0f / sqrtf(var + LN_EPS);
            const float y0 = silu_((a0[o] - mean) * rstd * g2.x + b2.x), y1 = silu_((a1[o] - mean) * rstd * g2.y + b2.y);
            *(unsigned*)(MIX + (size_t)(tok0 + o) * D + 1024 + c2) = pk2(y0, y1); }
        __syncthreads();
    }
}

__device__ __forceinline__ void router_unit(Frame& F, int unit) {
    const int tid = F.tid, lane = F.lane, wave = F.wave, m0 = 32 * unit;
    const float* Y1 = (const float*)(F.ws + WS_Y1); const float* g1 = F.in[16]; const float* b1 = F.in[17]; const float* WRT = (const float*)(F.ws + WS_WRT);
    bf16_t* H1 = (bf16_t*)(F.ws + WS_H1); float* stat1 = (float*)(F.ws + WS_STAT1);
    LAS float* st = (LAS float*)F.lds;
    LAS float* part = (LAS float*)(F.lds + 1024);
    LAS float* lgt = (LAS float*)(F.lds + 1024 + 24576);
    for (int i = 0; i < 4; ++i) { const int m = m0 + 4 * wave + i;
        const f32x4* yr = (const f32x4*)(Y1 + (size_t)m * D) + lane;
        f32x4 v[8]; float s = 0.f;
#pragma unroll
        for (int j = 0; j < 8; ++j) { v[j] = yr[64 * j]; s += (v[j].x + v[j].y) + (v[j].z + v[j].w); }
        const float mean = wave_sum(s) * (1.f / D); float s2 = 0.f;
#pragma unroll
        for (int j = 0; j < 8; ++j) { v[j] = v[j] - mean; s2 += (v[j].x * v[j].x + v[j].y * v[j].y) + (v[j].z * v[j].z + v[j].w * v[j].w); }
        const float rstd = 1.f / sqrtf(wave_sum(s2) * (1.f / D) + LN_EPS);
        u32x2* o8 = (u32x2*)(H1 + (size_t)m * D) + lane;
#pragma unroll
        for (int j = 0; j < 8; ++j) { const f32x4 g4 = ((const f32x4*)g1)[lane + 64 * j], b4 = ((const f32x4*)b1)[lane + 64 * j]; const f32x4 h = v[j] * rstd * g4 + b4;
            u32x2 w; w.x = pk2(h.x, h.y); w.y = pk2(h.z, h.w); o8[64 * j] = w; }
        if (lane == 0) { stat1[2 * m] = mean; stat1[2 * m + 1] = rstd; st[(4 * wave + i) * 2] = mean; st[(4 * wave + i) * 2 + 1] = rstd; } }
    LDS_WAIT(); __syncthreads();
    {
        const int mt = wave & 1, kp = wave >> 1, i = lane & 15, q = lane >> 4;
        const float mean = st[(16 * mt + i) * 2], rstd = st[(16 * mt + i) * 2 + 1];
        const float* yr = Y1 + (size_t)(m0 + 16 * mt + i) * D + 512 * kp + 4 * q; const float* gp = g1 + 512 * kp + 4 * q; const float* bp = b1 + 512 * kp + 4 * q;
        const float* wp = WRT + (size_t)i * D + 512 * kp + 4 * q;
        f32x4 acc0 = (f32x4){0.f, 0.f, 0.f, 0.f}, acc1 = acc0, acc2 = acc0;
#pragma unroll 4
        for (int jj = 0; jj < 32; ++jj) {
            const f32x4 y4 = *(const f32x4*)(yr + 16 * jj), g4 = *(const f32x4*)(gp + 16 * jj), b4 = *(const f32x4*)(bp + 16 * jj);
            const f32x4 a4 = ((y4 - mean) * rstd) * g4 + b4;
            const f32x4 w0 = *(const f32x4*)(wp + 16 * jj), w1 = *(const f32x4*)(wp + 16 * D + 16 * jj), w2 = *(const f32x4*)(wp + 32 * D + 16 * jj);
#pragma unroll
            for (int c = 0; c < 4; ++c) { acc0 = __builtin_amdgcn_mfma_f32_16x16x4f32(a4[c], w0[c], acc0, 0, 0, 0); acc1 = __builtin_amdgcn_mfma_f32_16x16x4f32(a4[c], w1[c], acc1, 0, 0, 0);
                acc2 = __builtin_amdgcn_mfma_f32_16x16x4f32(a4[c], w2[c], acc2, 0, 0, 0); }
        }
#pragma unroll
        for (int reg = 0; reg < 4; ++reg) { LAS float* pr = part + ((kp * 32) + 16 * mt + 4 * q + reg) * 48 + i; pr[0] = acc0[reg]; pr[16] = acc1[reg]; pr[32] = acc2[reg]; }
    }
    LDS_WAIT(); __syncthreads();
    for (int idx = tid; idx < 32 * 36; idx += NWAVES * 64) { const int tok = idx / 36, o = idx % 36;
        float v = (o < 4 ? F.in[19][o] : F.in[21][o - 4]);
#pragma unroll
        for (int kp = 0; kp < 4; ++kp) v += part[(kp * 32 + tok) * 48 + o];
        lgt[tok * 36 + o] = v; }
    LDS_WAIT(); __syncthreads();
    if (tid < 32) {
        const int m = m0 + tid; const LAS float* lg = lgt + tid * 36;
        unsigned* cnt = (unsigned*)(F.ws + WS_CTL) + CW_CNT; int* list = (int*)(F.ws + WS_LIST); float* ql = (float*)(F.ws + WS_QL); unsigned* route = (unsigned*)(F.ws + WS_ROUTE);
        int gs = 0; for (int j = 1; j < 4; ++j) if (lg[j] > lg[gs]) gs = j;
        float den = 0.f; for (int j = 0; j < 4; ++j) den += expf(lg[j] - lg[gs]);
        const float pg = 1.0f / den;
        const LAS float* le = lg + 4 + 8 * gs; int i0 = 0; for (int j = 1; j < 8; ++j) if (le[j] > le[i0]) i0 = j;
        int i1 = (i0 == 0) ? 1 : 0; for (int j = 0; j < 8; ++j) if (j != i0 && le[j] > le[i1]) i1 = j;
        const float ex = expf(le[i1] - le[i0]); const float q0 = pg / (1.0f + ex), q1 = pg * ex / (1.0f + ex);
        const int e0 = gs * 8 + i0, e1 = gs * 8 + i1;
        const unsigned p0 = atomicAdd(&cnt[e0], 1u), p1 = atomicAdd(&cnt[e1], 1u);
        list[e0 * 8192 + p0] = m; ql[e0 * 8192 + p0] = q0; list[e1 * 8192 + p1] = m; ql[e1 * 8192 + p1] = q1;
        unsigned* r = route + (size_t)m * 8; r[0] = e0; r[1] = e1; r[2] = __float_as_uint(q0); r[3] = __float_as_uint(q1); r[4] = p0; r[5] = p1;
    }
    __syncthreads();
}

__device__ __forceinline__ const LAS int* moe_tables(Frame& F) {
    LAS int* tab = (LAS int*)(F.lds + MISC_OFF + 256);
    if (F.tid == 0) { unsigned* cnt = (unsigned*)(F.ws + WS_CTL) + CW_CNT; int run = 0;
        for (int e = 0; e < NEXP; ++e) { const int c = (int)__hip_atomic_load(cnt + e, RLX_AGENT); tab[e] = run; tab[40 + e] = run * 256; tab[80 + e] = c; run += (c + 255) >> 8; }
        tab[32] = run; }
    LDS_WAIT(); __syncthreads();
    return tab;
}
struct MoeOrder {
    const LAS int* tab; const char* A; const char* Bt; const int* list; int npn, G, c; bool up;
    __device__ bool next(int i, pg8::Unit& u) const {
        const int L = i * G + c; if (L >= tab[32] * npn) return false;
        const int tt = L / npn, pn = L % npn; int e = 0; while (tab[e + 1] <= tt) ++e;
        const int mt = tt - tab[e];
        u.e = e; u.mt = mt; u.pn = pn; u.pm = (tab[40 + e] >> 8) + mt;
        if (up) { u.a = A; u.b = Bt + ((size_t)(e * 1024 + pn * 256)) * D * 2; }
        else { u.a = A + (size_t)(tab[40 + e] + mt * 256) * FF * 2; u.b = Bt + ((size_t)(e * D + pn * 256)) * FF * 2; }
        return true;
    }
    __device__ __forceinline__ void gather(const pg8::Unit& u, const int (&stR)[2], const int (&stC)[2], unsigned (&voff)[2][2]) const {
        const int cnt = tab[80 + u.e];
#pragma unroll
        for (int h = 0; h < 2; ++h)
#pragma unroll
            for (int i = 0; i < 2; ++i) { int pos = u.mt * 256 + h * 128 + stR[i]; if (pos >= cnt) pos = 0;
                const int tok = list[u.e * 8192 + pos]; voff[h][i] = (unsigned)(tok * D + stC[i]) * 2u; }
    }
};
struct EpiH {
    static constexpr bool PERM = true;
    bf16_t* HH; const float* ql; const LAS int* tab;
    __device__ __forceinline__ void operator()(const f32x4 (&acc)[2][2][4][2], const pg8::Unit& u, int wr, int wc, int fr, int fq) const {
        const int cnt = tab[80 + u.e];
#pragma unroll
        for (int ai = 0; ai < 2; ++ai)
#pragma unroll
            for (int m = 0; m < 4; ++m) { const int rl = ai * 128 + wr * 64 + m * 16 + fr, lr = u.mt * 256 + rl;
                const float q = lr < cnt ? ql[u.e * 8192 + lr] : 0.f;
                f32x4 v0 = acc[ai][0][m][0], v1 = acc[ai][0][m][1]; const f32x4 u0 = acc[ai][1][m][0], u1 = acc[ai][1][m][1];
#pragma unroll
                for (int j = 0; j < 4; ++j) { v0[j] = silu_(v0[j]) * u0[j] * q; v1[j] = silu_(v1[j]) * u1[j] * q; }
                u32x4 w; w.x = pg8::cvt_pk_bf16(v0[0], v0[1]); w.y = pg8::cvt_pk_bf16(v0[2], v0[3]); w.z = pg8::cvt_pk_bf16(v1[0], v1[1]); w.w = pg8::cvt_pk_bf16(v1[2], v1[3]);
                *(u32x4*)(HH + (size_t)(u.pm * 256 + rl) * FF + 128 * u.pn + wc * 32 + 8 * fq) = w; }
    }
};
struct EpiYf {
    static constexpr bool PERM = true;
    bf16_t* YF;
    __device__ __forceinline__ void operator()(const f32x4 (&acc)[2][2][4][2], const pg8::Unit& u, int wr, int wc, int fr, int fq) const {
#pragma unroll
        for (int ai = 0; ai < 2; ++ai)
#pragma unroll
            for (int m = 0; m < 4; ++m) { bf16_t* rowp = YF + (size_t)(u.pm * 256 + ai * 128 + wr * 64 + m * 16 + fr) * D + u.pn * 256 + wc * 32 + 8 * fq;
#pragma unroll
                for (int bj = 0; bj < 2; ++bj) { const f32x4 v0 = acc[ai][bj][m][0], v1 = acc[ai][bj][m][1];
                    u32x4 w; w.x = pg8::cvt_pk_bf16(v0[0], v0[1]); w.y = pg8::cvt_pk_bf16(v0[2], v0[3]); w.z = pg8::cvt_pk_bf16(v1[0], v1[1]); w.w = pg8::cvt_pk_bf16(v1[2], v1[3]);
                    *(u32x4*)(rowp + bj * 128) = w; } }
    }
};

__device__ __forceinline__ void final_phase(Frame& F, const LAS int* tab) {
    const int gw = F.vcu * NWAVES + F.wave, NGW = F.G * NWAVES, lane = F.lane;
    const float* Y1 = (const float*)(F.ws + WS_Y1); const float* stat1 = (const float*)(F.ws + WS_STAT1); const unsigned* route = (const unsigned*)(F.ws + WS_ROUTE);
    const bf16_t* YF = (const bf16_t*)(F.ws + WS_YF); const float* g1 = F.in[16]; const float* b1 = F.in[17]; const float* g2 = F.in[25]; const float* b2 = F.in[26];
    for (int m = gw; m < M; m += NGW) {
        const unsigned* r = route + (size_t)m * 8;
        const int s0 = tab[40 + (int)r[0]] + (int)r[4], s1 = tab[40 + (int)r[1]] + (int)r[5];
        const float mean1 = stat1[2 * m], rstd1 = stat1[2 * m + 1];
        const f32x4* yr = (const f32x4*)(Y1 + (size_t)m * D) + lane;
        const u32x2* f0 = (const u32x2*)(YF + (size_t)s0 * D) + lane; const u32x2* f1 = (const u32x2*)(YF + (size_t)s1 * D) + lane;
        f32x4 v[8]; float s = 0.f;
#pragma unroll
        for (int j = 0; j < 8; ++j) { const f32x4 y = yr[64 * j], g4 = ((const f32x4*)g1)[lane + 64 * j], b4 = ((const f32x4*)b1)[lane + 64 * j];
            const u32x2 a = f0[64 * j], c = f1[64 * j];
            const f32x4 ff = (f32x4){bflo(a.x) + bflo(c.x), bfhi(a.x) + bfhi(c.x), bflo(a.y) + bflo(c.y), bfhi(a.y) + bfhi(c.y)};
            v[j] = (((y - mean1) * rstd1) * g4 + b4) * ALPHA + ff; s += (v[j].x + v[j].y) + (v[j].z + v[j].w); }
        const float mean = wave_sum(s) * (1.f / D); float s2 = 0.f;
#pragma unroll
        for (int j = 0; j < 8; ++j) { v[j] = v[j] - mean; s2 += (v[j].x * v[j].x + v[j].y * v[j].y) + (v[j].z * v[j].z + v[j].w * v[j].w); }
        const float rstd = 1.f / sqrtf(wave_sum(s2) * (1.f / D) + LN_EPS);
        f32x4* o = (f32x4*)(F.out + (size_t)m * D) + lane;
#pragma unroll
        for (int j = 0; j < 8; ++j) { const f32x4 g4 = ((const f32x4*)g2)[lane + 64 * j], b4 = ((const f32x4*)b2)[lane + 64 * j]; o[64 * j] = (v[j] * rstd) * g4 + b4; }
    }
}

#ifndef FAST_MASK
#define FAST_MASK 0xFF
#endif
#ifndef ONE_LAUNCH
#define ONE_LAUNCH 1
#endif
constexpr int NPHASE = 8;
__global__ void __launch_bounds__(NWAVES * 64, 2) mk(Args args) {
    extern __shared__ __attribute__((aligned(16))) unsigned char lds_raw[];
    Frame F;
    F.lds = (LAS unsigned char*)lds_raw; F.MISC = (volatile LAS unsigned*)(F.lds + MISC_OFF);
    F.tid = threadIdx.x; F.lane = F.tid & 63; F.wave = __builtin_amdgcn_readfirstlane(F.tid >> 6);
    F.G = gridDim.x; { const int bx = blockIdx.x; F.vcu = (F.G % 8 == 0) ? (bx % 8) * (F.G / 8) + bx / 8 : bx; }
    F.in = args.in; F.out = args.out; F.ws = args.ws;
    unsigned char* ws = args.ws;
    const int lo = args.ph_lo, hi = args.ph_hi;
    for (int u = F.tid; u < 64; u += NWAVES * 64) F.MISC[u] = 0u;
    __syncthreads();
    XcdBarrier bar; bar.bar = (unsigned*)(ws + WS_CTL) + CW_BAR + lo * XCD_BAR_WORDS; bar.x = 0; bar.st = nullptr;
    if (hi - lo > 1) bar = xcd_barrier_post((unsigned*)(ws + WS_CTL) + CW_BAR + lo * XCD_BAR_WORDS, F.MISC + 8);
#ifndef PH_EN
#define PH_EN 0xFF
#endif
#define IN(k) (((PH_EN >> (k)) & 1) && lo <= (k) && (k) < hi)
#define SEAM(k) do { if (IN(k) && IN((k) + 1)) xcd_barrier(bar); } while (0)

    if (IN(0)) { p0_prologue(F); SEAM(0); }
    if (IN(1)) {
        pg8::DenseOrder S; S.init(ws + WS_H0, ws + WS_BT1, M, 4096, D, F.G, (int)blockIdx.x);
        EpiZ E{(bf16_t*)(ws + WS_ZP)};
        pg8::gemm_phase<EpiZ, pg8::DenseOrder, false, MK_ALIGN, MK_SP2>(F.lds, D, S, E);
        SEAM(1);
    }
    if (IN(2)) {
        for (int u = F.vcu; u < 256; u += F.G) lru_unit(F, u);
        for (int u = F.vcu; u < 256; u += F.G) conv31_unit(F, u);
        SEAM(2);
    }
    if (IN(3)) {
        pg8::DenseOrder S; S.init(ws + WS_MIX, ws + WS_BT2, M, D, D, F.G, (int)blockIdx.x);
        EpiY1 E{(float*)(ws + WS_Y1), F.in[0], (const float*)(ws + WS_STAT0), F.in[1], F.in[2]};
        pg8::gemm_phase<EpiY1, pg8::DenseOrder, false, MK_ALIGN, MK_SP2>(F.lds, D, S, E);
        SEAM(3);
    }
    if (IN(4)) {
        for (int u = F.vcu; u < 256; u += F.G) router_unit(F, u);
        SEAM(4);
    }
    if (IN(5)) {
        const LAS int* tab = moe_tables(F);
        MoeOrder S{tab, (const char*)(ws + WS_H1), (const char*)(ws + WS_BTU), (const int*)(ws + WS_LIST), 4, F.G, F.vcu, true};
        EpiH E{(bf16_t*)(ws + WS_HH), (const float*)(ws + WS_QL), tab};
        pg8::gemm_phase<EpiH, MoeOrder, true, MK_ALIGN, MK_SP2>(F.lds, D, S, E);
        SEAM(5);
    }
    if (IN(6)) {
        const LAS int* tab = moe_tables(F);
        MoeOrder S{tab, (const char*)(ws + WS_HH), (const char*)(ws + WS_BTD), (const int*)(ws + WS_LIST), 8, F.G, F.vcu, false};
        EpiYf E{(bf16_t*)(ws + WS_YF)};
        pg8::gemm_phase<EpiYf, MoeOrder, false, MK_ALIGN, MK_SP2>(F.lds, FF, S, E);
        SEAM(6);
    }
    if (IN(7)) {
        const LAS int* tab = moe_tables(F);
        final_phase(F, tab);
    }
#undef IN
#undef SEAM
}

extern "C" void kernel_launch(void* const* d_in, const int* in_sizes, int n_in, void* d_out, int out_size, void* d_ws, size_t ws_size, hipStream_t stream) {
    static int grid = 0;
    if (grid == 0) {
        if (n_in != 27 || in_sizes[0] != M * D || out_size != M * D || ws_size < WS_NEED) {
            fprintf(stderr, "kernel_launch: unexpected shapes (n_in %d, in0 %d, out %d, ws %zu); nothing launched\n", n_in, n_in > 0 ? in_sizes[0] : -1, out_size, ws_size); grid = -1; return; }
        int dev = 0, cus = 0, per_cu = 0;
        if (hipGetDevice(&dev) != hipSuccess || hipDeviceGetAttribute(&cus, hipDeviceAttributeMultiprocessorCount, dev) != hipSuccess) { grid = -1; return; }
        if (hipFuncSetAttribute((const void*)mk, hipFuncAttributeMaxDynamicSharedMemorySize, LDS_BYTES) != hipSuccess) { fprintf(stderr, "kernel_launch: hipFuncSetAttribute failed\n"); grid = -1; return; }
        if (hipOccupancyMaxActiveBlocksPerMultiprocessor(&per_cu, (const void*)mk, NWAVES * 64, LDS_BYTES) != hipSuccess || per_cu < 1) { fprintf(stderr, "kernel_launch: occupancy query says %d blocks per CU\n", per_cu); (void)hipGetLastError(); grid = -1; return; }
        grid = cus;
    }
    if (grid < 0) return;
    const float* const* in = (const float* const*)d_in;
    unsigned char* ws = (unsigned char*)d_ws;
    (void)hipMemsetAsync(ws + WS_CTL, 0, CTL_ZERO_BYTES, stream);
    float* stat0 = (float*)(ws + WS_STAT0); float* stat1 = (float*)(ws + WS_STAT1); unsigned* route = (unsigned*)(ws + WS_ROUTE);
    int* list = (int*)(ws + WS_LIST); float* ql = (float*)(ws + WS_QL); unsigned* cnt = (unsigned*)(ws + WS_CTL) + CW_CNT;
    bf16_t* H0 = (bf16_t*)(ws + WS_H0); bf16_t* ZP = (bf16_t*)(ws + WS_ZP); bf16_t* MIX = (bf16_t*)(ws + WS_MIX); float* Y1 = (float*)(ws + WS_Y1);
    bf16_t* H1 = (bf16_t*)(ws + WS_H1); bf16_t* HH = (bf16_t*)(ws + WS_HH); bf16_t* YF = (bf16_t*)(ws + WS_YF);
    float* ZRAW = (float*)(ws + WS_ZRAW); float* AIN = (float*)(ws + WS_AIN); float* ADEC = (float*)(ws + WS_ADEC); float* U = (float*)(ws + WS_U);
    Args a{};
    for (int i = 0; i < 27; ++i) a.in[i] = in[i];
    a.out = (float*)d_out; a.ws = ws;
    for (int p = 0; p < NPHASE;) {
        if ((FAST_MASK >> p) & 1) {
            int q = p + 1;
            if (ONE_LAUNCH) while (q < NPHASE && ((FAST_MASK >> q) & 1)) ++q;
            a.ph_lo = p; a.ph_hi = q;
            hipLaunchKernelGGL(mk, dim3(grid), dim3(NWAVES * 64), LDS_BYTES, stream, a);
            p = q; continue;
        }
        switch (p) {
        case 0:
            nv_ln_in<<<M, 256, 0, stream>>>(in[0], in[1], in[2], H0, stat0);
            break;
        case 1:
            nv_gemm<<<dim3(4096 / 64, M / 64), 256, 0, stream>>>(H0, in[3], ZRAW, M, 4096, D);
            nv_zprime<<<(unsigned)(((size_t)M * NZ + 255) / 256), 256, 0, stream>>>(ZRAW, ZP);
            break;
        case 2:
            nv_lru1<<<(M * DL + 255) / 256, 256, 0, stream>>>(ZP, in[4], in[5], AIN);
            nv_lru2<<<(M * DL + 255) / 256, 256, 0, stream>>>(AIN, in[6], in[7], in[8], in[9], in[10], ADEC, U);
            nv_lru3<<<(2 * DL + 255) / 256, 256, 0, stream>>>(ADEC, U, ZP, MIX);
            nv_conv31<<<M, 256, 0, stream>>>(ZP, in[11], in[12], in[13], in[14], MIX);
            break;
        case 3:
            nv_gemm<<<dim3(D / 64, M / 64), 256, 0, stream>>>(MIX, in[15], Y1, M, D, D);
            nv_y1<<<(unsigned)(((size_t)M * D + 255) / 256), 256, 0, stream>>>(Y1, in[0], stat0, in[1], in[2]);
            break;
        case 4:
            nv_router<<<M, 256, 0, stream>>>(Y1, in[16], in[17], in[18], in[19], in[20], in[21], H1, stat1, route, cnt, list, ql);
            break;
        case 5:
            nv_moe_up<<<2 * M, 512, 0, stream>>>(H1, route, cnt, in[22], in[23], HH);
            break;
        case 6:
            nv_moe_down<<<2 * M, 512, 0, stream>>>(HH, route, cnt, in[24], YF);
            break;
        case 7:
            nv_final<<<M, 256, 0, stream>>>(Y1, stat1, in[16], in[17], route, cnt, YF, in[25], in[26], (float*)d_out);
            break;
        }
        ++p;
    }
}
```

```cpp
#include <hip/hip_runtime.h>
#include <cstdio>
#include <cstdint>

constexpr int D = 2048, SEQ = 4096, M = 8192;
constexpr int DL = 1024, DC = 1024, NH = 16, HDIM = 64;
constexpr int NGRP = 4, NEXPG = 8, NEXP = 32, FF = 512;
constexpr int NZ = 3072;
constexpr float LN_EPS = 1e-5f;
constexpr float ALPHA = 1.189207115002721f;
constexpr int SLOT_ROWS = 24576;

typedef unsigned short bf16_t;
typedef float f32x4 __attribute__((ext_vector_type(4)));
typedef float f32x2 __attribute__((ext_vector_type(2)));
typedef short bf16x8 __attribute__((ext_vector_type(8)));
typedef unsigned u32x4 __attribute__((ext_vector_type(4)));
typedef unsigned u32x2 __attribute__((ext_vector_type(2)));

constexpr size_t MiB = 1u << 20;
constexpr size_t WS_CTL = 0, CTL_ZERO_BYTES = 1 * MiB;
constexpr size_t WS_STAT0 = 1 * MiB;
constexpr size_t WS_STAT1 = 1 * MiB + 65536;
constexpr size_t WS_ROUTE = 1 * MiB + 131072;
constexpr size_t WS_LIST = 2 * MiB;
constexpr size_t WS_QL = 3 * MiB;
constexpr size_t WS_BT1 = 8 * MiB;
constexpr size_t WS_BT2 = 24 * MiB;
constexpr size_t WS_BTU = 32 * MiB;
constexpr size_t WS_BTD = 160 * MiB;
constexpr size_t WS_Y1 = 224 * MiB;
constexpr size_t WS_H0 = 288 * MiB;
constexpr size_t WS_ZP = 320 * MiB;
constexpr size_t WS_MIX = 368 * MiB;
constexpr size_t WS_H1 = 288 * MiB;
constexpr size_t WS_HH = 320 * MiB;
constexpr size_t WS_YF = 344 * MiB;
constexpr size_t WS_ZRAW = 368 * MiB;
constexpr size_t WS_AIN = 400 * MiB;
constexpr size_t WS_ADEC = 440 * MiB;
constexpr size_t WS_U = 472 * MiB;
constexpr size_t WS_NEED = 504 * MiB;
constexpr int CW_CNT = 1024;

struct Args { const float* in[27]; float* out; unsigned char* ws; int ph_lo, ph_hi, rep, pad; };

__device__ __forceinline__ float bf2f(bf16_t v) { return __uint_as_float((unsigned)v << 16); }
__device__ __forceinline__ unsigned f2bf(float f) { unsigned u = __float_as_uint(f); return (u + 0x7fffu + ((u >> 16) & 1u)) >> 16; }
__device__ __forceinline__ float sigmoidf_(float x) { return 1.0f / (1.0f + __expf(-x)); }
__device__ __forceinline__ float gelu_tanh(float x) { const float u = 0.7978845608028654f * (x + 0.044715f * x * x * x); return x * sigmoidf_(2.0f * u); }
__device__ __forceinline__ float silu_(float x) { return x * sigmoidf_(x); }

__device__ __forceinline__ float block_sum256(float v, float* red) {
    red[threadIdx.x] = v; __syncthreads();
    for (int s = 128; s > 0; s >>= 1) { if ((int)threadIdx.x < s) red[threadIdx.x] += red[threadIdx.x + s]; __syncthreads(); }
    const float r = red[0]; __syncthreads(); return r;
}
__global__ void __launch_bounds__(256) nv_ln_in(const float* x, const float* g, const float* b, bf16_t* H0, float* stat) {
    __shared__ float red[256];
    const int m = blockIdx.x; const float* xr = x + (size_t)m * D;
    float s = 0.f; for (int c = threadIdx.x; c < D; c += 256) s += xr[c];
    const float mean = block_sum256(s, red) * (1.0f / D);
    float q = 0.f; for (int c = threadIdx.x; c < D; c += 256) { const float d = xr[c] - mean; q += d * d; }
    const float rstd = 1.0f / sqrtf(block_sum256(q, red) * (1.0f / D) + LN_EPS);
    for (int c = threadIdx.x; c < D; c += 256) H0[(size_t)m * D + c] = (bf16_t)f2bf((xr[c] - mean) * rstd * g[c] + b[c]);
    if (threadIdx.x == 0) { stat[2 * m] = mean; stat[2 * m + 1] = rstd; }
}
__host__ __device__ __forceinline__ int dst_row(int n, int mode) {
    if (mode == 0) return n;
    if (mode == 1) { if (n < 2048) return n; if (n < 3072) { const int s = n - 2048; return 2048 + 256 * (s >> 7) + (s & 127); } const int s = n - 3072; return 2048 + 256 * (s >> 7) + 128 + (s & 127); }
    if (mode == 2) return 256 * (n >> 7) + (n & 127);
    return 256 * (n >> 7) + 128 + (n & 127);
}
__global__ void __launch_bounds__(256) nv_transpose(const float* W, int K, int N, bf16_t* WT, int mode) {
    const size_t idx = (size_t)blockIdx.x * 256 + threadIdx.x; if (idx >= (size_t)K * N) return;
    const int n = (int)(idx % N), k = (int)(idx / N);
    WT[(size_t)dst_row(n, mode) * K + k] = (bf16_t)f2bf(W[idx]);
}
__global__ void __launch_bounds__(256) nv_gemm(const bf16_t* A, const float* B, float* C, int Mr, int N, int K) {
    __shared__ float As[16][65], Bs[16][65];
    const int tx = threadIdx.x & 15, ty = threadIdx.x >> 4, m0 = blockIdx.y * 64, n0 = blockIdx.x * 64;
    float acc[4][4] = {};
    for (int k0 = 0; k0 < K; k0 += 16) {
        for (int i = threadIdx.x; i < 64 * 16; i += 256) { const int r = i >> 4, kk = i & 15; As[kk][r] = bf2f(A[(size_t)(m0 + r) * K + k0 + kk]); }
        for (int i = threadIdx.x; i < 64 * 16; i += 256) { const int kk = i >> 6, c = i & 63; Bs[kk][c] = B[(size_t)(k0 + kk) * N + n0 + c]; }
        __syncthreads();
#pragma unroll
        for (int kk = 0; kk < 16; ++kk) {
            float a[4], b[4];
#pragma unroll
            for (int i = 0; i < 4; ++i) { a[i] = As[kk][ty * 4 + i]; b[i] = Bs[kk][tx * 4 + i]; }
#pragma unroll
            for (int i = 0; i < 4; ++i)
#pragma unroll
                for (int j = 0; j < 4; ++j) acc[i][j] += a[i] * b[j];
        }
        __syncthreads();
    }
    for (int i = 0; i < 4; ++i) for (int j = 0; j < 4; ++j) C[(size_t)(m0 + ty * 4 + i) * N + n0 + tx * 4 + j] = acc[i][j];
}
__global__ void __launch_bounds__(256) nv_zprime(const float* zraw, bf16_t* ZP) {
    const size_t idx = (size_t)blockIdx.x * 256 + threadIdx.x; if (idx >= (size_t)M * NZ) return;
    const int c = (int)(idx % NZ); const size_t m = idx / NZ; const float* zr = zraw + m * 4096;
    float v;
    if (c < 1024) v = zr[c]; else if (c < 2048) v = gelu_tanh(zr[c]); else v = zr[c] * sigmoidf_(zr[c + 1024]);
    ZP[idx] = (bf16_t)f2bf(v);
}
__global__ void __launch_bounds__(256) nv_lru1(const bf16_t* ZP, const float* w4, const float* b4, float* AIN) {
    const size_t idx = (size_t)blockIdx.x * 256 + threadIdx.x; if (idx >= (size_t)M * DL) return;
    const int c = (int)(idx % DL); const int m = (int)(idx / DL), t = m % SEQ;
    float s = b4[c];
    for (int j = 0; j < 4; ++j) { const int tt = t - 3 + j; if (tt >= 0) s += w4[j * DL + c] * bf2f(ZP[(size_t)(m - 3 + j) * NZ + c]); }
    AIN[idx] = s;
}
__global__ void __launch_bounds__(256) nv_lru2(const float* AIN, const float* wa, const float* ba, const float* wx, const float* bx, const float* lam, float* ADEC, float* U) {
    const size_t idx = (size_t)blockIdx.x * 256 + threadIdx.x; if (idx >= (size_t)M * DL) return;
    const int c = (int)(idx % DL); const size_t m = idx / DL; const int h = c >> 6, j = c & 63;
    const float* ar = AIN + m * DL + h * 64;
    float sr = ba[c], si = bx[c];
    for (int i = 0; i < 64; ++i) { const float a = ar[i]; sr += a * wa[(size_t)(h * 64 + i) * 64 + j]; si += a * wx[(size_t)(h * 64 + i) * 64 + j]; }
    const float r = sigmoidf_(sr), ig = sigmoidf_(si);
    const float l = lam[c]; const float sp = (-l > 20.f) ? -l : log1pf(expf(-l));
    const float log_a = -8.0f * r * sp; const float a = expf(log_a);
    ADEC[idx] = a; U[idx] = sqrtf(-expm1f(2.0f * log_a)) * (ig * ar[j]);
}
__global__ void __launch_bounds__(256) nv_lru3(const float* ADEC, const float* U, const bf16_t* ZP, bf16_t* MIX) {
    const int idx = blockIdx.x * 256 + threadIdx.x; if (idx >= 2 * DL) return;
    const int b = idx / DL, c = idx % DL; float h = 0.f;
    for (int t = 0; t < SEQ; ++t) { const size_t m = (size_t)b * SEQ + t; h = ADEC[m * DL + c] * h + U[m * DL + c]; MIX[m * D + c] = (bf16_t)f2bf(bf2f(ZP[m * NZ + 1024 + c]) * h); }
}
__global__ void __launch_bounds__(256) nv_conv31(const bf16_t* ZP, const float* w, const float* bias, const float* g, const float* b, bf16_t* MIX) {
    __shared__ float red[256];
    const int m = blockIdx.x, t = m % SEQ; float v[4]; float s = 0.f;
    for (int i = 0; i < 4; ++i) { const int c = threadIdx.x + 256 * i; float a = bias[c];
        for (int j = 0; j < 31; ++j) { const int tt = t - 30 + j; if (tt >= 0) a += w[j * DC + c] * bf2f(ZP[(size_t)(m - 30 + j) * NZ + 2048 + c]); }
        v[i] = a; s += a; }
    const float mean = block_sum256(s, red) * (1.0f / DC); float q = 0.f;
    for (int i = 0; i < 4; ++i) { const float d = v[i] - mean; q += d * d; }
    const float rstd = 1.0f / sqrtf(block_sum256(q, red) * (1.0f / DC) + LN_EPS);
    for (int i = 0; i < 4; ++i) { const int c = threadIdx.x + 256 * i; MIX[(size_t)m * D + 1024 + c] = (bf16_t)f2bf(silu_((v[i] - mean) * rstd * g[c] + b[c])); }
}
__global__ void __launch_bounds__(256) nv_y1(float* Y1, const float* x, const float* stat0, const float* g, const float* b) {
    const size_t idx = (size_t)blockIdx.x * 256 + threadIdx.x; if (idx >= (size_t)M * D) return;
    const int c = (int)(idx % D); const size_t m = idx / D;
    Y1[idx] += ALPHA * ((x[idx] - stat0[2 * m]) * stat0[2 * m + 1] * g[c] + b[c]);
}
__global__ void __launch_bounds__(256) nv_router(const float* Y1, const float* g1, const float* b1, const float* wg, const float* bg, const float* we, const float* be,
                                                 bf16_t* H1, float* stat1, unsigned* route, unsigned* cnt, int* list, float* ql) {
    __shared__ float red[256]; __shared__ float lg[36];
    const int m = blockIdx.x; const float* yr = Y1 + (size_t)m * D;
    float s = 0.f; for (int c = threadIdx.x; c < D; c += 256) s += yr[c];
    const float mean = block_sum256(s, red) * (1.0f / D);
    float q = 0.f; for (int c = threadIdx.x; c < D; c += 256) { const float d = yr[c] - mean; q += d * d; }
    const float rstd = 1.0f / sqrtf(block_sum256(q, red) * (1.0f / D) + LN_EPS);
    float hv[8];
    for (int i = 0; i < 8; ++i) { const int c = threadIdx.x + 256 * i; hv[i] = (yr[c] - mean) * rstd * g1[c] + b1[c]; H1[(size_t)m * D + c] = (bf16_t)f2bf(hv[i]); }
    for (int o = 0; o < 36; ++o) { float p = 0.f;
        for (int i = 0; i < 8; ++i) { const int c = threadIdx.x + 256 * i; p += hv[i] * (o < 4 ? wg[c * 4 + o] : we[c * 32 + (o - 4)]); }
        p = block_sum256(p, red); if (threadIdx.x == 0) lg[o] = p + (o < 4 ? bg[o] : be[o - 4]); }
    __syncthreads();
    if (threadIdx.x == 0) {
        stat1[2 * m] = mean; stat1[2 * m + 1] = rstd;
        int gs = 0; for (int j = 1; j < 4; ++j) if (lg[j] > lg[gs]) gs = j;
        float den = 0.f; for (int j = 0; j < 4; ++j) den += expf(lg[j] - lg[gs]);
        const float pg = 1.0f / den;
        const float* le = lg + 4 + 8 * gs; int i0 = 0; for (int j = 1; j < 8; ++j) if (le[j] > le[i0]) i0 = j;
        int i1 = (i0 == 0) ? 1 : 0; for (int j = 0; j < 8; ++j) if (j != i0 && le[j] > le[i1]) i1 = j;
        const float ex = expf(le[i1] - le[i0]); const float q0 = pg / (1.0f + ex), q1 = pg * ex / (1.0f + ex);
        const int e0 = gs * 8 + i0, e1 = gs * 8 + i1;
        const unsigned p0 = atomicAdd(&cnt[e0], 1u), p1 = atomicAdd(&cnt[e1], 1u);
        list[e0 * 8192 + p0] = m; ql[e0 * 8192 + p0] = q0; list[e1 * 8192 + p1] = m; ql[e1 * 8192 + p1] = q1;
        unsigned* r = route + (size_t)m * 8; r[0] = e0; r[1] = e1; r[2] = __float_as_uint(q0); r[3] = __float_as_uint(q1); r[4] = p0; r[5] = p1;
    }
}
__device__ __forceinline__ int slot_off(const unsigned* cnt, int e) { int o = 0; for (int j = 0; j < e; ++j) o += ((int)cnt[j] + 255) & ~255; return o; }
__global__ void __launch_bounds__(512) nv_moe_up(const bf16_t* H1, const unsigned* route, const unsigned* cnt, const float* wgate, const float* wup, bf16_t* HH) {
    __shared__ float xs[D];
    const int m = blockIdx.x >> 1, k = blockIdx.x & 1; const unsigned* r = route + (size_t)m * 8;
    const int e = (int)r[k]; const float q = __uint_as_float(r[2 + k]); const int slot = slot_off(cnt, e) + (int)r[4 + k];
    for (int c = threadIdx.x; c < D; c += 512) xs[c] = bf2f(H1[(size_t)m * D + c]);
    __syncthreads();
    const int f = threadIdx.x; const float* wgp = wgate + (size_t)e * D * FF + f; const float* wup_ = wup + (size_t)e * D * FF + f;
    float g = 0.f, u = 0.f;
    for (int d = 0; d < D; ++d) { g += xs[d] * wgp[(size_t)d * FF]; u += xs[d] * wup_[(size_t)d * FF]; }
    HH[(size_t)slot * FF + f] = (bf16_t)f2bf(silu_(g) * u * q);
}
__global__ void __launch_bounds__(512) nv_moe_down(const bf16_t* HH, const unsigned* route, const unsigned* cnt, const float* wdown, bf16_t* YF) {
    __shared__ float hs[FF];
    const int m = blockIdx.x >> 1, k = blockIdx.x & 1; const unsigned* r = route + (size_t)m * 8;
    const int e = (int)r[k]; const int slot = slot_off(cnt, e) + (int)r[4 + k];
    hs[threadIdx.x] = bf2f(HH[(size_t)slot * FF + threadIdx.x]);
    __syncthreads();
    const float* wd = wdown + (size_t)e * FF * D;
    for (int i = 0; i < 4; ++i) { const int d = threadIdx.x + 512 * i; float y = 0.f;
        for (int f = 0; f < FF; ++f) y += hs[f] * wd[(size_t)f * D + d];
        YF[(size_t)slot * D + d] = (bf16_t)f2bf(y); }
}
__global__ void __launch_bounds__(256) nv_final(const float* Y1, const float* stat1, const float* g1, const float* b1, const unsigned* route, const unsigned* cnt, const bf16_t* YF,
                                                const float* g2, const float* b2, float* out) {
    __shared__ float red[256];
    const int m = blockIdx.x; const unsigned* r = route + (size_t)m * 8;
    const int s0 = slot_off(cnt, (int)r[0]) + (int)r[4], s1 = slot_off(cnt, (int)r[1]) + (int)r[5];
    const float mean1 = stat1[2 * m], rstd1 = stat1[2 * m + 1];
    float v[8]; float s = 0.f;
    for (int i = 0; i < 8; ++i) { const int c = threadIdx.x + 256 * i;
        const float h1 = (Y1[(size_t)m * D + c] - mean1) * rstd1 * g1[c] + b1[c];
        v[i] = ALPHA * h1 + (bf2f(YF[(size_t)s0 * D + c]) + bf2f(YF[(size_t)s1 * D + c])); s += v[i]; }
    const float mean = block_sum256(s, red) * (1.0f / D); float q = 0.f;
    for (int i = 0; i < 8; ++i) { const float d = v[i] - mean; q += d * d; }
    const float rstd = 1.0f / sqrtf(block_sum256(q, red) * (1.0f / D) + LN_EPS);
    for (int i = 0; i < 8; ++i) { const int c = threadIdx.x + 256 * i; out[(size_t)m * D + c] = (v[i] - mean) * rstd * g2[c] + b2[c]; }
}


#define LAS __attribute__((address_space(3)))
#define GAS __attribute__((address_space(1)))
namespace pg8 {
constexpr int BM = 256, BK = 64, HALF = 128, HTB = HALF * BK * 2, STAGE_BYTES = 8 * HTB, NXCD = 8, WGM = 8;
__host__ __device__ __forceinline__ int lds_byte(int r, int c) { const int st = (r >> 4) * 2 + (c >> 5), rr = r & 15, cc = c & 31, ob = rr * 64 + cc * 2; return st * 1024 + (ob ^ (((ob >> 9) & 1) << 5)); }
__host__ __device__ __forceinline__ void stage_rc(int b, int& R, int& C) { const int st = b / 1024, sb = b % 1024, swz = sb ^ (((sb >> 9) & 1) << 5); R = (st >> 1) * 16 + swz / 64; C = (st & 1) * 32 + (swz % 64) / 2; }
__host__ __device__ __forceinline__ int perm32(int rho) { const int n = rho >> 4, i = rho & 15; return 8 * (i >> 2) + 4 * n + (i & 3); }

struct Unit { const char* a; const char* b; int pm, pn, e, mt; };

__device__ __forceinline__ unsigned cvt_pk_bf16(float lo, float hi) { unsigned r; asm volatile("v_cvt_pk_bf16_f32 %0, %1, %2" : "=v"(r) : "v"(lo), "v"(hi)); return r; }

struct DenseOrder {
    const char* A; const char* Bt; int K, nM, nN, nwg, G, c;
    __device__ void init(const void* A_, const void* Bt_, int Mr, int N, int K_, int G_, int c_) { A = (const char*)A_; Bt = (const char*)Bt_; K = K_; nM = Mr / BM; nN = N / BM; nwg = nM * nN; G = G_; c = c_; }
    __device__ bool next(int i, Unit& u) const {
        const long L = (long)i * G + c; if (L >= nwg) return false;
        int wgid = (int)L; { const int q = nwg / NXCD, r = nwg % NXCD, xcd = wgid % NXCD, off = wgid / NXCD; wgid = (xcd < r ? xcd * (q + 1) : r * (q + 1) + (xcd - r) * q) + off; }
        const int nig = WGM * nN, gid = wgid / nig, fm = gid * WGM, gsz = (nM - fm) < WGM ? (nM - fm) : WGM;
        u.pm = fm + ((wgid % nig) % gsz); u.pn = (wgid % nig) / gsz; u.e = 0; u.mt = 0;
        u.a = A + (size_t)u.pm * BM * K * 2; u.b = Bt + (size_t)u.pn * BM * K * 2; return true;
    }
    __device__ __forceinline__ void gather(const Unit&, const int (&)[2], const int (&)[2], unsigned (&)[2][2]) const {}
};

template <class Epi, class Sched, bool GATHER, bool ALIGN_EPI, bool SP2>
__device__ __forceinline__ void gemm_phase(LAS unsigned char* lds, const int K, const Sched& S, const Epi& E) {
    const int tid = threadIdx.x, wid = __builtin_amdgcn_readfirstlane(tid >> 6), lane = tid & 63, wr = wid >> 2, wc = wid & 3, fr = lane & 15, fq = lane >> 4;
    const int nt = K / BK;
    unsigned voffA[2], voffB[2]; int stR[2], stC[2];
#pragma unroll
    for (int i = 0; i < 2; ++i) { int R, C; stage_rc(tid * 16 + i * 8192, R, C); const int Rb = Epi::PERM ? ((R & ~31) + perm32(R & 31)) : R;
        voffA[i] = (unsigned)(R * K + C) * 2u; voffB[i] = (unsigned)(Rb * K + C) * 2u; stR[i] = R; stC[i] = C; }
    unsigned voffG[2][2] = {{0u, 0u}, {0u, 0u}}, voffGn[2][2] = {{0u, 0u}, {0u, 0u}};
    const size_t kstep = (size_t)(BK * 2);
    const size_t hstep = (size_t)HALF * K * 2;
    const unsigned ldsw = (unsigned)wid * 1024u;
    const int aoff = lds_byte(wr * 64 + fr, fq * 8), boff = lds_byte(wc * 32 + fr, fq * 8);
#define PG8_SA(b, h) (((b) * 2 + (h)) * HTB)
#define PG8_SB(b, h) ((4 + (b) * 2 + (h)) * HTB)
#define PG8_STAGE(bufoff, gbase, voff) do { _Pragma("unroll") for (int _i = 0; _i < 2; ++_i) \
        __builtin_amdgcn_global_load_lds((const unsigned*)((const char*)(gbase) + (voff)[_i]), (LAS unsigned*)(lds + (bufoff) + ldsw + _i * 8192), 16, 0, 0); } while (0)
#define PG8_STAGE_A(bufoff, gk, h, og) do { if constexpr (GATHER) { PG8_STAGE(bufoff, gk, (og)[h]); } else { PG8_STAGE(bufoff, (gk) + (h) * hstep, voffA); } } while (0)
#define PG8_LDA(dst, b, h) do { _Pragma("unroll") for (int m = 0; m < 4; ++m) _Pragma("unroll") for (int k = 0; k < 2; ++k) dst[m][k] = *(const LAS bf16x8*)(lds + PG8_SA(b, h) + aoff + m * 2048 + k * 1024); } while (0)
#define PG8_LDB(dst, b, h) do { _Pragma("unroll") for (int n = 0; n < 2; ++n) _Pragma("unroll") for (int k = 0; k < 2; ++k) dst[n][k] = *(const LAS bf16x8*)(lds + PG8_SB(b, h) + boff + n * 2048 + k * 1024); } while (0)
#define PG8_MMA(ai, bj, At, Bt) do { __builtin_amdgcn_s_setprio(1); _Pragma("unroll") for (int m = 0; m < 4; ++m) _Pragma("unroll") for (int n = 0; n < 2; ++n) _Pragma("unroll") for (int k = 0; k < 2; ++k) \
        acc[ai][bj][m][n] = __builtin_amdgcn_mfma_f32_16x16x32_bf16(Bt[n][k], At[m][k], acc[ai][bj][m][n], 0, 0, 0); __builtin_amdgcn_s_setprio(0); } while (0)
#define PG8_WAIT_V(n) asm volatile("s_waitcnt vmcnt(" #n ")" ::: "memory")
#define PG8_WAIT_L(n) asm volatile("s_waitcnt lgkmcnt(" #n ")" ::: "memory")
#define PG8_BAR __builtin_amdgcn_s_barrier()
#define PG8_SCHED __builtin_amdgcn_sched_barrier(0)
    Unit cur, nxt; int ui = 0;
    if (!S.next(0, cur)) return;
    f32x4 acc[2][2][4][2];
#pragma unroll
    for (int a = 0; a < 2; ++a)
#pragma unroll
        for (int b = 0; b < 2; ++b)
#pragma unroll
            for (int m = 0; m < 4; ++m)
#pragma unroll
                for (int n = 0; n < 2; ++n) acc[a][b][m][n] = (f32x4){0.f, 0.f, 0.f, 0.f};
    bf16x8 At[4][2], B0[2][2], B1[2][2];
    const char* cA = cur.a; const char* cB = cur.b;
    if constexpr (GATHER) { S.gather(cur, stR, stC, voffG); asm volatile("s_waitcnt vmcnt(0)" ::: "memory"); }
    if constexpr (SP2) {
        PG8_STAGE(PG8_SB(0, 0), cB, voffB); PG8_STAGE(PG8_SB(0, 1), cB + hstep, voffB); PG8_STAGE_A(PG8_SA(0, 0), cA, 0, voffG); PG8_STAGE_A(PG8_SA(0, 1), cA, 1, voffG);
        if (wr == 1) PG8_BAR;
        PG8_WAIT_V(2); PG8_BAR;
        PG8_STAGE(PG8_SB(1, 0), cB + kstep, voffB); PG8_STAGE_A(PG8_SA(1, 0), cA + kstep, 0, voffG); PG8_STAGE(PG8_SB(1, 1), cB + hstep + kstep, voffB);
        PG8_WAIT_V(6); PG8_BAR;
    } else {
        PG8_STAGE(PG8_SB(0, 0), cB, voffB); PG8_STAGE_A(PG8_SA(0, 0), cA, 0, voffG); PG8_STAGE(PG8_SB(0, 1), cB + hstep, voffB); PG8_STAGE_A(PG8_SA(0, 1), cA, 1, voffG);
        if (wr == 1) PG8_BAR;
        PG8_WAIT_V(4); PG8_BAR;
        PG8_STAGE(PG8_SB(1, 0), cB + kstep, voffB); PG8_STAGE_A(PG8_SA(1, 0), cA + kstep, 0, voffG); PG8_STAGE(PG8_SB(1, 1), cB + hstep + kstep, voffB);
        PG8_WAIT_V(6); PG8_BAR;
    }
    for (;;) {
        const bool has_next = S.next(ui + 1, nxt);
        const char* nA = has_next ? nxt.a : cA; const char* nB = has_next ? nxt.b : cB;
        if constexpr (GATHER) { if (has_next) S.gather(nxt, stR, stC, voffGn); else {
#pragma unroll
            for (int h = 0; h < 2; ++h)
#pragma unroll
                for (int i = 0; i < 2; ++i) voffGn[h][i] = voffG[h][i]; } }
        for (int t = 0; t < nt; t += 2) {
            const bool last = (t == nt - 2);
            const char* a1 = cA + (size_t)(t + 1) * kstep;
            const char* a2 = last ? nA : cA + (size_t)(t + 2) * kstep; const char* b2 = last ? nB : cB + (size_t)(t + 2) * kstep;
            const char* a3 = a2 + kstep; const char* b3 = b2 + kstep;
            unsigned og2[2][2];
            if constexpr (GATHER) {
#pragma unroll
                for (int h = 0; h < 2; ++h)
#pragma unroll
                    for (int i = 0; i < 2; ++i) og2[h][i] = last ? voffGn[h][i] : voffG[h][i]; }
            if constexpr (SP2) {
            PG8_LDB(B0, 0, 0); PG8_LDB(B1, 0, 1); PG8_SCHED; PG8_LDA(At, 0, 0); PG8_STAGE_A(PG8_SA(1, 1), a1, 1, voffG);
            PG8_WAIT_V(8); PG8_WAIT_L(0); PG8_BAR; PG8_MMA(0, 0, At, B0); PG8_MMA(0, 1, At, B1); PG8_BAR; PG8_SCHED;
            PG8_LDA(At, 0, 1); PG8_STAGE(PG8_SB(0, 0), b2, voffB); PG8_STAGE(PG8_SB(0, 1), b2 + hstep, voffB); PG8_STAGE_A(PG8_SA(0, 0), a2, 0, og2);
            PG8_WAIT_V(8); PG8_WAIT_L(0); PG8_BAR; PG8_MMA(1, 0, At, B0); PG8_MMA(1, 1, At, B1); PG8_BAR; PG8_SCHED;
            PG8_LDB(B0, 1, 0); PG8_LDB(B1, 1, 1); PG8_SCHED; PG8_LDA(At, 1, 0); PG8_STAGE_A(PG8_SA(0, 1), a2, 1, og2);
            PG8_WAIT_V(8); PG8_WAIT_L(0); PG8_BAR; PG8_MMA(0, 0, At, B0); PG8_MMA(0, 1, At, B1); PG8_BAR; PG8_SCHED;
            PG8_LDA(At, 1, 1); PG8_STAGE(PG8_SB(1, 0), b3, voffB); PG8_STAGE(PG8_SB(1, 1), b3 + hstep, voffB); PG8_STAGE_A(PG8_SA(1, 0), a3, 0, og2);
            PG8_WAIT_V(8); PG8_WAIT_L(0); PG8_BAR; PG8_MMA(1, 0, At, B0); PG8_MMA(1, 1, At, B1); PG8_BAR; PG8_SCHED;
            } else {
            PG8_LDB(B0, 0, 0); PG8_SCHED; PG8_LDA(At, 0, 0); PG8_STAGE_A(PG8_SA(1, 1), a1, 1, voffG);
            PG8_WAIT_L(8); PG8_BAR; PG8_WAIT_L(0); PG8_MMA(0, 0, At, B0); PG8_BAR; PG8_SCHED;
            PG8_LDB(B1, 0, 1); PG8_STAGE(PG8_SB(0, 0), b2, voffB);
            PG8_BAR; PG8_WAIT_L(0); PG8_MMA(0, 1, At, B1); PG8_BAR;
            PG8_LDA(At, 0, 1); PG8_STAGE_A(PG8_SA(0, 0), a2, 0, og2);
            PG8_BAR; PG8_WAIT_L(0); PG8_MMA(1, 0, At, B0); PG8_BAR; PG8_SCHED;
            PG8_STAGE(PG8_SB(0, 1), b2 + hstep, voffB);
            PG8_WAIT_V(6); PG8_BAR; PG8_MMA(1, 1, At, B1); PG8_BAR;
            PG8_LDB(B0, 1, 0); PG8_SCHED; PG8_LDA(At, 1, 0); PG8_STAGE_A(PG8_SA(0, 1), a2, 1, og2);
            PG8_WAIT_L(8); PG8_BAR; PG8_WAIT_L(0); PG8_MMA(0, 0, At, B0); PG8_BAR; PG8_SCHED;
            PG8_LDB(B1, 1, 1); PG8_STAGE(PG8_SB(1, 0), b3, voffB);
            PG8_BAR; PG8_WAIT_L(0); PG8_MMA(0, 1, At, B1); PG8_BAR;
            PG8_LDA(At, 1, 1); PG8_STAGE_A(PG8_SA(1, 0), a3, 0, og2);
            PG8_BAR; PG8_WAIT_L(0); PG8_MMA(1, 0, At, B0); PG8_BAR; PG8_SCHED;
            PG8_STAGE(PG8_SB(1, 1), b3 + hstep, voffB);
            PG8_WAIT_V(6); PG8_BAR; PG8_MMA(1, 1, At, B1); PG8_BAR;
            }
        }
        if constexpr (ALIGN_EPI) { if (wr == 0) PG8_BAR; }
        E(acc, cur, wr, wc, fr, fq);
        if (!has_next) break;
#pragma unroll
        for (int a = 0; a < 2; ++a)
#pragma unroll
            for (int b = 0; b < 2; ++b)
#pragma unroll
                for (int m = 0; m < 4; ++m)
#pragma unroll
                    for (int n = 0; n < 2; ++n) acc[a][b][m][n] = (f32x4){0.f, 0.f, 0.f, 0.f};
        cur = nxt; cA = nA; cB = nB; ++ui;
        if constexpr (GATHER) {
#pragma unroll
            for (int h = 0; h < 2; ++h)
#pragma unroll
                for (int i = 0; i < 2; ++i) voffG[h][i] = voffGn[h][i]; }
        if constexpr (ALIGN_EPI) { if (wr == 1) PG8_BAR; }
    }
    PG8_WAIT_V(0);
    if constexpr (!ALIGN_EPI) { if (wr == 0) PG8_BAR; }
    PG8_BAR;
    (void)stR; (void)stC;
#undef PG8_SA
#undef PG8_SB
#undef PG8_STAGE
#undef PG8_STAGE_A
#undef PG8_LDA
#undef PG8_LDB
#undef PG8_MMA
#undef PG8_WAIT_V
#undef PG8_WAIT_L
#undef PG8_BAR
#undef PG8_SCHED
}
}
#ifndef MK_SP2
#define MK_SP2 true
#endif
#ifndef MK_ALIGN
#define MK_ALIGN true
#endif

constexpr int NWAVES = 8;
constexpr int RING_BYTES = 131072;
constexpr int MISC_OFF = RING_BYTES;
constexpr int LDS_BYTES = 147456;
constexpr int CW_BAR = 4096;
constexpr size_t WS_WRT = 4 * MiB;

typedef GAS unsigned gu32;
#define RLX_AGENT __ATOMIC_RELAXED, __HIP_MEMORY_SCOPE_AGENT
#define LDS_WAIT() asm volatile("s_waitcnt lgkmcnt(0)" ::: "memory")
#define VM_WAIT() asm volatile("s_waitcnt vmcnt(0)" ::: "memory")
__device__ __forceinline__ unsigned pk2(float lo, float hi) { return f2bf(lo) | (f2bf(hi) << 16); }

#define XB_TMO      128
#define XB_XCNT(j)  (256  + 64 * (j))
#define XB_XSUB(j)  (1280 + 64 * (j))
#define XB_XGEN(j)  (2304 + 64 * (j))
#define XB_TOP      3328
#define XB_TOPGEN   3392
#define XCD_BAR_WORDS 3456
#define XB_SPIN_CAP (1u << 18)
__device__ __forceinline__ unsigned xb_ld(unsigned* p)              { return __hip_atomic_load(p, __ATOMIC_RELAXED, __HIP_MEMORY_SCOPE_AGENT); }
__device__ __forceinline__ unsigned xb_add(unsigned* p, unsigned v) { return __hip_atomic_fetch_add(p, v, __ATOMIC_RELAXED, __HIP_MEMORY_SCOPE_AGENT); }
__device__ __forceinline__ unsigned xb_xcc_id() { return (unsigned)__builtin_amdgcn_s_getreg((3 << 11) | 20) & 0xFu; }
#define XB_SPIN(cond, bar) do { unsigned _sp = 0; while (cond) { __builtin_amdgcn_s_sleep(1); \
    if ((++_sp & 255u) == 0u) { if (xb_ld(&(bar)[XB_TMO])) break; if (_sp > XB_SPIN_CAP) { atomicAdd(&(bar)[XB_TMO], 1u); break; } } } } while (0)
struct XcdBarrier { unsigned* bar; unsigned x; volatile LAS unsigned* st; };
__device__ __forceinline__ XcdBarrier xcd_barrier_post(unsigned* bar, volatile LAS unsigned* st) {
    XcdBarrier b; b.bar = bar; b.x = xb_xcc_id(); b.st = st;
    if (threadIdx.x == 0) (void)xb_add(&bar[XB_XCNT(b.x)], 1u);
    return b;
}
__device__ __forceinline__ void xcd_barrier_complete(unsigned* bar, unsigned x, unsigned& nloc, unsigned& nx) {
    const unsigned G = gridDim.x * gridDim.y * gridDim.z;
    unsigned sum, cnt, mine, sp = 0u;
    for (;;) {
        sum = 0u; cnt = 0u; mine = 0u;
#pragma unroll
        for (unsigned j = 0; j < 16; ++j) { const unsigned c = xb_ld(&bar[XB_XCNT(j)]); sum += c; cnt += (c > 0u) ? 1u : 0u; mine = (j == x) ? c : mine; }
        if (sum == G) break;
        __builtin_amdgcn_s_sleep(1);
        if ((++sp & 255u) == 0u) { if (xb_ld(&bar[XB_TMO])) break; if (sp > XB_SPIN_CAP) { atomicAdd(&bar[XB_TMO], 1u); break; } }
    }
    nloc = mine > 0u ? mine : 1u; nx = cnt > 0u ? cnt : 1u;
}
__device__ __forceinline__ void xcd_barrier(const XcdBarrier& b) {
    asm volatile("s_waitcnt vmcnt(0)" ::: "memory");
    __syncthreads();
    if (threadIdx.x == 0) {
        unsigned* bar = b.bar;
        __builtin_amdgcn_s_waitcnt(0);
        unsigned nloc = b.st[0], nx = b.st[1];
        if (nloc == 0u) { xcd_barrier_complete(bar, b.x, nloc, nx); b.st[0] = nloc; b.st[1] = nx; }
        const unsigned old = xb_add(&bar[XB_XSUB(b.x)], 1u);
        const unsigned gen = old / nloc;
        if (old + 1u == (gen + 1u) * nloc) {
            __builtin_amdgcn_fence(__ATOMIC_RELEASE, "agent");
            asm volatile("s_waitcnt vmcnt(0)" ::: "memory");
            const unsigned og = xb_add(&bar[XB_TOP], 1u);
            const unsigned tg = og / nx;
            if (og + 1u == (tg + 1u) * nx) xb_add(&bar[XB_TOPGEN], 1u);
            else XB_SPIN(xb_ld(&bar[XB_TOPGEN]) == tg, bar);
            __builtin_amdgcn_fence(__ATOMIC_ACQUIRE, "agent");
            xb_add(&bar[XB_XGEN(b.x)], 1u);
            asm volatile("s_waitcnt vmcnt(0)" ::: "memory");
        } else {
            XB_SPIN(xb_ld(&bar[XB_XGEN(b.x)]) == gen, bar);
            __builtin_amdgcn_fence(__ATOMIC_ACQUIRE, "agent");
            asm volatile("s_waitcnt vmcnt(0)" ::: "memory");
        }
    }
    __syncthreads();
}

struct Frame {
    LAS unsigned char* lds; volatile LAS unsigned* MISC;
    int tid, lane, wave, vcu, G;
    const float* const* in; float* out; unsigned char* ws;
};
__device__ __forceinline__ float wave_sum(float v) {
#pragma unroll
    for (int o = 1; o < 64; o <<= 1) v += __shfl_xor(v, o);
    return v;
}

__device__ __forceinline__ void p0_transpose_item(const float* W, int K, int N, bf16_t* WT, int mode, LAS float* scr, int item, int lane) {
    const int nblk = N / 32, kb = item / nblk, nb = item % nblk, k0 = 64 * kb, n0 = 32 * nb;
#pragma unroll 8
    for (int i = 0; i < 32; ++i) { const int kk = 2 * i + (lane >> 5); scr[kk * 33 + (lane & 31)] = W[(size_t)(k0 + kk) * N + n0 + (lane & 31)]; }
    LDS_WAIT(); asm volatile("" ::: "memory");
    const int c = lane & 7; const int d0 = dst_row(n0, mode);
#pragma unroll
    for (int j = 0; j < 4; ++j) { const int n = (lane >> 3) + 8 * j; const LAS float* s = scr + (8 * c) * 33 + n;
        u32x4 o; o.x = pk2(s[0 * 33], s[1 * 33]); o.y = pk2(s[2 * 33], s[3 * 33]); o.z = pk2(s[4 * 33], s[5 * 33]); o.w = pk2(s[6 * 33], s[7 * 33]);
        *(u32x4*)(WT + (size_t)(d0 + n) * K + k0 + 8 * c) = o; }
    LDS_WAIT(); asm volatile("" ::: "memory");
}
__device__ __forceinline__ void p0_prologue(Frame& F) {
    LAS float* scr = (LAS float*)(F.lds + F.wave * 16384);
    const int gw = F.vcu * NWAVES + F.wave, NGW = F.G * NWAVES, lane = F.lane;
    unsigned char* ws = F.ws;
    { const float* g = F.in[1]; const float* b = F.in[2]; bf16_t* H0 = (bf16_t*)(ws + WS_H0); float* stat = (float*)(ws + WS_STAT0);
      for (int m = gw; m < M; m += NGW) {
        const f32x4* xr = (const f32x4*)(F.in[0] + (size_t)m * D) + lane;
        f32x4 v[8]; float s = 0.f;
#pragma unroll
        for (int j = 0; j < 8; ++j) { v[j] = xr[64 * j]; s += (v[j].x + v[j].y) + (v[j].z + v[j].w); }
        const float mean = wave_sum(s) * (1.f / D); float s2 = 0.f;
#pragma unroll
        for (int j = 0; j < 8; ++j) { v[j] = v[j] - mean; s2 += (v[j].x * v[j].x + v[j].y * v[j].y) + (v[j].z * v[j].z + v[j].w * v[j].w); }
        const float rstd = 1.f / sqrtf(wave_sum(s2) * (1.f / D) + LN_EPS);
        u32x2* o8 = (u32x2*)(H0 + (size_t)m * D) + lane;
#pragma unroll
        for (int j = 0; j < 8; ++j) { const f32x4 g4 = ((const f32x4*)g)[lane + 64 * j], b4 = ((const f32x4*)b)[lane + 64 * j]; const f32x4 h = v[j] * rstd * g4 + b4;
            u32x2 w; w.x = pk2(h.x, h.y); w.y = pk2(h.z, h.w); o8[64 * j] = w; }
        if (lane == 0) { stat[2 * m] = mean; stat[2 * m + 1] = rstd; }
      } }
    { float* wrt = (float*)(ws + WS_WRT);
      for (int i = gw * 64 + lane; i < 48 * D; i += NGW * 64) { const int o = i / D, k = i % D; wrt[i] = o < 4 ? F.in[18][k * 4 + o] : (o < 36 ? F.in[20][k * 32 + (o - 4)] : 0.f); } }
    constexpr int I_IN = (D / 64) * (4096 / 32), I_OUT = (D / 64) * (D / 32), I_G = (D / 64) * (FF / 32), I_D = (FF / 64) * (D / 32), I_E = 2 * I_G + I_D;
    constexpr int NITEMS = I_IN + I_OUT + NEXP * I_E;
    for (int it = gw; it < NITEMS; it += NGW) {
        int r = it;
        if (r < I_IN) { p0_transpose_item(F.in[3], D, 4096, (bf16_t*)(ws + WS_BT1), 1, scr, r, lane); continue; } r -= I_IN;
        if (r < I_OUT) { p0_transpose_item(F.in[15], D, D, (bf16_t*)(ws + WS_BT2), 0, scr, r, lane); continue; } r -= I_OUT;
        const int e = r / I_E; r -= e * I_E;
        bf16_t* btu = (bf16_t*)(ws + WS_BTU) + (size_t)e * 1024 * D; bf16_t* btd = (bf16_t*)(ws + WS_BTD) + (size_t)e * D * FF;
        if (r < I_G) { p0_transpose_item(F.in[22] + (size_t)e * D * FF, D, FF, btu, 2, scr, r, lane); continue; } r -= I_G;
        if (r < I_G) { p0_transpose_item(F.in[23] + (size_t)e * D * FF, D, FF, btu, 3, scr, r, lane); continue; } r -= I_G;
        p0_transpose_item(F.in[24] + (size_t)e * FF * D, FF, D, btd, 0, scr, r, lane);
    }
}

struct EpiZ {
    static constexpr bool PERM = true;
    bf16_t* Z;
    __device__ __forceinline__ void operator()(const f32x4 (&acc)[2][2][4][2], const pg8::Unit& u, int wr, int wc, int fr, int fq) const {
        const int row0 = u.pm * 256 + wr * 64 + fr;
        if (u.pn < 8) {
            const int col0 = u.pn * 256 + wc * 32 + 8 * fq; const bool act = u.pn >= 4;
#pragma unroll
            for (int ai = 0; ai < 2; ++ai)
#pragma unroll
                for (int m = 0; m < 4; ++m) { bf16_t* rowp = Z + (size_t)(row0 + ai * 128 + m * 16) * NZ + col0;
#pragma unroll
                    for (int bj = 0; bj < 2; ++bj) { f32x4 v0 = acc[ai][bj][m][0], v1 = acc[ai][bj][m][1];
                        if (act) {
#pragma unroll
                            for (int j = 0; j < 4; ++j) { v0[j] = gelu_tanh(v0[j]); v1[j] = gelu_tanh(v1[j]); } }
                        u32x4 w; w.x = pg8::cvt_pk_bf16(v0[0], v0[1]); w.y = pg8::cvt_pk_bf16(v0[2], v0[3]); w.z = pg8::cvt_pk_bf16(v1[0], v1[1]); w.w = pg8::cvt_pk_bf16(v1[2], v1[3]);
                        *(u32x4*)(rowp + bj * 128) = w; } }
        } else {
            const int col0 = 2048 + 128 * (u.pn - 8) + wc * 32 + 8 * fq;
#pragma unroll
            for (int ai = 0; ai < 2; ++ai)
#pragma unroll
                for (int m = 0; m < 4; ++m) { bf16_t* rowp = Z + (size_t)(row0 + ai * 128 + m * 16) * NZ + col0;
                    f32x4 v0 = acc[ai][0][m][0], v1 = acc[ai][0][m][1]; const f32x4 g0 = acc[ai][1][m][0], g1 = acc[ai][1][m][1];
#pragma unroll
                    for (int j = 0; j < 4; ++j) { v0[j] = v0[j] * sigmoidf_(g0[j]); v1[j] = v1[j] * sigmoidf_(g1[j]); }
                    u32x4 w; w.x = pg8::cvt_pk_bf16(v0[0], v0[1]); w.y = pg8::cvt_pk_bf16(v0[2], v0[3]); w.z = pg8::cvt_pk_bf16(v1[0], v1[1]); w.w = pg8::cvt_pk_bf16(v1[2], v1[3]);
                    *(u32x4*)rowp = w; }
        }
    }
};
struct EpiY1 {
    static constexpr bool PERM = false;
    float* Y1; const float* x; const float* stat0; const float* g; const float* b;
    __device__ __forceinline__ void operator()(const f32x4 (&acc)[2][2][4][2], const pg8::Unit& u, int wr, int wc, int fr, int fq) const {
        const int row0 = u.pm * 256 + wr * 64 + fr, col0 = u.pn * 256 + wc * 32 + 4 * fq;
        f32x4 gv[2][2], bv[2][2];
#pragma unroll
        for (int bj = 0; bj < 2; ++bj)
#pragma unroll
            for (int n = 0; n < 2; ++n) { gv[bj][n] = *(const f32x4*)(g + col0 + bj * 128 + n * 16) * ALPHA; bv[bj][n] = *(const f32x4*)(b + col0 + bj * 128 + n * 16) * ALPHA; }
#pragma unroll
        for (int ai = 0; ai < 2; ++ai)
#pragma unroll
            for (int m = 0; m < 4; ++m) { const int r = row0 + ai * 128 + m * 16; const float mean = stat0[2 * r], rstd = stat0[2 * r + 1]; const size_t off = (size_t)r * D + col0;
#pragma unroll
                for (int bj = 0; bj < 2; ++bj)
#pragma unroll
                    for (int n = 0; n < 2; ++n) { const f32x4 xv = *(const f32x4*)(x + off + bj * 128 + n * 16);
                        *(f32x4*)(Y1 + off + bj * 128 + n * 16) = acc[ai][bj][m][n] + ((xv - mean) * rstd) * gv[bj][n] + bv[bj][n]; }
                asm volatile("" ::: "memory"); }
    }
};


template <int SH> __device__ __forceinline__ float row_shr(float v, float ident) {
    return __int_as_float(__builtin_amdgcn_update_dpp(__float_as_int(ident), __float_as_int(v), 0x110 + SH, 0xF, 0xF, false)); }
__device__ __forceinline__ float bcast15(float v) { return __int_as_float(__builtin_amdgcn_ds_swizzle(__float_as_int(v), 0x1F0)); }
__device__ __forceinline__ float bflo(unsigned x) { return __uint_as_float(x << 16); }
__device__ __forceinline__ float bfhi(unsigned x) { return __uint_as_float(x & 0xffff0000u); }
#define SCAN_STEP(SH) do { const float pp = row_shr<SH>(p, 1.0f), hp = row_shr<SH>(h, 0.0f); h = p * hp + h; p = p * pp; } while (0)
__device__ __forceinline__ void lru_unit(Frame& F, int unit) {
    const int b = unit >> 7, hd = (unit >> 3) & 15, s = unit & 7;
    const int lane = F.lane, wave = F.wave, fr = lane & 15, fq = lane >> 4;
    const float* w4 = F.in[4]; const float* b4 = F.in[5]; const float* wa = F.in[6]; const float* ba = F.in[7]; const float* wx = F.in[8]; const float* bx = F.in[9]; const float* lam = F.in[10];
    const bf16_t* ZP = (const bf16_t*)(F.ws + WS_ZP); bf16_t* MIX = (bf16_t*)(F.ws + WS_MIX);
    bf16x8 Afr[8];
    {
        const int gsel = (fr >> 1) & 1, ch = 2 * (fr >> 2) + (fr & 1);
        const float* Wg = (gsel ? wx : wa) + (size_t)hd * 4096 + 8 * s + ch;
#pragma unroll
        for (int ks = 0; ks < 8; ++ks) { const int j = ks >> 1, cb = 32 * (ks & 1) + 8 * fq; float v[8];
#pragma unroll
            for (int jj = 0; jj < 8; ++jj) { const int c = cb + jj; v[jj] = w4[j * DL + 64 * hd + c] * Wg[c * 64]; }
            u32x4 w; w.x = pk2(v[0], v[1]); w.y = pk2(v[2], v[3]); w.z = pk2(v[4], v[5]); w.w = pk2(v[6], v[7]);
            Afr[ks] = __builtin_bit_cast(bf16x8, w); }
    }
    float gb[4];
#pragma unroll
    for (int reg = 0; reg < 4; ++reg) { const int gsel = reg >> 1, ch = 2 * fq + (reg & 1); const float* Wg = (gsel ? wx : wa) + (size_t)hd * 4096 + 8 * s + ch;
        float a = 0.f;
#pragma unroll
        for (int i = 0; i < 4; ++i) { const int c = 4 * fr + i; a += b4[64 * hd + c] * Wg[c * 64]; }
        a += __shfl_xor(a, 1); a += __shfl_xor(a, 2); a += __shfl_xor(a, 4); a += __shfl_xor(a, 8);
        gb[reg] = a + (gsel ? bx : ba)[64 * hd + 8 * s + ch]; }
    float sp8[2], w4c[4][2], b4c[2];
#pragma unroll
    for (int e = 0; e < 2; ++e) { const int cch = 64 * hd + 8 * s + 2 * fq + e; const float l = lam[cch]; sp8[e] = 8.0f * ((-l > 20.f) ? -l : log1pf(expf(-l))); b4c[e] = b4[cch];
#pragma unroll
        for (int j = 0; j < 4; ++j) w4c[j][e] = w4[j * DL + cch]; }
    float carryH[2] = {0.f, 0.f};
    LAS float* tot = (LAS float*)F.lds;
    LAS unsigned char* tile = F.lds + 1024 + wave * 12544;
    LAS unsigned char* otile = tile + 10368;
    const bf16_t* zx = ZP + (size_t)b * SEQ * NZ + 64 * hd + 8 * (lane & 7);
    const bf16_t* zg = ZP + (size_t)b * SEQ * NZ + 1024 + 64 * hd + 8 * s;
    u32x4 pf[9], pg;
#define LRU_ISSUE(ck_) do { const int tb_ = 512 * (ck_) + 64 * wave; \
        _Pragma("unroll") for (int i = 0; i < 9; ++i) { const int t_ = tb_ - 3 + 8 * i + (lane >> 3); const int tc_ = t_ < 0 ? 0 : (t_ > SEQ - 1 ? SEQ - 1 : t_); \
            const u32x4 v_ = *(const u32x4*)(zx + (size_t)tc_ * NZ); pf[i] = t_ >= 0 ? v_ : (u32x4){0u, 0u, 0u, 0u}; } \
        pg = *(const u32x4*)(zg + (size_t)(tb_ + lane) * NZ); } while (0)
    LRU_ISSUE(0);
#pragma unroll 1
    for (int ck = 0; ck < 8; ++ck) {
        const int tb = 512 * ck + 64 * wave;
#pragma unroll
        for (int i = 0; i < 9; ++i) *(LAS u32x4*)(tile + (8 * i + (lane >> 3)) * 144 + 16 * (lane & 7)) = pf[i];
        const u32x4 gcur = pg;
        if (ck < 7) LRU_ISSUE(ck + 1);
        f32x4 Dm[4];
#pragma unroll
        for (int m = 0; m < 4; ++m) { Dm[m] = (f32x4){0.f, 0.f, 0.f, 0.f};
#pragma unroll
            for (int ks = 0; ks < 8; ++ks) { const bf16x8 bfr = *(const LAS bf16x8*)(tile + (16 * m + fr + (ks >> 1)) * 144 + (32 * (ks & 1) + 8 * fq) * 2);
                Dm[m] = __builtin_amdgcn_mfma_f32_16x16x32_bf16(Afr[ks], bfr, Dm[m], 0, 0, 0); } }
        float P[4][2], Hh[4][2];
#pragma unroll
        for (int m = 0; m < 4; ++m) {
            float ain[2] = {b4c[0], b4c[1]};
#pragma unroll
            for (int j = 0; j < 4; ++j) { const unsigned xw = *(const LAS unsigned*)(tile + (16 * m + fr + j) * 144 + (8 * s + 2 * fq) * 2);
                ain[0] += w4c[j][0] * bflo(xw); ain[1] += w4c[j][1] * bfhi(xw); }
#pragma unroll
            for (int e = 0; e < 2; ++e) { const float r = sigmoidf_(Dm[m][e] + gb[e]), ig = sigmoidf_(Dm[m][2 + e] + gb[2 + e]);
                const float la = -r * sp8[e], a = __expf(la), x2 = 2.0f * la;
                const float om = (x2 > -0.25f) ? -x2 * (1.0f + x2 * (0.5f + x2 * (0.16666667f + x2 * (0.041666668f + x2 * 0.0083333338f)))) : 1.0f - a * a;
                P[m][e] = a; Hh[m][e] = sqrtf(om) * (ig * ain[e]); } }
        float cP[2] = {1.f, 1.f}, cH[2] = {0.f, 0.f};
#pragma unroll
        for (int m = 0; m < 4; ++m)
#pragma unroll
            for (int e = 0; e < 2; ++e) { float p = P[m][e], h = Hh[m][e];
                SCAN_STEP(1); SCAN_STEP(2); SCAN_STEP(4); SCAN_STEP(8);
                h = h + p * cH[e]; p = p * cP[e];
                P[m][e] = p; Hh[m][e] = h; cH[e] = bcast15(h); cP[e] = bcast15(p); }
        const int buf = ck & 1;
        if (fr == 0) {
#pragma unroll
            for (int e = 0; e < 2; ++e) { tot[((buf * 8 + wave) * 8 + 2 * fq + e) * 2 + 0] = cP[e]; tot[((buf * 8 + wave) * 8 + 2 * fq + e) * 2 + 1] = cH[e]; } }
        LDS_WAIT(); __syncthreads();
        float hin[2] = {carryH[0], carryH[1]}, hmine[2] = {0.f, 0.f};
#pragma unroll
        for (int w2 = 0; w2 < 8; ++w2) {
#pragma unroll
            for (int e = 0; e < 2; ++e) { if (w2 == wave) hmine[e] = hin[e];
                const float tp = tot[((buf * 8 + w2) * 8 + 2 * fq + e) * 2 + 0], th = tot[((buf * 8 + w2) * 8 + 2 * fq + e) * 2 + 1]; hin[e] = tp * hin[e] + th; } }
        carryH[0] = hin[0]; carryH[1] = hin[1];
#pragma unroll
        for (int m = 0; m < 4; ++m) *(LAS f32x2*)(otile + (16 * m + fr) * 32 + fq * 8) = (f32x2){Hh[m][0] + P[m][0] * hmine[0], Hh[m][1] + P[m][1] * hmine[1]};
        LDS_WAIT();
        const f32x4 h0 = *(const LAS f32x4*)(otile + lane * 32), h1 = *(const LAS f32x4*)(otile + lane * 32 + 16);
        u32x4 o; o.x = pk2(bflo(gcur.x) * h0.x, bfhi(gcur.x) * h0.y); o.y = pk2(bflo(gcur.y) * h0.z, bfhi(gcur.y) * h0.w);
        o.z = pk2(bflo(gcur.z) * h1.x, bfhi(gcur.z) * h1.y); o.w = pk2(bflo(gcur.w) * h1.z, bfhi(gcur.w) * h1.w);
        *(u32x4*)(MIX + ((size_t)b * SEQ + tb + lane) * D + 64 * hd + 8 * s) = o;
    }
#undef LRU_ISSUE
    __syncthreads();
}
#undef SCAN_STEP
__device__ __forceinline__ void conv31_unit(Frame& F, int unit) {
    constexpr int CT = 16;
    const int tid = F.tid, lane = F.lane, wave = F.wave, m0 = unit * 32, c2 = 2 * tid;
    const __amdgpu_buffer_rsrc_t rw = __builtin_amdgcn_make_buffer_rsrc((void*)F.in[11], 0, 31 * DC * 4, 0x00020000);
    const __amdgpu_buffer_rsrc_t rz = __builtin_amdgcn_make_buffer_rsrc((void*)(F.ws + WS_ZP), 0, M * NZ * 2, 0x00020000);
    bf16_t* MIX = (bf16_t*)(F.ws + WS_MIX);
    const f32x2 bs = *(const f32x2*)(F.in[12] + c2), g2 = *(const f32x2*)(F.in[13] + c2), b2 = *(const f32x2*)(F.in[14] + c2);
    LAS float* red = (LAS float*)(F.lds + 4096);
    LAS float* tot2 = (LAS float*)(F.lds + 4096 + 1024);
    f32x2 wj[31];
#pragma unroll
    for (int j = 0; j < 31; ++j) { const u32x2 t = __builtin_amdgcn_raw_buffer_load_b64(rw, c2 * 4, j * DC * 4, 0); wj[j] = __builtin_bit_cast(f32x2, t); }
#pragma unroll 1
    for (int pass = 0; pass < 32 / CT; ++pass) {
        const int tok0 = m0 + CT * pass, t0 = tok0 % SEQ;
        unsigned xin[CT + 30];
#pragma unroll
        for (int i = 0; i < CT + 30; ++i) { const int tt = t0 - 30 + i; const int row = tt >= 0 ? tok0 - 30 + i : tok0;
            const unsigned v = __builtin_amdgcn_raw_buffer_load_b32(rz, (2048 + c2) * 2, row * (NZ * 2), 0); xin[i] = tt >= 0 ? v : 0u; }
        float a0[CT], a1[CT];
#pragma unroll
        for (int o = 0; o < CT; ++o) { float x0 = bs.x, x1 = bs.y;
#pragma unroll
            for (int j = 0; j < 31; ++j) { x0 += wj[j].x * bflo(xin[o + j]); x1 += wj[j].y * bfhi(xin[o + j]); }
            a0[o] = x0; a1[o] = x1; }
#pragma unroll
        for (int o = 0; o < CT; ++o) { const float sm = wave_sum(a0[o] + a1[o]), sq = wave_sum(a0[o] * a0[o] + a1[o] * a1[o]);
            if (lane == 0) { red[(wave * CT + o) * 2] = sm; red[(wave * CT + o) * 2 + 1] = sq; } }
        LDS_WAIT(); __syncthreads();
        if (tid < 2 * CT) { float t = 0.f;
#pragma unroll
            for (int w2 = 0; w2 < 8; ++w2) t += red[w2 * 2 * CT + tid];
            tot2[tid] = t; }
        LDS_WAIT(); __syncthreads();
#pragma unroll
        for (int o = 0; o < CT; ++o) { const float mean = tot2[2 * o] * (1.0f / DC), var = tot2[2 * o + 1] * (1.0f / DC) - mean * mean, rstd = 1.0f / sqrtf(var + LN_EPS);
            const float y0 = silu_((a0[o] - mean) * rstd * g2.x + b2.x), y1 = silu_((a1[o] - mean) * rstd * g2.y + b2.y);
            *(unsigned*)(MIX + (size_t)(tok0 + o) * D + 1024 + c2) = pk2(y0, y1); }
        __syncthreads();
    }
}

__device__ __forceinline__ void router_unit(Frame& F, int unit, bool publish) {
    const int tid = F.tid, lane = F.lane, wave = F.wave, m0 = 32 * unit;
    const float* Y1 = (const float*)(F.ws + WS_Y1); const float* g1 = F.in[16]; const float* b1 = F.in[17]; const float* WRT = (const float*)(F.ws + WS_WRT);
    bf16_t* H1 = (bf16_t*)(F.ws + WS_H1); float* stat1 = (float*)(F.ws + WS_STAT1);
    LAS float* st = (LAS float*)F.lds;
    LAS float* part = (LAS float*)(F.lds + 1024);
    LAS float* lgt = (LAS float*)(F.lds + 1024 + 24576);
    for (int i = 0; i < 4; ++i) { const int m = m0 + 4 * wave + i;
        const f32x4* yr = (const f32x4*)(Y1 + (size_t)m * D) + lane;
        f32x4 v[8]; float s = 0.f;
#pragma unroll
        for (int j = 0; j < 8; ++j) { v[j] = yr[64 * j]; s += (v[j].x + v[j].y) + (v[j].z + v[j].w); }
        const float mean = wave_sum(s) * (1.f / D); float s2 = 0.f;
#pragma unroll
        for (int j = 0; j < 8; ++j) { v[j] = v[j] - mean; s2 += (v[j].x * v[j].x + v[j].y * v[j].y) + (v[j].z * v[j].z + v[j].w * v[j].w); }
        const float rstd = 1.f / sqrtf(wave_sum(s2) * (1.f / D) + LN_EPS);
        u32x2* o8 = (u32x2*)(H1 + (size_t)m * D) + lane;
#pragma unroll
        for (int j = 0; j < 8; ++j) { const f32x4 g4 = ((const f32x4*)g1)[lane + 64 * j], b4 = ((const f32x4*)b1)[lane + 64 * j]; const f32x4 h = v[j] * rstd * g4 + b4;
            u32x2 w; w.x = pk2(h.x, h.y); w.y = pk2(h.z, h.w); o8[64 * j] = w; }
        if (lane == 0) { stat1[2 * m] = mean; stat1[2 * m + 1] = rstd; st[(4 * wave + i) * 2] = mean; st[(4 * wave + i) * 2 + 1] = rstd; } }
    LDS_WAIT(); __syncthreads();
    {
        const int mt = wave & 1, kp = wave >> 1, i = lane & 15, q = lane >> 4;
        const float mean = st[(16 * mt + i) * 2], rstd = st[(16 * mt + i) * 2 + 1];
        const float* yr = Y1 + (size_t)(m0 + 16 * mt + i) * D + 512 * kp + 4 * q; const float* gp = g1 + 512 * kp + 4 * q; const float* bp = b1 + 512 * kp + 4 * q;
        const float* wp = WRT + (size_t)i * D + 512 * kp + 4 * q;
        f32x4 acc0 = (f32x4){0.f, 0.f, 0.f, 0.f}, acc1 = acc0, acc2 = acc0;
#pragma unroll 4
        for (int jj = 0; jj < 32; ++jj) {
            const f32x4 y4 = *(const f32x4*)(yr + 16 * jj), g4 = *(const f32x4*)(gp + 16 * jj), b4 = *(const f32x4*)(bp + 16 * jj);
            const f32x4 a4 = ((y4 - mean) * rstd) * g4 + b4;
            const f32x4 w0 = *(const f32x4*)(wp + 16 * jj), w1 = *(const f32x4*)(wp + 16 * D + 16 * jj), w2 = *(const f32x4*)(wp + 32 * D + 16 * jj);
#pragma unroll
            for (int c = 0; c < 4; ++c) { acc0 = __builtin_amdgcn_mfma_f32_16x16x4f32(a4[c], w0[c], acc0, 0, 0, 0); acc1 = __builtin_amdgcn_mfma_f32_16x16x4f32(a4[c], w1[c], acc1, 0, 0, 0);
                acc2 = __builtin_amdgcn_mfma_f32_16x16x4f32(a4[c], w2[c], acc2, 0, 0, 0); }
        }
#pragma unroll
        for (int reg = 0; reg < 4; ++reg) { LAS float* pr = part + ((kp * 32) + 16 * mt + 4 * q + reg) * 48 + i; pr[0] = acc0[reg]; pr[16] = acc1[reg]; pr[32] = acc2[reg]; }
    }
    LDS_WAIT(); __syncthreads();
    for (int idx = tid; idx < 32 * 36; idx += NWAVES * 64) { const int tok = idx / 36, o = idx % 36;
        float v = (o < 4 ? F.in[19][o] : F.in[21][o - 4]);
#pragma unroll
        for (int kp = 0; kp < 4; ++kp) v += part[(kp * 32 + tok) * 48 + o];
        lgt[tok * 36 + o] = v; }
    LDS_WAIT(); __syncthreads();
    if (tid < 32 && publish) {
        const int m = m0 + tid; const LAS float* lg = lgt + tid * 36;
        unsigned* cnt = (unsigned*)(F.ws + WS_CTL) + CW_CNT; int* list = (int*)(F.ws + WS_LIST); float* ql = (float*)(F.ws + WS_QL); unsigned* route = (unsigned*)(F.ws + WS_ROUTE);
        int gs = 0; for (int j = 1; j < 4; ++j) if (lg[j] > lg[gs]) gs = j;
        float den = 0.f; for (int j = 0; j < 4; ++j) den += expf(lg[j] - lg[gs]);
        const float pg = 1.0f / den;
        const LAS float* le = lg + 4 + 8 * gs; int i0 = 0; for (int j = 1; j < 8; ++j) if (le[j] > le[i0]) i0 = j;
        int i1 = (i0 == 0) ? 1 : 0; for (int j = 0; j < 8; ++j) if (j != i0 && le[j] > le[i1]) i1 = j;
        const float ex = expf(le[i1] - le[i0]); const float q0 = pg / (1.0f + ex), q1 = pg * ex / (1.0f + ex);
        const int e0 = gs * 8 + i0, e1 = gs * 8 + i1;
        const unsigned p0 = atomicAdd(&cnt[e0], 1u), p1 = atomicAdd(&cnt[e1], 1u);
        list[e0 * 8192 + p0] = m; ql[e0 * 8192 + p0] = q0; list[e1 * 8192 + p1] = m; ql[e1 * 8192 + p1] = q1;
        unsigned* r = route + (size_t)m * 8; r[0] = e0; r[1] = e1; r[2] = __float_as_uint(q0); r[3] = __float_as_uint(q1); r[4] = p0; r[5] = p1;
    }
    __syncthreads();
}

__device__ __forceinline__ const LAS int* moe_tables(Frame& F) {
    LAS int* tab = (LAS int*)(F.lds + MISC_OFF + 256);
    if (F.tid == 0) { unsigned* cnt = (unsigned*)(F.ws + WS_CTL) + CW_CNT; int run = 0;
        for (int e = 0; e < NEXP; ++e) { const int c = (int)__hip_atomic_load(cnt + e, RLX_AGENT); tab[e] = run; tab[40 + e] = run * 256; tab[80 + e] = c; run += (c + 255) >> 8; }
        tab[32] = run; }
    LDS_WAIT(); __syncthreads();
    return tab;
}
struct MoeOrder {
    const LAS int* tab; const char* A; const char* Bt; const int* list; int npn, G, c; bool up;
    __device__ bool next(int i, pg8::Unit& u) const {
        const int L = i * G + c; if (L >= tab[32] * npn) return false;
        const int tt = L / npn, pn = L % npn; int e = 0; while (tab[e + 1] <= tt) ++e;
        const int mt = tt - tab[e];
        u.e = e; u.mt = mt; u.pn = pn; u.pm = (tab[40 + e] >> 8) + mt;
        if (up) { u.a = A; u.b = Bt + ((size_t)(e * 1024 + pn * 256)) * D * 2; }
        else { u.a = A + (size_t)(tab[40 + e] + mt * 256) * FF * 2; u.b = Bt + ((size_t)(e * D + pn * 256)) * FF * 2; }
        return true;
    }
    __device__ __forceinline__ void gather(const pg8::Unit& u, const int (&stR)[2], const int (&stC)[2], unsigned (&voff)[2][2]) const {
        const int cnt = tab[80 + u.e];
#pragma unroll
        for (int h = 0; h < 2; ++h)
#pragma unroll
            for (int i = 0; i < 2; ++i) { int pos = u.mt * 256 + h * 128 + stR[i]; if (pos >= cnt) pos = 0;
                const int tok = list[u.e * 8192 + pos]; voff[h][i] = (unsigned)(tok * D + stC[i]) * 2u; }
    }
};
struct EpiH {
    static constexpr bool PERM = true;
    bf16_t* HH; const float* ql; const LAS int* tab;
    __device__ __forceinline__ void operator()(const f32x4 (&acc)[2][2][4][2], const pg8::Unit& u, int wr, int wc, int fr, int fq) const {
        const int cnt = tab[80 + u.e];
#pragma unroll
        for (int ai = 0; ai < 2; ++ai)
#pragma unroll
            for (int m = 0; m < 4; ++m) { const int rl = ai * 128 + wr * 64 + m * 16 + fr, lr = u.mt * 256 + rl;
                const float q = lr < cnt ? ql[u.e * 8192 + lr] : 0.f;
                f32x4 v0 = acc[ai][0][m][0], v1 = acc[ai][0][m][1]; const f32x4 u0 = acc[ai][1][m][0], u1 = acc[ai][1][m][1];
#pragma unroll
                for (int j = 0; j < 4; ++j) { v0[j] = silu_(v0[j]) * u0[j] * q; v1[j] = silu_(v1[j]) * u1[j] * q; }
                u32x4 w; w.x = pg8::cvt_pk_bf16(v0[0], v0[1]); w.y = pg8::cvt_pk_bf16(v0[2], v0[3]); w.z = pg8::cvt_pk_bf16(v1[0], v1[1]); w.w = pg8::cvt_pk_bf16(v1[2], v1[3]);
                *(u32x4*)(HH + (size_t)(u.pm * 256 + rl) * FF + 128 * u.pn + wc * 32 + 8 * fq) = w; }
    }
};
struct EpiYf {
    static constexpr bool PERM = true;
    bf16_t* YF;
    __device__ __forceinline__ void operator()(const f32x4 (&acc)[2][2][4][2], const pg8::Unit& u, int wr, int wc, int fr, int fq) const {
#pragma unroll
        for (int ai = 0; ai < 2; ++ai)
#pragma unroll
            for (int m = 0; m < 4; ++m) { bf16_t* rowp = YF + (size_t)(u.pm * 256 + ai * 128 + wr * 64 + m * 16 + fr) * D + u.pn * 256 + wc * 32 + 8 * fq;
#pragma unroll
                for (int bj = 0; bj < 2; ++bj) { const f32x4 v0 = acc[ai][bj][m][0], v1 = acc[ai][bj][m][1];
                    u32x4 w; w.x = pg8::cvt_pk_bf16(v0[0], v0[1]); w.y = pg8::cvt_pk_bf16(v0[2], v0[3]); w.z = pg8::cvt_pk_bf16(v1[0], v1[1]); w.w = pg8::cvt_pk_bf16(v1[2], v1[3]);
                    *(u32x4*)(rowp + bj * 128) = w; } }
    }
};

__device__ __forceinline__ void final_phase(Frame& F, const LAS int* tab) {
    const int gw = F.vcu * NWAVES + F.wave, NGW = F.G * NWAVES, lane = F.lane;
    const float* Y1 = (const float*)(F.ws + WS_Y1); const float* stat1 = (const float*)(F.ws + WS_STAT1); const unsigned* route = (const unsigned*)(F.ws + WS_ROUTE);
    const bf16_t* YF = (const bf16_t*)(F.ws + WS_YF); const float* g1 = F.in[16]; const float* b1 = F.in[17]; const float* g2 = F.in[25]; const float* b2 = F.in[26];
    for (int m = gw; m < M; m += NGW) {
        const unsigned* r = route + (size_t)m * 8;
        const int s0 = tab[40 + (int)r[0]] + (int)r[4], s1 = tab[40 + (int)r[1]] + (int)r[5];
        const float mean1 = stat1[2 * m], rstd1 = stat1[2 * m + 1];
        const f32x4* yr = (const f32x4*)(Y1 + (size_t)m * D) + lane;
        const u32x2* f0 = (const u32x2*)(YF + (size_t)s0 * D) + lane; const u32x2* f1 = (const u32x2*)(YF + (size_t)s1 * D) + lane;
        f32x4 v[8]; float s = 0.f;
#pragma unroll
        for (int j = 0; j < 8; ++j) { const f32x4 y = yr[64 * j], g4 = ((const f32x4*)g1)[lane + 64 * j], b4 = ((const f32x4*)b1)[lane + 64 * j];
            const u32x2 a = f0[64 * j], c = f1[64 * j];
            const f32x4 ff = (f32x4){bflo(a.x) + bflo(c.x), bfhi(a.x) + bfhi(c.x), bflo(a.y) + bflo(c.y), bfhi(a.y) + bfhi(c.y)};
            v[j] = (((y - mean1) * rstd1) * g4 + b4) * ALPHA + ff; s += (v[j].x + v[j].y) + (v[j].z + v[j].w); }
        const float mean = wave_sum(s) * (1.f / D); float s2 = 0.f;
#pragma unroll
        for (int j = 0; j < 8; ++j) { v[j] = v[j] - mean; s2 += (v[j].x * v[j].x + v[j].y * v[j].y) + (v[j].z * v[j].z + v[j].w * v[j].w); }
        const float rstd = 1.f / sqrtf(wave_sum(s2) * (1.f / D) + LN_EPS);
        f32x4* o = (f32x4*)(F.out + (size_t)m * D) + lane;
#pragma unroll
        for (int j = 0; j < 8; ++j) { const f32x4 g4 = ((const f32x4*)g2)[lane + 64 * j], b4 = ((const f32x4*)b2)[lane + 64 * j]; o[64 * j] = (v[j] * rstd) * g4 + b4; }
    }
}

#ifndef FAST_MASK
#define FAST_MASK 0xFF
#endif
#ifndef HOST_REP
#define HOST_REP -1
#endif
#ifndef REP_SUB
#define REP_SUB 1
#endif
#ifndef ONE_LAUNCH
#define ONE_LAUNCH 1
#endif
constexpr int NPHASE = 8;
__global__ void __launch_bounds__(NWAVES * 64, 2) mk(Args args) {
    extern __shared__ __attribute__((aligned(16))) unsigned char lds_raw[];
    Frame F;
    F.lds = (LAS unsigned char*)lds_raw; F.MISC = (volatile LAS unsigned*)(F.lds + MISC_OFF);
    F.tid = threadIdx.x; F.lane = F.tid & 63; F.wave = __builtin_amdgcn_readfirstlane(F.tid >> 6);
    F.G = gridDim.x; { const int bx = blockIdx.x; F.vcu = (F.G % 8 == 0) ? (bx % 8) * (F.G / 8) + bx / 8 : bx; }
    F.in = args.in; F.out = args.out; F.ws = args.ws;
    unsigned char* ws = args.ws;
    const int lo = args.ph_lo, hi = args.ph_hi;
    for (int u = F.tid; u < 64; u += NWAVES * 64) F.MISC[u] = 0u;
    __syncthreads();
    XcdBarrier bar; bar.bar = (unsigned*)(ws + WS_CTL) + CW_BAR + lo * XCD_BAR_WORDS; bar.x = 0; bar.st = nullptr;
    if (hi - lo > 1) bar = xcd_barrier_post((unsigned*)(ws + WS_CTL) + CW_BAR + lo * XCD_BAR_WORDS, F.MISC + 8);
#ifndef PH_EN
#define PH_EN 0xFF
#endif
#define IN(k) (((PH_EN >> (k)) & 1) && lo <= (k) && (k) < hi)
#define SEAM(k) do { if (IN(k) && IN((k) + 1)) xcd_barrier(bar); } while (0)

#ifndef REP_PHASE
#define REP_PHASE -1
#endif
#define REPS(k) for (int rep_ = 0; rep_ < ((REP_PHASE == (k)) ? 2 : 1); ++rep_)
#define REP_BAR(k) do { if (REP_PHASE == (k) && rep_ == 0 && hi - lo > 1) xcd_barrier(bar); } while (0)
    if (IN(0)) { REPS(0) { p0_prologue(F); REP_BAR(0); } SEAM(0); }
    if (IN(1)) {
        REPS(1) {
        pg8::DenseOrder S; S.init(ws + WS_H0, ws + WS_BT1, M, 4096, D, F.G, (int)blockIdx.x);
        EpiZ E{(bf16_t*)(ws + WS_ZP)};
        pg8::gemm_phase<EpiZ, pg8::DenseOrder, false, MK_ALIGN, MK_SP2>(F.lds, D, S, E);
        REP_BAR(1); }
        SEAM(1);
    }
    if (IN(2)) {
        REPS(2) {
        if (args.rep != 2) for (int u = F.vcu; u < 256; u += F.G) lru_unit(F, u);
        if (args.rep != 1) for (int u = F.vcu; u < 256; u += F.G) conv31_unit(F, u);
        REP_BAR(2); }
        SEAM(2);
    }
    if (IN(3)) {
        REPS(3) {
        pg8::DenseOrder S; S.init(ws + WS_MIX, ws + WS_BT2, M, D, D, F.G, (int)blockIdx.x);
        EpiY1 E{(float*)(ws + WS_Y1), F.in[0], (const float*)(ws + WS_STAT0), F.in[1], F.in[2]};
        pg8::gemm_phase<EpiY1, pg8::DenseOrder, false, MK_ALIGN, MK_SP2>(F.lds, D, S, E);
        REP_BAR(3); }
        SEAM(3);
    }
    if (IN(4)) {
        REPS(4) {
        for (int u = F.vcu; u < 256; u += F.G) router_unit(F, u, args.rep == 0);
        REP_BAR(4); }
        SEAM(4);
    }
    if (IN(5)) {
        REPS(5) {
        const LAS int* tab = moe_tables(F);
        MoeOrder S{tab, (const char*)(ws + WS_H1), (const char*)(ws + WS_BTU), (const int*)(ws + WS_LIST), 4, F.G, F.vcu, true};
        EpiH E{(bf16_t*)(ws + WS_HH), (const float*)(ws + WS_QL), tab};
        pg8::gemm_phase<EpiH, MoeOrder, true, MK_ALIGN, MK_SP2>(F.lds, D, S, E);
        REP_BAR(5); }
        SEAM(5);
    }
    if (IN(6)) {
        REPS(6) {
        const LAS int* tab = moe_tables(F);
        MoeOrder S{tab, (const char*)(ws + WS_HH), (const char*)(ws + WS_BTD), (const int*)(ws + WS_LIST), 8, F.G, F.vcu, false};
        EpiYf E{(bf16_t*)(ws + WS_YF)};
        pg8::gemm_phase<EpiYf, MoeOrder, false, MK_ALIGN, MK_SP2>(F.lds, FF, S, E);
        REP_BAR(6); }
        SEAM(6);
    }
    if (IN(7)) {
        REPS(7) {
        const LAS int* tab = moe_tables(F);
        final_phase(F, tab);
        REP_BAR(7); }
    }
#undef IN
#undef SEAM
}

extern "C" void kernel_launch(void* const* d_in, const int* in_sizes, int n_in, void* d_out, int out_size, void* d_ws, size_t ws_size, hipStream_t stream) {
    static int grid = 0;
    if (grid == 0) {
        if (n_in != 27 || in_sizes[0] != M * D || out_size != M * D || ws_size < WS_NEED) {
            fprintf(stderr, "kernel_launch: unexpected shapes (n_in %d, in0 %d, out %d, ws %zu); nothing launched\n", n_in, n_in > 0 ? in_sizes[0] : -1, out_size, ws_size); grid = -1; return; }
        int dev = 0, cus = 0, per_cu = 0;
        if (hipGetDevice(&dev) != hipSuccess || hipDeviceGetAttribute(&cus, hipDeviceAttributeMultiprocessorCount, dev) != hipSuccess) { grid = -1; return; }
        if (hipFuncSetAttribute((const void*)mk, hipFuncAttributeMaxDynamicSharedMemorySize, LDS_BYTES) != hipSuccess) { fprintf(stderr, "kernel_launch: hipFuncSetAttribute failed\n"); grid = -1; return; }
        if (hipOccupancyMaxActiveBlocksPerMultiprocessor(&per_cu, (const void*)mk, NWAVES * 64, LDS_BYTES) != hipSuccess || per_cu < 1) { fprintf(stderr, "kernel_launch: occupancy query says %d blocks per CU\n", per_cu); (void)hipGetLastError(); grid = -1; return; }
        grid = cus;
    }
    if (grid < 0) return;
    const float* const* in = (const float* const*)d_in;
    unsigned char* ws = (unsigned char*)d_ws;
    (void)hipMemsetAsync(ws + WS_CTL, 0, CTL_ZERO_BYTES, stream);
    float* stat0 = (float*)(ws + WS_STAT0); float* stat1 = (float*)(ws + WS_STAT1); unsigned* route = (unsigned*)(ws + WS_ROUTE);
    int* list = (int*)(ws + WS_LIST); float* ql = (float*)(ws + WS_QL); unsigned* cnt = (unsigned*)(ws + WS_CTL) + CW_CNT;
    bf16_t* H0 = (bf16_t*)(ws + WS_H0); bf16_t* ZP = (bf16_t*)(ws + WS_ZP); bf16_t* MIX = (bf16_t*)(ws + WS_MIX); float* Y1 = (float*)(ws + WS_Y1);
    bf16_t* H1 = (bf16_t*)(ws + WS_H1); bf16_t* HH = (bf16_t*)(ws + WS_HH); bf16_t* YF = (bf16_t*)(ws + WS_YF);
    float* ZRAW = (float*)(ws + WS_ZRAW); float* AIN = (float*)(ws + WS_AIN); float* ADEC = (float*)(ws + WS_ADEC); float* U = (float*)(ws + WS_U);
    Args a{};
    for (int i = 0; i < 27; ++i) a.in[i] = in[i];
    a.out = (float*)d_out; a.ws = ws;
    for (int p = 0; p < NPHASE;) {
        if ((FAST_MASK >> p) & 1) {
            int q = p + 1;
            if (ONE_LAUNCH) while (q < NPHASE && ((FAST_MASK >> q) & 1) && q != HOST_REP && (q - 1) != HOST_REP) ++q;
            a.ph_lo = p; a.ph_hi = q;
            hipLaunchKernelGGL(mk, dim3(grid), dim3(NWAVES * 64), LDS_BYTES, stream, a);
            if (p == HOST_REP) { a.rep = REP_SUB; hipLaunchKernelGGL(mk, dim3(grid), dim3(NWAVES * 64), LDS_BYTES, stream, a); a.rep = 0; }
            p = q; continue;
        }
        switch (p) {
        case 0:
            nv_ln_in<<<M, 256, 0, stream>>>(in[0], in[1], in[2], H0, stat0);
            break;
        case 1:
            nv_gemm<<<dim3(4096 / 64, M / 64), 256, 0, stream>>>(H0, in[3], ZRAW, M, 4096, D);
            nv_zprime<<<(unsigned)(((size_t)M * NZ + 255) / 256), 256, 0, stream>>>(ZRAW, ZP);
            break;
        case 2:
            nv_lru1<<<(M * DL + 255) / 256, 256, 0, stream>>>(ZP, in[4], in[5], AIN);
            nv_lru2<<<(M * DL + 255) / 256, 256, 0, stream>>>(AIN, in[6], in[7], in[8], in[9], in[10], ADEC, U);
            nv_lru3<<<(2 * DL + 255) / 256, 256, 0, stream>>>(ADEC, U, ZP, MIX);
            nv_conv31<<<M, 256, 0, stream>>>(ZP, in[11], in[12], in[13], in[14], MIX);
            break;
        case 3:
            nv_gemm<<<dim3(D / 64, M / 64), 256, 0, stream>>>(MIX, in[15], Y1, M, D, D);
            nv_y1<<<(unsigned)(((size_t)M * D + 255) / 256), 256, 0, stream>>>(Y1, in[0], stat0, in[1], in[2]);
            break;
        case 4:
            nv_router<<<M, 256, 0, stream>>>(Y1, in[16], in[17], in[18], in[19], in[20], in[21], H1, stat1, route, cnt, list, ql);
            break;
        case 5:
            nv_moe_up<<<2 * M, 512, 0, stream>>>(H1, route, cnt, in[22], in[23], HH);
            break;
        case 6:
            nv_moe_down<<<2 * M, 512, 0, stream>>>(HH, route, cnt, in[24], YF);
            break;
        case 7:
            nv_final<<<M, 256, 0, stream>>>(Y1, stat1, in[16], in[17], route, cnt, YF, in[25], in[26], (float*)d_out);
            break;
        }
        ++p;
    }
}
```

```cpp
#include <hip/hip_runtime.h>
#include <cstdio>
#include <cstdint>

constexpr int D = 2048, SEQ = 4096, M = 8192;
constexpr int DL = 1024, DC = 1024, NH = 16, HDIM = 64;
constexpr int NGRP = 4, NEXPG = 8, NEXP = 32, FF = 512;
constexpr int NZ = 3072;
constexpr float LN_EPS = 1e-5f;
constexpr float ALPHA = 1.189207115002721f;
constexpr int SLOT_ROWS = 24576;

typedef unsigned short bf16_t;
typedef float f32x4 __attribute__((ext_vector_type(4)));
typedef float f32x2 __attribute__((ext_vector_type(2)));
typedef short bf16x8 __attribute__((ext_vector_type(8)));
typedef unsigned u32x4 __attribute__((ext_vector_type(4)));
typedef unsigned u32x2 __attribute__((ext_vector_type(2)));

constexpr size_t MiB = 1u << 20;
constexpr size_t WS_CTL = 0, CTL_ZERO_BYTES = 1 * MiB;
constexpr size_t WS_STAT0 = 1 * MiB;
constexpr size_t WS_STAT1 = 1 * MiB + 65536;
constexpr size_t WS_ROUTE = 1 * MiB + 131072;
constexpr size_t WS_LIST = 2 * MiB;
constexpr size_t WS_QL = 3 * MiB;
constexpr size_t WS_BT1 = 8 * MiB;
constexpr size_t WS_BT2 = 24 * MiB;
constexpr size_t WS_BTU = 32 * MiB;
constexpr size_t WS_BTD = 160 * MiB;
constexpr size_t WS_Y1 = 224 * MiB;
constexpr size_t WS_H0 = 288 * MiB;
constexpr size_t WS_ZP = 320 * MiB;
constexpr size_t WS_MIX = 368 * MiB;
constexpr size_t WS_H1 = 288 * MiB;
constexpr size_t WS_HH = 320 * MiB;
constexpr size_t WS_YF = 344 * MiB;
constexpr size_t WS_ZRAW = 368 * MiB;
constexpr size_t WS_AIN = 400 * MiB;
constexpr size_t WS_ADEC = 440 * MiB;
constexpr size_t WS_U = 472 * MiB;
constexpr size_t WS_NEED = 504 * MiB;
constexpr int CW_CNT = 1024;

struct Args { const float* in[27]; float* out; unsigned char* ws; int ph_lo, ph_hi, rep, pad; };

__device__ __forceinline__ float bf2f(bf16_t v) { return __uint_as_float((unsigned)v << 16); }
__device__ __forceinline__ unsigned f2bf(float f) { unsigned u = __float_as_uint(f); return (u + 0x7fffu + ((u >> 16) & 1u)) >> 16; }
__device__ __forceinline__ float frcp_(float x) { return __builtin_amdgcn_rcpf(x); }
__device__ __forceinline__ float fexp_(float x) { return __builtin_amdgcn_exp2f(1.4426950408889634f * x); }
__device__ __forceinline__ float fsqrt_(float x) { return __builtin_amdgcn_sqrtf(x); }
__device__ __forceinline__ float frsq_(float x) { return __builtin_amdgcn_rsqf(x); }
__device__ __forceinline__ float sigmoidf_(float x) { return frcp_(1.0f + __builtin_amdgcn_exp2f(-1.4426950408889634f * x)); }
__device__ __forceinline__ float gelu_tanh(float x) { const float u = 1.5957691216057308f * (x + 0.044715f * x * x * x); return x * sigmoidf_(u); }
__device__ __forceinline__ float silu_(float x) { return x * sigmoidf_(x); }

__device__ __forceinline__ float block_sum256(float v, float* red) {
    red[threadIdx.x] = v; __syncthreads();
    for (int s = 128; s > 0; s >>= 1) { if ((int)threadIdx.x < s) red[threadIdx.x] += red[threadIdx.x + s]; __syncthreads(); }
    const float r = red[0]; __syncthreads(); return r;
}
__global__ void __launch_bounds__(256) nv_ln_in(const float* x, const float* g, const float* b, bf16_t* H0, float* stat) {
    __shared__ float red[256];
    const int m = blockIdx.x; const float* xr = x + (size_t)m * D;
    float s = 0.f; for (int c = threadIdx.x; c < D; c += 256) s += xr[c];
    const float mean = block_sum256(s, red) * (1.0f / D);
    float q = 0.f; for (int c = threadIdx.x; c < D; c += 256) { const float d = xr[c] - mean; q += d * d; }
    const float rstd = 1.0f / sqrtf(block_sum256(q, red) * (1.0f / D) + LN_EPS);
    for (int c = threadIdx.x; c < D; c += 256) H0[(size_t)m * D + c] = (bf16_t)f2bf((xr[c] - mean) * rstd * g[c] + b[c]);
    if (threadIdx.x == 0) { stat[2 * m] = mean; stat[2 * m + 1] = rstd; }
}
__host__ __device__ __forceinline__ int dst_row(int n, int mode) {
    if (mode == 0) return n;
    if (mode == 1) { if (n < 2048) return n; if (n < 3072) { const int s = n - 2048; return 2048 + 256 * (s >> 7) + (s & 127); } const int s = n - 3072; return 2048 + 256 * (s >> 7) + 128 + (s & 127); }
    if (mode == 2) return 256 * (n >> 7) + (n & 127);
    return 256 * (n >> 7) + 128 + (n & 127);
}
__global__ void __launch_bounds__(256) nv_transpose(const float* W, int K, int N, bf16_t* WT, int mode) {
    const size_t idx = (size_t)blockIdx.x * 256 + threadIdx.x; if (idx >= (size_t)K * N) return;
    const int n = (int)(idx % N), k = (int)(idx / N);
    WT[(size_t)dst_row(n, mode) * K + k] = (bf16_t)f2bf(W[idx]);
}
__global__ void __launch_bounds__(256) nv_gemm(const bf16_t* A, const float* B, float* C, int Mr, int N, int K) {
    __shared__ float As[16][65], Bs[16][65];
    const int tx = threadIdx.x & 15, ty = threadIdx.x >> 4, m0 = blockIdx.y * 64, n0 = blockIdx.x * 64;
    float acc[4][4] = {};
    for (int k0 = 0; k0 < K; k0 += 16) {
        for (int i = threadIdx.x; i < 64 * 16; i += 256) { const int r = i >> 4, kk = i & 15; As[kk][r] = bf2f(A[(size_t)(m0 + r) * K + k0 + kk]); }
        for (int i = threadIdx.x; i < 64 * 16; i += 256) { const int kk = i >> 6, c = i & 63; Bs[kk][c] = B[(size_t)(k0 + kk) * N + n0 + c]; }
        __syncthreads();
#pragma unroll
        for (int kk = 0; kk < 16; ++kk) {
            float a[4], b[4];
#pragma unroll
            for (int i = 0; i < 4; ++i) { a[i] = As[kk][ty * 4 + i]; b[i] = Bs[kk][tx * 4 + i]; }
#pragma unroll
            for (int i = 0; i < 4; ++i)
#pragma unroll
                for (int j = 0; j < 4; ++j) acc[i][j] += a[i] * b[j];
        }
        __syncthreads();
    }
    for (int i = 0; i < 4; ++i) for (int j = 0; j < 4; ++j) C[(size_t)(m0 + ty * 4 + i) * N + n0 + tx * 4 + j] = acc[i][j];
}
__global__ void __launch_bounds__(256) nv_zprime(const float* zraw, bf16_t* ZP) {
    const size_t idx = (size_t)blockIdx.x * 256 + threadIdx.x; if (idx >= (size_t)M * NZ) return;
    const int c = (int)(idx % NZ); const size_t m = idx / NZ; const float* zr = zraw + m * 4096;
    float v;
    if (c < 1024) v = zr[c]; else if (c < 2048) v = gelu_tanh(zr[c]); else v = zr[c] * sigmoidf_(zr[c + 1024]);
    ZP[idx] = (bf16_t)f2bf(v);
}
__global__ void __launch_bounds__(256) nv_lru1(const bf16_t* ZP, const float* w4, const float* b4, float* AIN) {
    const size_t idx = (size_t)blockIdx.x * 256 + threadIdx.x; if (idx >= (size_t)M * DL) return;
    const int c = (int)(idx % DL); const int m = (int)(idx / DL), t = m % SEQ;
    float s = b4[c];
    for (int j = 0; j < 4; ++j) { const int tt = t - 3 + j; if (tt >= 0) s += w4[j * DL + c] * bf2f(ZP[(size_t)(m - 3 + j) * NZ + c]); }
    AIN[idx] = s;
}
__global__ void __launch_bounds__(256) nv_lru2(const float* AIN, const float* wa, const float* ba, const float* wx, const float* bx, const float* lam, float* ADEC, float* U) {
    const size_t idx = (size_t)blockIdx.x * 256 + threadIdx.x; if (idx >= (size_t)M * DL) return;
    const int c = (int)(idx % DL); const size_t m = idx / DL; const int h = c >> 6, j = c & 63;
    const float* ar = AIN + m * DL + h * 64;
    float sr = ba[c], si = bx[c];
    for (int i = 0; i < 64; ++i) { const float a = ar[i]; sr += a * wa[(size_t)(h * 64 + i) * 64 + j]; si += a * wx[(size_t)(h * 64 + i) * 64 + j]; }
    const float r = sigmoidf_(sr), ig = sigmoidf_(si);
    const float l = lam[c]; const float sp = (-l > 20.f) ? -l : log1pf(expf(-l));
    const float log_a = -8.0f * r * sp; const float a = expf(log_a);
    ADEC[idx] = a; U[idx] = sqrtf(-expm1f(2.0f * log_a)) * (ig * ar[j]);
}
__global__ void __launch_bounds__(256) nv_lru3(const float* ADEC, const float* U, const bf16_t* ZP, bf16_t* MIX) {
    const int idx = blockIdx.x * 256 + threadIdx.x; if (idx >= 2 * DL) return;
    const int b = idx / DL, c = idx % DL; float h = 0.f;
    for (int t = 0; t < SEQ; ++t) { const size_t m = (size_t)b * SEQ + t; h = ADEC[m * DL + c] * h + U[m * DL + c]; MIX[m * D + c] = (bf16_t)f2bf(bf2f(ZP[m * NZ + 1024 + c]) * h); }
}
__global__ void __launch_bounds__(256) nv_conv31(const bf16_t* ZP, const float* w, const float* bias, const float* g, const float* b, bf16_t* MIX) {
    __shared__ float red[256];
    const int m = blockIdx.x, t = m % SEQ; float v[4]; float s = 0.f;
    for (int i = 0; i < 4; ++i) { const int c = threadIdx.x + 256 * i; float a = bias[c];
        for (int j = 0; j < 31; ++j) { const int tt = t - 30 + j; if (tt >= 0) a += w[j * DC + c] * bf2f(ZP[(size_t)(m - 30 + j) * NZ + 2048 + c]); }
        v[i] = a; s += a; }
    const float mean = block_sum256(s, red) * (1.0f / DC); float q = 0.f;
    for (int i = 0; i < 4; ++i) { const float d = v[i] - mean; q += d * d; }
    const float rstd = 1.0f / sqrtf(block_sum256(q, red) * (1.0f / DC) + LN_EPS);
    for (int i = 0; i < 4; ++i) { const int c = threadIdx.x + 256 * i; MIX[(size_t)m * D + 1024 + c] = (bf16_t)f2bf(silu_((v[i] - mean) * rstd * g[c] + b[c])); }
}
__global__ void __launch_bounds__(256) nv_y1(float* Y1, const float* x, const float* stat0, const float* g, const float* b) {
    const size_t idx = (size_t)blockIdx.x * 256 + threadIdx.x; if (idx >= (size_t)M * D) return;
    const int c = (int)(idx % D); const size_t m = idx / D;
    Y1[idx] += ALPHA * ((x[idx] - stat0[2 * m]) * stat0[2 * m + 1] * g[c] + b[c]);
}
__global__ void __launch_bounds__(256) nv_router(const float* Y1, const float* g1, const float* b1, const float* wg, const float* bg, const float* we, const float* be,
                                                 bf16_t* H1, float* stat1, unsigned* route, unsigned* cnt, int* list, float* ql) {
    __shared__ float red[256]; __shared__ float lg[36];
    const int m = blockIdx.x; const float* yr = Y1 + (size_t)m * D;
    float s = 0.f; for (int c = threadIdx.x; c < D; c += 256) s += yr[c];
    const float mean = block_sum256(s, red) * (1.0f / D);
    float q = 0.f; for (int c = threadIdx.x; c < D; c += 256) { const float d = yr[c] - mean; q += d * d; }
    const float rstd = 1.0f / sqrtf(block_sum256(q, red) * (1.0f / D) + LN_EPS);
    float hv[8];
    for (int i = 0; i < 8; ++i) { const int c = threadIdx.x + 256 * i; hv[i] = (yr[c] - mean) * rstd * g1[c] + b1[c]; H1[(size_t)m * D + c] = (bf16_t)f2bf(hv[i]); }
    for (int o = 0; o < 36; ++o) { float p = 0.f;
        for (int i = 0; i < 8; ++i) { const int c = threadIdx.x + 256 * i; p += hv[i] * (o < 4 ? wg[c * 4 + o] : we[c * 32 + (o - 4)]); }
        p = block_sum256(p, red); if (threadIdx.x == 0) lg[o] = p + (o < 4 ? bg[o] : be[o - 4]); }
    __syncthreads();
    if (threadIdx.x == 0) {
        stat1[2 * m] = mean; stat1[2 * m + 1] = rstd;
        int gs = 0; for (int j = 1; j < 4; ++j) if (lg[j] > lg[gs]) gs = j;
        float den = 0.f; for (int j = 0; j < 4; ++j) den += expf(lg[j] - lg[gs]);
        const float pg = 1.0f / den;
        const float* le = lg + 4 + 8 * gs; int i0 = 0; for (int j = 1; j < 8; ++j) if (le[j] > le[i0]) i0 = j;
        int i1 = (i0 == 0) ? 1 : 0; for (int j = 0; j < 8; ++j) if (j != i0 && le[j] > le[i1]) i1 = j;
        const float ex = expf(le[i1] - le[i0]); const float q0 = pg / (1.0f + ex), q1 = pg * ex / (1.0f + ex);
        const int e0 = gs * 8 + i0, e1 = gs * 8 + i1;
        const unsigned p0 = atomicAdd(&cnt[e0], 1u), p1 = atomicAdd(&cnt[e1], 1u);
        list[e0 * 8192 + p0] = m; ql[e0 * 8192 + p0] = q0; list[e1 * 8192 + p1] = m; ql[e1 * 8192 + p1] = q1;
        unsigned* r = route + (size_t)m * 8; r[0] = e0; r[1] = e1; r[2] = __float_as_uint(q0); r[3] = __float_as_uint(q1); r[4] = p0; r[5] = p1;
    }
}
__device__ __forceinline__ int slot_off(const unsigned* cnt, int e) { int o = 0; for (int j = 0; j < e; ++j) o += ((int)cnt[j] + 255) & ~255; return o; }
__global__ void __launch_bounds__(512) nv_moe_up(const bf16_t* H1, const unsigned* route, const unsigned* cnt, const float* wgate, const float* wup, bf16_t* HH) {
    __shared__ float xs[D];
    const int m = blockIdx.x >> 1, k = blockIdx.x & 1; const unsigned* r = route + (size_t)m * 8;
    const int e = (int)r[k]; const float q = __uint_as_float(r[2 + k]); const int slot = slot_off(cnt, e) + (int)r[4 + k];
    for (int c = threadIdx.x; c < D; c += 512) xs[c] = bf2f(H1[(size_t)m * D + c]);
    __syncthreads();
    const int f = threadIdx.x; const float* wgp = wgate + (size_t)e * D * FF + f; const float* wup_ = wup + (size_t)e * D * FF + f;
    float g = 0.f, u = 0.f;
    for (int d = 0; d < D; ++d) { g += xs[d] * wgp[(size_t)d * FF]; u += xs[d] * wup_[(size_t)d * FF]; }
    HH[(size_t)slot * FF + f] = (bf16_t)f2bf(silu_(g) * u * q);
}
__global__ void __launch_bounds__(512) nv_moe_down(const bf16_t* HH, const unsigned* route, const unsigned* cnt, const float* wdown, bf16_t* YF) {
    __shared__ float hs[FF];
    const int m = blockIdx.x >> 1, k = blockIdx.x & 1; const unsigned* r = route + (size_t)m * 8;
    const int e = (int)r[k]; const int slot = slot_off(cnt, e) + (int)r[4 + k];
    hs[threadIdx.x] = bf2f(HH[(size_t)slot * FF + threadIdx.x]);
    __syncthreads();
    const float* wd = wdown + (size_t)e * FF * D;
    for (int i = 0; i < 4; ++i) { const int d = threadIdx.x + 512 * i; float y = 0.f;
        for (int f = 0; f < FF; ++f) y += hs[f] * wd[(size_t)f * D + d];
        YF[(size_t)slot * D + d] = (bf16_t)f2bf(y); }
}
__global__ void __launch_bounds__(256) nv_final(const float* Y1, const float* stat1, const float* g1, const float* b1, const unsigned* route, const unsigned* cnt, const bf16_t* YF,
                                                const float* g2, const float* b2, float* out) {
    __shared__ float red[256];
    const int m = blockIdx.x; const unsigned* r = route + (size_t)m * 8;
    const int s0 = slot_off(cnt, (int)r[0]) + (int)r[4], s1 = slot_off(cnt, (int)r[1]) + (int)r[5];
    const float mean1 = stat1[2 * m], rstd1 = stat1[2 * m + 1];
    float v[8]; float s = 0.f;
    for (int i = 0; i < 8; ++i) { const int c = threadIdx.x + 256 * i;
        const float h1 = (Y1[(size_t)m * D + c] - mean1) * rstd1 * g1[c] + b1[c];
        v[i] = ALPHA * h1 + (bf2f(YF[(size_t)s0 * D + c]) + bf2f(YF[(size_t)s1 * D + c])); s += v[i]; }
    const float mean = block_sum256(s, red) * (1.0f / D); float q = 0.f;
    for (int i = 0; i < 8; ++i) { const float d = v[i] - mean; q += d * d; }
    const float rstd = 1.0f / sqrtf(block_sum256(q, red) * (1.0f / D) + LN_EPS);
    for (int i = 0; i < 8; ++i) { const int c = threadIdx.x + 256 * i; out[(size_t)m * D + c] = (v[i] - mean) * rstd * g2[c] + b2[c]; }
}


#define LAS __attribute__((address_space(3)))
#define GAS __attribute__((address_space(1)))
namespace pg8 {
constexpr int BM = 256, BK = 64, HALF = 128, HTB = HALF * BK * 2, STAGE_BYTES = 8 * HTB, NXCD = 8, WGM = 8;
__host__ __device__ __forceinline__ int lds_byte(int r, int c) { const int st = (r >> 4) * 2 + (c >> 5), rr = r & 15, cc = c & 31, ob = rr * 64 + cc * 2; return st * 1024 + (ob ^ (((ob >> 9) & 1) << 5)); }
__host__ __device__ __forceinline__ void stage_rc(int b, int& R, int& C) { const int st = b / 1024, sb = b % 1024, swz = sb ^ (((sb >> 9) & 1) << 5); R = (st >> 1) * 16 + swz / 64; C = (st & 1) * 32 + (swz % 64) / 2; }
__host__ __device__ __forceinline__ int perm32(int rho) { const int n = rho >> 4, i = rho & 15; return 8 * (i >> 2) + 4 * n + (i & 3); }

struct Unit { const char* a; const char* b; int pm, pn, e, mt; };

__device__ __forceinline__ unsigned cvt_pk_bf16(float lo, float hi) { unsigned r; asm volatile("v_cvt_pk_bf16_f32 %0, %1, %2" : "=v"(r) : "v"(lo), "v"(hi)); return r; }

struct DenseOrder {
    const char* A; const char* Bt; int K, nM, nN, nwg, G, c;
    __device__ void init(const void* A_, const void* Bt_, int Mr, int N, int K_, int G_, int c_) { A = (const char*)A_; Bt = (const char*)Bt_; K = K_; nM = Mr / BM; nN = N / BM; nwg = nM * nN; G = G_; c = c_; }
    __device__ bool next(int i, Unit& u) const {
        const long L = (long)i * G + c; if (L >= nwg) return false;
        int wgid = (int)L; { const int q = nwg / NXCD, r = nwg % NXCD, xcd = wgid % NXCD, off = wgid / NXCD; wgid = (xcd < r ? xcd * (q + 1) : r * (q + 1) + (xcd - r) * q) + off; }
        const int nig = WGM * nN, gid = wgid / nig, fm = gid * WGM, gsz = (nM - fm) < WGM ? (nM - fm) : WGM;
        u.pm = fm + ((wgid % nig) % gsz); u.pn = (wgid % nig) / gsz; u.e = 0; u.mt = 0;
        u.a = A + (size_t)u.pm * BM * K * 2; u.b = Bt + (size_t)u.pn * BM * K * 2; return true;
    }
    __device__ __forceinline__ void gather(const Unit&, const int (&)[2], const int (&)[2], unsigned (&)[2][2]) const {}
};

template <class Epi, class Sched, bool GATHER, bool ALIGN_EPI, bool SP2>
__device__ __forceinline__ void gemm_phase(LAS unsigned char* lds, const int K, const Sched& S, const Epi& E) {
    const int tid = threadIdx.x, wid = __builtin_amdgcn_readfirstlane(tid >> 6), lane = tid & 63, wr = wid >> 2, wc = wid & 3, fr = lane & 15, fq = lane >> 4;
    const int nt = K / BK;
    unsigned voffA[2], voffB[2]; int stR[2], stC[2];
#pragma unroll
    for (int i = 0; i < 2; ++i) { int R, C; stage_rc(tid * 16 + i * 8192, R, C); const int Rb = Epi::PERM ? ((R & ~31) + perm32(R & 31)) : R;
        voffA[i] = (unsigned)(R * K + C) * 2u; voffB[i] = (unsigned)(Rb * K + C) * 2u; stR[i] = R; stC[i] = C; }
    unsigned voffG[2][2] = {{0u, 0u}, {0u, 0u}}, voffGn[2][2] = {{0u, 0u}, {0u, 0u}};
    const size_t kstep = (size_t)(BK * 2);
    const size_t hstep = (size_t)HALF * K * 2;
    const unsigned ldsw = (unsigned)wid * 1024u;
    const int aoff = lds_byte(wr * 64 + fr, fq * 8), boff = lds_byte(wc * 32 + fr, fq * 8);
#define PG8_SA(b, h) (((b) * 2 + (h)) * HTB)
#define PG8_SB(b, h) ((4 + (b) * 2 + (h)) * HTB)
#define PG8_STAGE(bufoff, gbase, voff) do { _Pragma("unroll") for (int _i = 0; _i < 2; ++_i) \
        __builtin_amdgcn_global_load_lds((const unsigned*)((const char*)(gbase) + (voff)[_i]), (LAS unsigned*)(lds + (bufoff) + ldsw + _i * 8192), 16, 0, 0); } while (0)
#define PG8_STAGE_A(bufoff, gk, h, og) do { if constexpr (GATHER) { PG8_STAGE(bufoff, gk, (og)[h]); } else { PG8_STAGE(bufoff, (gk) + (h) * hstep, voffA); } } while (0)
#define PG8_LDA(dst, b, h) do { _Pragma("unroll") for (int m = 0; m < 4; ++m) _Pragma("unroll") for (int k = 0; k < 2; ++k) dst[m][k] = *(const LAS bf16x8*)(lds + PG8_SA(b, h) + aoff + m * 2048 + k * 1024); } while (0)
#define PG8_LDB(dst, b, h) do { _Pragma("unroll") for (int n = 0; n < 2; ++n) _Pragma("unroll") for (int k = 0; k < 2; ++k) dst[n][k] = *(const LAS bf16x8*)(lds + PG8_SB(b, h) + boff + n * 2048 + k * 1024); } while (0)
#define PG8_MMA(ai, bj, At, Bt) do { __builtin_amdgcn_s_setprio(1); _Pragma("unroll") for (int m = 0; m < 4; ++m) _Pragma("unroll") for (int n = 0; n < 2; ++n) _Pragma("unroll") for (int k = 0; k < 2; ++k) \
        acc[ai][bj][m][n] = __builtin_amdgcn_mfma_f32_16x16x32_bf16(Bt[n][k], At[m][k], acc[ai][bj][m][n], 0, 0, 0); __builtin_amdgcn_s_setprio(0); } while (0)
#define PG8_WAIT_V(n) asm volatile("s_waitcnt vmcnt(" #n ")" ::: "memory")
#define PG8_WAIT_L(n) asm volatile("s_waitcnt lgkmcnt(" #n ")" ::: "memory")
#define PG8_BAR __builtin_amdgcn_s_barrier()
#define PG8_SCHED __builtin_amdgcn_sched_barrier(0)
    Unit cur, nxt; int ui = 0;
    if (!S.next(0, cur)) return;
    f32x4 acc[2][2][4][2];
#pragma unroll
    for (int a = 0; a < 2; ++a)
#pragma unroll
        for (int b = 0; b < 2; ++b)
#pragma unroll
            for (int m = 0; m < 4; ++m)
#pragma unroll
                for (int n = 0; n < 2; ++n) acc[a][b][m][n] = (f32x4){0.f, 0.f, 0.f, 0.f};
    bf16x8 At[4][2], B0[2][2], B1[2][2];
    const char* cA = cur.a; const char* cB = cur.b;
    if constexpr (GATHER) { S.gather(cur, stR, stC, voffG); asm volatile("s_waitcnt vmcnt(0)" ::: "memory"); }
    if constexpr (SP2) {
        PG8_STAGE(PG8_SB(0, 0), cB, voffB); PG8_STAGE(PG8_SB(0, 1), cB + hstep, voffB); PG8_STAGE_A(PG8_SA(0, 0), cA, 0, voffG); PG8_STAGE_A(PG8_SA(0, 1), cA, 1, voffG);
        if (wr == 1) PG8_BAR;
        PG8_WAIT_V(2); PG8_BAR;
        PG8_STAGE(PG8_SB(1, 0), cB + kstep, voffB); PG8_STAGE_A(PG8_SA(1, 0), cA + kstep, 0, voffG); PG8_STAGE(PG8_SB(1, 1), cB + hstep + kstep, voffB);
        PG8_WAIT_V(6); PG8_BAR;
    } else {
        PG8_STAGE(PG8_SB(0, 0), cB, voffB); PG8_STAGE_A(PG8_SA(0, 0), cA, 0, voffG); PG8_STAGE(PG8_SB(0, 1), cB + hstep, voffB); PG8_STAGE_A(PG8_SA(0, 1), cA, 1, voffG);
        if (wr == 1) PG8_BAR;
        PG8_WAIT_V(4); PG8_BAR;
        PG8_STAGE(PG8_SB(1, 0), cB + kstep, voffB); PG8_STAGE_A(PG8_SA(1, 0), cA + kstep, 0, voffG); PG8_STAGE(PG8_SB(1, 1), cB + hstep + kstep, voffB);
        PG8_WAIT_V(6); PG8_BAR;
    }
    for (;;) {
        const bool has_next = S.next(ui + 1, nxt);
        const char* nA = has_next ? nxt.a : cA; const char* nB = has_next ? nxt.b : cB;
        if constexpr (GATHER) { if (has_next) S.gather(nxt, stR, stC, voffGn); else {
#pragma unroll
            for (int h = 0; h < 2; ++h)
#pragma unroll
                for (int i = 0; i < 2; ++i) voffGn[h][i] = voffG[h][i]; } }
        for (int t = 0; t < nt; t += 2) {
            const bool last = (t == nt - 2);
            const char* a1 = cA + (size_t)(t + 1) * kstep;
            const char* a2 = last ? nA : cA + (size_t)(t + 2) * kstep; const char* b2 = last ? nB : cB + (size_t)(t + 2) * kstep;
            const char* a3 = a2 + kstep; const char* b3 = b2 + kstep;
            unsigned og2[2][2];
            if constexpr (GATHER) {
#pragma unroll
                for (int h = 0; h < 2; ++h)
#pragma unroll
                    for (int i = 0; i < 2; ++i) og2[h][i] = last ? voffGn[h][i] : voffG[h][i]; }
            if constexpr (SP2) {
            PG8_LDB(B0, 0, 0); PG8_LDB(B1, 0, 1); PG8_SCHED; PG8_LDA(At, 0, 0); PG8_STAGE_A(PG8_SA(1, 1), a1, 1, voffG);
            PG8_WAIT_V(8); PG8_WAIT_L(0); PG8_BAR; PG8_MMA(0, 0, At, B0); PG8_MMA(0, 1, At, B1); PG8_BAR; PG8_SCHED;
            PG8_LDA(At, 0, 1); PG8_STAGE(PG8_SB(0, 0), b2, voffB); PG8_STAGE(PG8_SB(0, 1), b2 + hstep, voffB); PG8_STAGE_A(PG8_SA(0, 0), a2, 0, og2);
            PG8_WAIT_V(8); PG8_WAIT_L(0); PG8_BAR; PG8_MMA(1, 0, At, B0); PG8_MMA(1, 1, At, B1); PG8_BAR; PG8_SCHED;
            PG8_LDB(B0, 1, 0); PG8_LDB(B1, 1, 1); PG8_SCHED; PG8_LDA(At, 1, 0); PG8_STAGE_A(PG8_SA(0, 1), a2, 1, og2);
            PG8_WAIT_V(8); PG8_WAIT_L(0); PG8_BAR; PG8_MMA(0, 0, At, B0); PG8_MMA(0, 1, At, B1); PG8_BAR; PG8_SCHED;
            PG8_LDA(At, 1, 1); PG8_STAGE(PG8_SB(1, 0), b3, voffB); PG8_STAGE(PG8_SB(1, 1), b3 + hstep, voffB); PG8_STAGE_A(PG8_SA(1, 0), a3, 0, og2);
            PG8_WAIT_V(8); PG8_WAIT_L(0); PG8_BAR; PG8_MMA(1, 0, At, B0); PG8_MMA(1, 1, At, B1); PG8_BAR; PG8_SCHED;
            } else {
            PG8_LDB(B0, 0, 0); PG8_SCHED; PG8_LDA(At, 0, 0); PG8_STAGE_A(PG8_SA(1, 1), a1, 1, voffG);
            PG8_WAIT_L(8); PG8_BAR; PG8_WAIT_L(0); PG8_MMA(0, 0, At, B0); PG8_BAR; PG8_SCHED;
            PG8_LDB(B1, 0, 1); PG8_STAGE(PG8_SB(0, 0), b2, voffB);
            PG8_BAR; PG8_WAIT_L(0); PG8_MMA(0, 1, At, B1); PG8_BAR;
            PG8_LDA(At, 0, 1); PG8_STAGE_A(PG8_SA(0, 0), a2, 0, og2);
            PG8_BAR; PG8_WAIT_L(0); PG8_MMA(1, 0, At, B0); PG8_BAR; PG8_SCHED;
            PG8_STAGE(PG8_SB(0, 1), b2 + hstep, voffB);
            PG8_WAIT_V(6); PG8_BAR; PG8_MMA(1, 1, At, B1); PG8_BAR;
            PG8_LDB(B0, 1, 0); PG8_SCHED; PG8_LDA(At, 1, 0); PG8_STAGE_A(PG8_SA(0, 1), a2, 1, og2);
            PG8_WAIT_L(8); PG8_BAR; PG8_WAIT_L(0); PG8_MMA(0, 0, At, B0); PG8_BAR; PG8_SCHED;
            PG8_LDB(B1, 1, 1); PG8_STAGE(PG8_SB(1, 0), b3, voffB);
            PG8_BAR; PG8_WAIT_L(0); PG8_MMA(0, 1, At, B1); PG8_BAR;
            PG8_LDA(At, 1, 1); PG8_STAGE_A(PG8_SA(1, 0), a3, 0, og2);
            PG8_BAR; PG8_WAIT_L(0); PG8_MMA(1, 0, At, B0); PG8_BAR; PG8_SCHED;
            PG8_STAGE(PG8_SB(1, 1), b3 + hstep, voffB);
            PG8_WAIT_V(6); PG8_BAR; PG8_MMA(1, 1, At, B1); PG8_BAR;
            }
        }
        if constexpr (ALIGN_EPI) { if (wr == 0) PG8_BAR; }
        E(acc, cur, wr, wc, fr, fq);
        if (!has_next) break;
#pragma unroll
        for (int a = 0; a < 2; ++a)
#pragma unroll
            for (int b = 0; b < 2; ++b)
#pragma unroll
                for (int m = 0; m < 4; ++m)
#pragma unroll
                    for (int n = 0; n < 2; ++n) acc[a][b][m][n] = (f32x4){0.f, 0.f, 0.f, 0.f};
        cur = nxt; cA = nA; cB = nB; ++ui;
        if constexpr (GATHER) {
#pragma unroll
            for (int h = 0; h < 2; ++h)
#pragma unroll
                for (int i = 0; i < 2; ++i) voffG[h][i] = voffGn[h][i]; }
        if constexpr (ALIGN_EPI) { if (wr == 1) PG8_BAR; }
    }
    PG8_WAIT_V(0);
    if constexpr (!ALIGN_EPI) { if (wr == 0) PG8_BAR; }
    PG8_BAR;
    (void)stR; (void)stC;
#undef PG8_SA
#undef PG8_SB
#undef PG8_STAGE
#undef PG8_STAGE_A
#undef PG8_LDA
#undef PG8_LDB
#undef PG8_MMA
#undef PG8_WAIT_V
#undef PG8_WAIT_L
#undef PG8_BAR
#undef PG8_SCHED
}
}
#ifndef MK_SP2
#define MK_SP2 true
#endif
#ifndef MK_ALIGN
#define MK_ALIGN true
#endif

constexpr int NWAVES = 8;
constexpr int RING_BYTES = 131072;
constexpr int MISC_OFF = RING_BYTES;
constexpr int LDS_BYTES = 147456;
constexpr int CW_BAR = 4096;
constexpr size_t WS_WRT = 4 * MiB;

typedef GAS unsigned gu32;
#define RLX_AGENT __ATOMIC_RELAXED, __HIP_MEMORY_SCOPE_AGENT
#define LDS_WAIT() asm volatile("s_waitcnt lgkmcnt(0)" ::: "memory")
#define VM_WAIT() asm volatile("s_waitcnt vmcnt(0)" ::: "memory")
__device__ __forceinline__ unsigned pk2(float lo, float hi) { return f2bf(lo) | (f2bf(hi) << 16); }

#define XB_TMO      128
#define XB_XCNT(j)  (256  + 64 * (j))
#define XB_XSUB(j)  (1280 + 64 * (j))
#define XB_XGEN(j)  (2304 + 64 * (j))
#define XB_TOP      3328
#define XB_TOPGEN   3392
#define XCD_BAR_WORDS 3456
#define XB_SPIN_CAP (1u << 18)
__device__ __forceinline__ unsigned xb_ld(unsigned* p)              { return __hip_atomic_load(p, __ATOMIC_RELAXED, __HIP_MEMORY_SCOPE_AGENT); }
__device__ __forceinline__ unsigned xb_add(unsigned* p, unsigned v) { return __hip_atomic_fetch_add(p, v, __ATOMIC_RELAXED, __HIP_MEMORY_SCOPE_AGENT); }
__device__ __forceinline__ unsigned xb_xcc_id() { return (unsigned)__builtin_amdgcn_s_getreg((3 << 11) | 20) & 0xFu; }
#define XB_SPIN(cond, bar) do { unsigned _sp = 0; while (cond) { __builtin_amdgcn_s_sleep(1); \
    if ((++_sp & 255u) == 0u) { if (xb_ld(&(bar)[XB_TMO])) break; if (_sp > XB_SPIN_CAP) { atomicAdd(&(bar)[XB_TMO], 1u); break; } } } } while (0)
struct XcdBarrier { unsigned* bar; unsigned x; volatile LAS unsigned* st; };
__device__ __forceinline__ XcdBarrier xcd_barrier_post(unsigned* bar, volatile LAS unsigned* st) {
    XcdBarrier b; b.bar = bar; b.x = xb_xcc_id(); b.st = st;
    if (threadIdx.x == 0) (void)xb_add(&bar[XB_XCNT(b.x)], 1u);
    return b;
}
__device__ __forceinline__ void xcd_barrier_complete(unsigned* bar, unsigned x, unsigned& nloc, unsigned& nx) {
    const unsigned G = gridDim.x * gridDim.y * gridDim.z;
    unsigned sum, cnt, mine, sp = 0u;
    for (;;) {
        sum = 0u; cnt = 0u; mine = 0u;
#pragma unroll
        for (unsigned j = 0; j < 16; ++j) { const unsigned c = xb_ld(&bar[XB_XCNT(j)]); sum += c; cnt += (c > 0u) ? 1u : 0u; mine = (j == x) ? c : mine; }
        if (sum == G) break;
        __builtin_amdgcn_s_sleep(1);
        if ((++sp & 255u) == 0u) { if (xb_ld(&bar[XB_TMO])) break; if (sp > XB_SPIN_CAP) { atomicAdd(&bar[XB_TMO], 1u); break; } }
    }
    nloc = mine > 0u ? mine : 1u; nx = cnt > 0u ? cnt : 1u;
}
__device__ __forceinline__ void xcd_barrier(const XcdBarrier& b) {
    asm volatile("s_waitcnt vmcnt(0)" ::: "memory");
    __syncthreads();
    if (threadIdx.x == 0) {
        unsigned* bar = b.bar;
        __builtin_amdgcn_s_waitcnt(0);
        unsigned nloc = b.st[0], nx = b.st[1];
        if (nloc == 0u) { xcd_barrier_complete(bar, b.x, nloc, nx); b.st[0] = nloc; b.st[1] = nx; }
        const unsigned old = xb_add(&bar[XB_XSUB(b.x)], 1u);
        const unsigned gen = old / nloc;
        if (old + 1u == (gen + 1u) * nloc) {
            __builtin_amdgcn_fence(__ATOMIC_RELEASE, "agent");
            asm volatile("s_waitcnt vmcnt(0)" ::: "memory");
            const unsigned og = xb_add(&bar[XB_TOP], 1u);
            const unsigned tg = og / nx;
            if (og + 1u == (tg + 1u) * nx) xb_add(&bar[XB_TOPGEN], 1u);
            else XB_SPIN(xb_ld(&bar[XB_TOPGEN]) == tg, bar);
            __builtin_amdgcn_fence(__ATOMIC_ACQUIRE, "agent");
            xb_add(&bar[XB_XGEN(b.x)], 1u);
            asm volatile("s_waitcnt vmcnt(0)" ::: "memory");
        } else {
            XB_SPIN(xb_ld(&bar[XB_XGEN(b.x)]) == gen, bar);
            __builtin_amdgcn_fence(__ATOMIC_ACQUIRE, "agent");
            asm volatile("s_waitcnt vmcnt(0)" ::: "memory");
        }
    }
    __syncthreads();
}

struct Frame {
    LAS unsigned char* lds; volatile LAS unsigned* MISC;
    int tid, lane, wave, vcu, G;
    const float* const* in; float* out; unsigned char* ws;
};
__device__ __forceinline__ float wave_sum(float v) {
#pragma unroll
    for (int o = 1; o < 64; o <<= 1) v += __shfl_xor(v, o);
    return v;
}

__device__ __forceinline__ void p0_transpose_item(const float* W, int K, int N, bf16_t* WT, int mode, LAS float* scr, int item, int lane) {
    const int nblk = N / 32, kb = item / nblk, nb = item % nblk, k0 = 64 * kb, n0 = 32 * nb;
#pragma unroll 8
    for (int i = 0; i < 32; ++i) { const int kk = 2 * i + (lane >> 5); scr[kk * 33 + (lane & 31)] = W[(size_t)(k0 + kk) * N + n0 + (lane & 31)]; }
    LDS_WAIT(); asm volatile("" ::: "memory");
    const int c = lane & 7; const int d0 = dst_row(n0, mode);
#pragma unroll
    for (int j = 0; j < 4; ++j) { const int n = (lane >> 3) + 8 * j; const LAS float* s = scr + (8 * c) * 33 + n;
        u32x4 o; o.x = pk2(s[0 * 33], s[1 * 33]); o.y = pk2(s[2 * 33], s[3 * 33]); o.z = pk2(s[4 * 33], s[5 * 33]); o.w = pk2(s[6 * 33], s[7 * 33]);
        *(u32x4*)(WT + (size_t)(d0 + n) * K + k0 + 8 * c) = o; }
    LDS_WAIT(); asm volatile("" ::: "memory");
}
__device__ __forceinline__ void p0_prologue(Frame& F) {
    LAS float* scr = (LAS float*)(F.lds + F.wave * 16384);
    const int gw = F.vcu * NWAVES + F.wave, NGW = F.G * NWAVES, lane = F.lane;
    unsigned char* ws = F.ws;
    { const float* g = F.in[1]; const float* b = F.in[2]; bf16_t* H0 = (bf16_t*)(ws + WS_H0); float* stat = (float*)(ws + WS_STAT0);
      for (int m = gw; m < M; m += NGW) {
        const f32x4* xr = (const f32x4*)(F.in[0] + (size_t)m * D) + lane;
        f32x4 v[8]; float s = 0.f;
#pragma unroll
        for (int j = 0; j < 8; ++j) { v[j] = xr[64 * j]; s += (v[j].x + v[j].y) + (v[j].z + v[j].w); }
        const float mean = wave_sum(s) * (1.f / D); float s2 = 0.f;
#pragma unroll
        for (int j = 0; j < 8; ++j) { v[j] = v[j] - mean; s2 += (v[j].x * v[j].x + v[j].y * v[j].y) + (v[j].z * v[j].z + v[j].w * v[j].w); }
        const float rstd = 1.f / sqrtf(wave_sum(s2) * (1.f / D) + LN_EPS);
        u32x2* o8 = (u32x2*)(H0 + (size_t)m * D) + lane;
#pragma unroll
        for (int j = 0; j < 8; ++j) { const f32x4 g4 = ((const f32x4*)g)[lane + 64 * j], b4 = ((const f32x4*)b)[lane + 64 * j]; const f32x4 h = v[j] * rstd * g4 + b4;
            u32x2 w; w.x = pk2(h.x, h.y); w.y = pk2(h.z, h.w); o8[64 * j] = w; }
        if (lane == 0) { stat[2 * m] = mean; stat[2 * m + 1] = rstd; }
      } }
    { float* wrt = (float*)(ws + WS_WRT);
      for (int i = gw * 64 + lane; i < 48 * D; i += NGW * 64) { const int o = i / D, k = i % D; wrt[i] = o < 4 ? F.in[18][k * 4 + o] : (o < 36 ? F.in[20][k * 32 + (o - 4)] : 0.f); } }
    constexpr int I_IN = (D / 64) * (4096 / 32), I_OUT = (D / 64) * (D / 32), I_G = (D / 64) * (FF / 32), I_D = (FF / 64) * (D / 32), I_E = 2 * I_G + I_D;
    constexpr int NITEMS = I_IN + I_OUT + NEXP * I_E;
    for (int it = gw; it < NITEMS; it += NGW) {
        int r = it;
        if (r < I_IN) { p0_transpose_item(F.in[3], D, 4096, (bf16_t*)(ws + WS_BT1), 1, scr, r, lane); continue; } r -= I_IN;
        if (r < I_OUT) { p0_transpose_item(F.in[15], D, D, (bf16_t*)(ws + WS_BT2), 0, scr, r, lane); continue; } r -= I_OUT;
        const int e = r / I_E; r -= e * I_E;
        bf16_t* btu = (bf16_t*)(ws + WS_BTU) + (size_t)e * 1024 * D; bf16_t* btd = (bf16_t*)(ws + WS_BTD) + (size_t)e * D * FF;
        if (r < I_G) { p0_transpose_item(F.in[22] + (size_t)e * D * FF, D, FF, btu, 2, scr, r, lane); continue; } r -= I_G;
        if (r < I_G) { p0_transpose_item(F.in[23] + (size_t)e * D * FF, D, FF, btu, 3, scr, r, lane); continue; } r -= I_G;
        p0_transpose_item(F.in[24] + (size_t)e * FF * D, FF, D, btd, 0, scr, r, lane);
    }
}

struct EpiZ {
    static constexpr bool PERM = true;
    bf16_t* Z;
    __device__ __forceinline__ void operator()(const f32x4 (&acc)[2][2][4][2], const pg8::Unit& u, int wr, int wc, int fr, int fq) const {
        const int row0 = u.pm * 256 + wr * 64 + fr;
        if (u.pn < 8) {
            const int col0 = u.pn * 256 + wc * 32 + 8 * fq; const bool act = u.pn >= 4;
#pragma unroll
            for (int ai = 0; ai < 2; ++ai)
#pragma unroll
                for (int m = 0; m < 4; ++m) { bf16_t* rowp = Z + (size_t)(row0 + ai * 128 + m * 16) * NZ + col0;
#pragma unroll
                    for (int bj = 0; bj < 2; ++bj) { f32x4 v0 = acc[ai][bj][m][0], v1 = acc[ai][bj][m][1];
                        if (act) {
#pragma unroll
                            for (int j = 0; j < 4; ++j) { v0[j] = gelu_tanh(v0[j]); v1[j] = gelu_tanh(v1[j]); } }
                        u32x4 w; w.x = pg8::cvt_pk_bf16(v0[0], v0[1]); w.y = pg8::cvt_pk_bf16(v0[2], v0[3]); w.z = pg8::cvt_pk_bf16(v1[0], v1[1]); w.w = pg8::cvt_pk_bf16(v1[2], v1[3]);
                        *(u32x4*)(rowp + bj * 128) = w; } }
        } else {
            const int col0 = 2048 + 128 * (u.pn - 8) + wc * 32 + 8 * fq;
#pragma unroll
            for (int ai = 0; ai < 2; ++ai)
#pragma unroll
                for (int m = 0; m < 4; ++m) { bf16_t* rowp = Z + (size_t)(row0 + ai * 128 + m * 16) * NZ + col0;
                    f32x4 v0 = acc[ai][0][m][0], v1 = acc[ai][0][m][1]; const f32x4 g0 = acc[ai][1][m][0], g1 = acc[ai][1][m][1];
#pragma unroll
                    for (int j = 0; j < 4; ++j) { v0[j] = v0[j] * sigmoidf_(g0[j]); v1[j] = v1[j] * sigmoidf_(g1[j]); }
                    u32x4 w; w.x = pg8::cvt_pk_bf16(v0[0], v0[1]); w.y = pg8::cvt_pk_bf16(v0[2], v0[3]); w.z = pg8::cvt_pk_bf16(v1[0], v1[1]); w.w = pg8::cvt_pk_bf16(v1[2], v1[3]);
                    *(u32x4*)rowp = w; }
        }
    }
};
struct EpiY1 {
    static constexpr bool PERM = false;
    float* Y1; const float* x; const float* stat0; const float* g; const float* b;
    __device__ __forceinline__ void operator()(const f32x4 (&acc)[2][2][4][2], const pg8::Unit& u, int wr, int wc, int fr, int fq) const {
        const int row0 = u.pm * 256 + wr * 64 + fr, col0 = u.pn * 256 + wc * 32 + 4 * fq;
        f32x4 gv[2][2], bv[2][2];
#pragma unroll
        for (int bj = 0; bj < 2; ++bj)
#pragma unroll
            for (int n = 0; n < 2; ++n) { gv[bj][n] = *(const f32x4*)(g + col0 + bj * 128 + n * 16) * ALPHA; bv[bj][n] = *(const f32x4*)(b + col0 + bj * 128 + n * 16) * ALPHA; }
#pragma unroll
        for (int ai = 0; ai < 2; ++ai)
#pragma unroll
            for (int m = 0; m < 4; ++m) { const int r = row0 + ai * 128 + m * 16; const float mean = stat0[2 * r], rstd = stat0[2 * r + 1]; const size_t off = (size_t)r * D + col0;
#pragma unroll
                for (int bj = 0; bj < 2; ++bj)
#pragma unroll
                    for (int n = 0; n < 2; ++n) { const f32x4 xv = *(const f32x4*)(x + off + bj * 128 + n * 16);
                        *(f32x4*)(Y1 + off + bj * 128 + n * 16) = acc[ai][bj][m][n] + ((xv - mean) * rstd) * gv[bj][n] + bv[bj][n]; }
                asm volatile("" ::: "memory"); }
    }
};


template <int SH> __device__ __forceinline__ float row_shr(float v, float ident) {
    return __int_as_float(__builtin_amdgcn_update_dpp(__float_as_int(ident), __float_as_int(v), 0x110 + SH, 0xF, 0xF, false)); }
__device__ __forceinline__ float bcast15(float v) { return __int_as_float(__builtin_amdgcn_ds_swizzle(__float_as_int(v), 0x1F0)); }
__device__ __forceinline__ float bflo(unsigned x) { return __uint_as_float(x << 16); }
__device__ __forceinline__ float bfhi(unsigned x) { return __uint_as_float(x & 0xffff0000u); }
#define SCAN_STEP(SH) do { const float pp = row_shr<SH>(p, 1.0f), hp = row_shr<SH>(h, 0.0f); h = p * hp + h; p = p * pp; } while (0)
__device__ __forceinline__ void lru_unit(Frame& F, int unit) {
    const int b = unit >> 7, hd = (unit >> 3) & 15, s = unit & 7;
    const int lane = F.lane, wave = F.wave, fr = lane & 15, fq = lane >> 4;
    const float* w4 = F.in[4]; const float* b4 = F.in[5]; const float* wa = F.in[6]; const float* ba = F.in[7]; const float* wx = F.in[8]; const float* bx = F.in[9]; const float* lam = F.in[10];
    const bf16_t* ZP = (const bf16_t*)(F.ws + WS_ZP); bf16_t* MIX = (bf16_t*)(F.ws + WS_MIX);
    bf16x8 Afr[8];
    {
        const int gsel = (fr >> 1) & 1, ch = 2 * (fr >> 2) + (fr & 1);
        const float* Wg = (gsel ? wx : wa) + (size_t)hd * 4096 + 8 * s + ch;
#pragma unroll
        for (int ks = 0; ks < 8; ++ks) { const int j = ks >> 1, cb = 32 * (ks & 1) + 8 * fq; float v[8];
#pragma unroll
            for (int jj = 0; jj < 8; ++jj) { const int c = cb + jj; v[jj] = w4[j * DL + 64 * hd + c] * Wg[c * 64]; }
            u32x4 w; w.x = pk2(v[0], v[1]); w.y = pk2(v[2], v[3]); w.z = pk2(v[4], v[5]); w.w = pk2(v[6], v[7]);
            Afr[ks] = __builtin_bit_cast(bf16x8, w); }
    }
    float gb[4];
#pragma unroll
    for (int reg = 0; reg < 4; ++reg) { const int gsel = reg >> 1, ch = 2 * fq + (reg & 1); const float* Wg = (gsel ? wx : wa) + (size_t)hd * 4096 + 8 * s + ch;
        float a = 0.f;
#pragma unroll
        for (int i = 0; i < 4; ++i) { const int c = 4 * fr + i; a += b4[64 * hd + c] * Wg[c * 64]; }
        a += __shfl_xor(a, 1); a += __shfl_xor(a, 2); a += __shfl_xor(a, 4); a += __shfl_xor(a, 8);
        gb[reg] = a + (gsel ? bx : ba)[64 * hd + 8 * s + ch]; }
    float sp8[2], w4c[4][2], b4c[2];
#pragma unroll
    for (int e = 0; e < 2; ++e) { const int cch = 64 * hd + 8 * s + 2 * fq + e; const float l = lam[cch]; sp8[e] = 8.0f * ((-l > 20.f) ? -l : log1pf(expf(-l))); b4c[e] = b4[cch];
#pragma unroll
        for (int j = 0; j < 4; ++j) w4c[j][e] = w4[j * DL + cch]; }
    float carryH[2] = {0.f, 0.f};
    LAS float* tot = (LAS float*)F.lds;
    LAS unsigned char* tile = F.lds + 1024 + wave * 12544;
    LAS unsigned char* otile = tile + 10368;
    const bf16_t* zx = ZP + (size_t)b * SEQ * NZ + 64 * hd + 8 * (lane & 7);
    const bf16_t* zg = ZP + (size_t)b * SEQ * NZ + 1024 + 64 * hd + 8 * s;
    u32x4 pf[9], pg;
#define LRU_ISSUE(ck_) do { const int tb_ = 512 * (ck_) + 64 * wave; \
        _Pragma("unroll") for (int i = 0; i < 9; ++i) { const int t_ = tb_ - 3 + 8 * i + (lane >> 3); const int tc_ = t_ < 0 ? 0 : (t_ > SEQ - 1 ? SEQ - 1 : t_); \
            const u32x4 v_ = *(const u32x4*)(zx + (size_t)tc_ * NZ); pf[i] = t_ >= 0 ? v_ : (u32x4){0u, 0u, 0u, 0u}; } \
        pg = *(const u32x4*)(zg + (size_t)(tb_ + lane) * NZ); } while (0)
    LRU_ISSUE(0);
#pragma unroll 1
    for (int ck = 0; ck < 8; ++ck) {
        const int tb = 512 * ck + 64 * wave;
#pragma unroll
        for (int i = 0; i < 9; ++i) *(LAS u32x4*)(tile + (8 * i + (lane >> 3)) * 144 + 16 * (lane & 7)) = pf[i];
        const u32x4 gcur = pg;
        if (ck < 7) LRU_ISSUE(ck + 1);
        f32x4 Dm[4];
#pragma unroll
        for (int m = 0; m < 4; ++m) { Dm[m] = (f32x4){0.f, 0.f, 0.f, 0.f};
#pragma unroll
            for (int ks = 0; ks < 8; ++ks) { const bf16x8 bfr = *(const LAS bf16x8*)(tile + (16 * m + fr + (ks >> 1)) * 144 + (32 * (ks & 1) + 8 * fq) * 2);
                Dm[m] = __builtin_amdgcn_mfma_f32_16x16x32_bf16(Afr[ks], bfr, Dm[m], 0, 0, 0); } }
        float P[4][2], Hh[4][2];
#pragma unroll
        for (int m = 0; m < 4; ++m) {
            float ain[2] = {b4c[0], b4c[1]};
#pragma unroll
            for (int j = 0; j < 4; ++j) { const unsigned xw = *(const LAS unsigned*)(tile + (16 * m + fr + j) * 144 + (8 * s + 2 * fq) * 2);
                ain[0] += w4c[j][0] * bflo(xw); ain[1] += w4c[j][1] * bfhi(xw); }
#pragma unroll
            for (int e = 0; e < 2; ++e) { const float r = sigmoidf_(Dm[m][e] + gb[e]), ig = sigmoidf_(Dm[m][2 + e] + gb[2 + e]);
                const float la = -r * sp8[e], a = fexp_(la), x2 = 2.0f * la;
                const float om = (x2 > -0.25f) ? -x2 * (1.0f + x2 * (0.5f + x2 * (0.16666667f + x2 * (0.041666668f + x2 * 0.0083333338f)))) : 1.0f - a * a;
                P[m][e] = a; Hh[m][e] = fsqrt_(om) * (ig * ain[e]); } }
        float cP[2] = {1.f, 1.f}, cH[2] = {0.f, 0.f};
#pragma unroll
        for (int m = 0; m < 4; ++m)
#pragma unroll
            for (int e = 0; e < 2; ++e) { float p = P[m][e], h = Hh[m][e];
                SCAN_STEP(1); SCAN_STEP(2); SCAN_STEP(4); SCAN_STEP(8);
                h = h + p * cH[e]; p = p * cP[e];
                P[m][e] = p; Hh[m][e] = h; cH[e] = bcast15(h); cP[e] = bcast15(p); }
        const int buf = ck & 1;
        if (fr == 0) {
#pragma unroll
            for (int e = 0; e < 2; ++e) { tot[((buf * 8 + wave) * 8 + 2 * fq + e) * 2 + 0] = cP[e]; tot[((buf * 8 + wave) * 8 + 2 * fq + e) * 2 + 1] = cH[e]; } }
        LDS_WAIT(); __syncthreads();
        float hin[2] = {carryH[0], carryH[1]}, hmine[2] = {0.f, 0.f};
#pragma unroll
        for (int w2 = 0; w2 < 8; ++w2) {
#pragma unroll
            for (int e = 0; e < 2; ++e) { if (w2 == wave) hmine[e] = hin[e];
                const float tp = tot[((buf * 8 + w2) * 8 + 2 * fq + e) * 2 + 0], th = tot[((buf * 8 + w2) * 8 + 2 * fq + e) * 2 + 1]; hin[e] = tp * hin[e] + th; } }
        carryH[0] = hin[0]; carryH[1] = hin[1];
#pragma unroll
        for (int m = 0; m < 4; ++m) *(LAS f32x2*)(otile + (16 * m + fr) * 32 + fq * 8) = (f32x2){Hh[m][0] + P[m][0] * hmine[0], Hh[m][1] + P[m][1] * hmine[1]};
        LDS_WAIT();
        const f32x4 h0 = *(const LAS f32x4*)(otile + lane * 32), h1 = *(const LAS f32x4*)(otile + lane * 32 + 16);
        u32x4 o; o.x = pk2(bflo(gcur.x) * h0.x, bfhi(gcur.x) * h0.y); o.y = pk2(bflo(gcur.y) * h0.z, bfhi(gcur.y) * h0.w);
        o.z = pk2(bflo(gcur.z) * h1.x, bfhi(gcur.z) * h1.y); o.w = pk2(bflo(gcur.w) * h1.z, bfhi(gcur.w) * h1.w);
        *(u32x4*)(MIX + ((size_t)b * SEQ + tb + lane) * D + 64 * hd + 8 * s) = o;
    }
#undef LRU_ISSUE
    __syncthreads();
}
#undef SCAN_STEP
__device__ __forceinline__ void conv31_unit(Frame& F, int unit) {
    constexpr int CT = 16;
    const int tid = F.tid, lane = F.lane, wave = F.wave, m0 = unit * 32, c2 = 2 * tid;
    const __amdgpu_buffer_rsrc_t rw = __builtin_amdgcn_make_buffer_rsrc((void*)F.in[11], 0, 31 * DC * 4, 0x00020000);
    const __amdgpu_buffer_rsrc_t rz = __builtin_amdgcn_make_buffer_rsrc((void*)(F.ws + WS_ZP), 0, M * NZ * 2, 0x00020000);
    bf16_t* MIX = (bf16_t*)(F.ws + WS_MIX);
    const f32x2 bs = *(const f32x2*)(F.in[12] + c2), g2 = *(const f32x2*)(F.in[13] + c2), b2 = *(const f32x2*)(F.in[14] + c2);
    LAS float* red = (LAS float*)(F.lds + 4096);
    LAS float* tot2 = (LAS float*)(F.lds + 4096 + 1024);
    f32x2 wj[31];
#pragma unroll
    for (int j = 0; j < 31; ++j) { const u32x2 t = __builtin_amdgcn_raw_buffer_load_b64(rw, c2 * 4, j * DC * 4, 0); wj[j] = __builtin_bit_cast(f32x2, t); }
#pragma unroll 1
    for (int pass = 0; pass < 32 / CT; ++pass) {
        const int tok0 = m0 + CT * pass, t0 = tok0 % SEQ;
        unsigned xin[CT + 30];
#pragma unroll
        for (int i = 0; i < CT + 30; ++i) { const int tt = t0 - 30 + i; const int row = tt >= 0 ? tok0 - 30 + i : tok0;
            const unsigned v = __builtin_amdgcn_raw_buffer_load_b32(rz, (2048 + c2) * 2, row * (NZ * 2), 0); xin[i] = tt >= 0 ? v : 0u; }
        float a0[CT], a1[CT];
#pragma unroll
        for (int o = 0; o < CT; ++o) { float x0 = bs.x, x1 = bs.y;
#pragma unroll
            for (int j = 0; j < 31; ++j) { x0 += wj[j].x * bflo(xin[o + j]); x1 += wj[j].y * bfhi(xin[o + j]); }
            a0[o] = x0; a1[o] = x1; }
#pragma unroll
        for (int o = 0; o < CT; ++o) { const float sm = wave_sum(a0[o] + a1[o]), sq = wave_sum(a0[o] * a0[o] + a1[o] * a1[o]);
            if (lane == 0) { red[(wave * CT + o) * 2] = sm; red[(wave * CT + o) * 2 + 1] = sq; } }
        LDS_WAIT(); __syncthreads();
        if (tid < 2 * CT) { float t = 0.f;
#pragma unroll
            for (int w2 = 0; w2 < 8; ++w2) t += red[w2 * 2 * CT + tid];
            tot2[tid] = t; }
        LDS_WAIT(); __syncthreads();
#pragma unroll
        for (int o = 0; o < CT; ++o) { const float mean = tot2[2 * o] * (1.0f / DC), var = tot2[2 * o + 1] * (1.0f / DC) - mean * mean, rstd = frsq_(var + LN_EPS);
            const float y0 = silu_((a0[o] - mean) * rstd * g2.x + b2.x), y1 = silu_((a1[o] - mean) * rstd * g2.y + b2.y);
            *(unsigned*)(MIX + (size_t)(tok0 + o) * D + 1024 + c2) = pk2(y0, y1); }
        __syncthreads();
    }
}

__device__ __forceinline__ void router_unit(Frame& F, int unit, bool publish) {
    const int tid = F.tid, lane = F.lane, wave = F.wave, m0 = 32 * unit;
    const float* Y1 = (const float*)(F.ws + WS_Y1); const float* g1 = F.in[16]; const float* b1 = F.in[17]; const float* WRT = (const float*)(F.ws + WS_WRT);
    bf16_t* H1 = (bf16_t*)(F.ws + WS_H1); float* stat1 = (float*)(F.ws + WS_STAT1);
    LAS float* st = (LAS float*)F.lds;
    LAS float* part = (LAS float*)(F.lds + 1024);
    LAS float* lgt = (LAS float*)(F.lds + 1024 + 24576);
    for (int i = 0; i < 4; ++i) { const int m = m0 + 4 * wave + i;
        const f32x4* yr = (const f32x4*)(Y1 + (size_t)m * D) + lane;
        f32x4 v[8]; float s = 0.f;
#pragma unroll
        for (int j = 0; j < 8; ++j) { v[j] = yr[64 * j]; s += (v[j].x + v[j].y) + (v[j].z + v[j].w); }
        const float mean = wave_sum(s) * (1.f / D); float s2 = 0.f;
#pragma unroll
        for (int j = 0; j < 8; ++j) { v[j] = v[j] - mean; s2 += (v[j].x * v[j].x + v[j].y * v[j].y) + (v[j].z * v[j].z + v[j].w * v[j].w); }
        const float rstd = 1.f / sqrtf(wave_sum(s2) * (1.f / D) + LN_EPS);
        u32x2* o8 = (u32x2*)(H1 + (size_t)m * D) + lane;
#pragma unroll
        for (int j = 0; j < 8; ++j) { const f32x4 g4 = ((const f32x4*)g1)[lane + 64 * j], b4 = ((const f32x4*)b1)[lane + 64 * j]; const f32x4 h = v[j] * rstd * g4 + b4;
            u32x2 w; w.x = pk2(h.x, h.y); w.y = pk2(h.z, h.w); o8[64 * j] = w; }
        if (lane == 0) { stat1[2 * m] = mean; stat1[2 * m + 1] = rstd; st[(4 * wave + i) * 2] = mean; st[(4 * wave + i) * 2 + 1] = rstd; } }
    LDS_WAIT(); __syncthreads();
    {
        const int mt = wave & 1, kp = wave >> 1, i = lane & 15, q = lane >> 4;
        const float mean = st[(16 * mt + i) * 2], rstd = st[(16 * mt + i) * 2 + 1];
        const float* yr = Y1 + (size_t)(m0 + 16 * mt + i) * D + 512 * kp + 4 * q; const float* gp = g1 + 512 * kp + 4 * q; const float* bp = b1 + 512 * kp + 4 * q;
        const float* wp = WRT + (size_t)i * D + 512 * kp + 4 * q;
        f32x4 acc0 = (f32x4){0.f, 0.f, 0.f, 0.f}, acc1 = acc0, acc2 = acc0;
#pragma unroll 4
        for (int jj = 0; jj < 32; ++jj) {
            const f32x4 y4 = *(const f32x4*)(yr + 16 * jj), g4 = *(const f32x4*)(gp + 16 * jj), b4 = *(const f32x4*)(bp + 16 * jj);
            const f32x4 a4 = ((y4 - mean) * rstd) * g4 + b4;
            const f32x4 w0 = *(const f32x4*)(wp + 16 * jj), w1 = *(const f32x4*)(wp + 16 * D + 16 * jj), w2 = *(const f32x4*)(wp + 32 * D + 16 * jj);
#pragma unroll
            for (int c = 0; c < 4; ++c) { acc0 = __builtin_amdgcn_mfma_f32_16x16x4f32(a4[c], w0[c], acc0, 0, 0, 0); acc1 = __builtin_amdgcn_mfma_f32_16x16x4f32(a4[c], w1[c], acc1, 0, 0, 0);
                acc2 = __builtin_amdgcn_mfma_f32_16x16x4f32(a4[c], w2[c], acc2, 0, 0, 0); }
        }
#pragma unroll
        for (int reg = 0; reg < 4; ++reg) { LAS float* pr = part + ((kp * 32) + 16 * mt + 4 * q + reg) * 48 + i; pr[0] = acc0[reg]; pr[16] = acc1[reg]; pr[32] = acc2[reg]; }
    }
    LDS_WAIT(); __syncthreads();
    for (int idx = tid; idx < 32 * 36; idx += NWAVES * 64) { const int tok = idx / 36, o = idx % 36;
        float v = (o < 4 ? F.in[19][o] : F.in[21][o - 4]);
#pragma unroll
        for (int kp = 0; kp < 4; ++kp) v += part[(kp * 32 + tok) * 48 + o];
        lgt[tok * 36 + o] = v; }
    LDS_WAIT(); __syncthreads();
    if (tid < 32 && publish) {
        const int m = m0 + tid; const LAS float* lg = lgt + tid * 36;
        unsigned* cnt = (unsigned*)(F.ws + WS_CTL) + CW_CNT; int* list = (int*)(F.ws + WS_LIST); float* ql = (float*)(F.ws + WS_QL); unsigned* route = (unsigned*)(F.ws + WS_ROUTE);
        int gs = 0; for (int j = 1; j < 4; ++j) if (lg[j] > lg[gs]) gs = j;
        float den = 0.f; for (int j = 0; j < 4; ++j) den += expf(lg[j] - lg[gs]);
        const float pg = 1.0f / den;
        const LAS float* le = lg + 4 + 8 * gs; int i0 = 0; for (int j = 1; j < 8; ++j) if (le[j] > le[i0]) i0 = j;
        int i1 = (i0 == 0) ? 1 : 0; for (int j = 0; j < 8; ++j) if (j != i0 && le[j] > le[i1]) i1 = j;
        const float ex = expf(le[i1] - le[i0]); const float q0 = pg / (1.0f + ex), q1 = pg * ex / (1.0f + ex);
        const int e0 = gs * 8 + i0, e1 = gs * 8 + i1;
        const unsigned p0 = atomicAdd(&cnt[e0], 1u), p1 = atomicAdd(&cnt[e1], 1u);
        list[e0 * 8192 + p0] = m; ql[e0 * 8192 + p0] = q0; list[e1 * 8192 + p1] = m; ql[e1 * 8192 + p1] = q1;
        unsigned* r = route + (size_t)m * 8; r[0] = e0; r[1] = e1; r[2] = __float_as_uint(q0); r[3] = __float_as_uint(q1); r[4] = p0; r[5] = p1;
    }
    __syncthreads();
}

__device__ __forceinline__ const LAS int* moe_tables(Frame& F) {
    LAS int* tab = (LAS int*)(F.lds + MISC_OFF + 256);
    if (F.tid == 0) { unsigned* cnt = (unsigned*)(F.ws + WS_CTL) + CW_CNT; int run = 0;
        for (int e = 0; e < NEXP; ++e) { const int c = (int)__hip_atomic_load(cnt + e, RLX_AGENT); tab[e] = run; tab[40 + e] = run * 256; tab[80 + e] = c; run += (c + 255) >> 8; }
        tab[32] = run; }
    LDS_WAIT(); __syncthreads();
    return tab;
}
struct MoeOrder {
    const LAS int* tab; const char* A; const char* Bt; const int* list; int npn, G, c; bool up;
    __device__ bool next(int i, pg8::Unit& u) const {
        const int L = i * G + c; if (L >= tab[32] * npn) return false;
        const int tt = L / npn, pn = L % npn; int e = 0; while (tab[e + 1] <= tt) ++e;
        const int mt = tt - tab[e];
        u.e = e; u.mt = mt; u.pn = pn; u.pm = (tab[40 + e] >> 8) + mt;
        if (up) { u.a = A; u.b = Bt + ((size_t)(e * 1024 + pn * 256)) * D * 2; }
        else { u.a = A + (size_t)(tab[40 + e] + mt * 256) * FF * 2; u.b = Bt + ((size_t)(e * D + pn * 256)) * FF * 2; }
        return true;
    }
    __device__ __forceinline__ void gather(const pg8::Unit& u, const int (&stR)[2], const int (&stC)[2], unsigned (&voff)[2][2]) const {
        const int cnt = tab[80 + u.e];
#pragma unroll
        for (int h = 0; h < 2; ++h)
#pragma unroll
            for (int i = 0; i < 2; ++i) { int pos = u.mt * 256 + h * 128 + stR[i]; if (pos >= cnt) pos = 0;
                const int tok = list[u.e * 8192 + pos]; voff[h][i] = (unsigned)(tok * D + stC[i]) * 2u; }
    }
};
struct EpiH {
    static constexpr bool PERM = true;
    bf16_t* HH; const float* ql; const LAS int* tab;
    __device__ __forceinline__ void operator()(const f32x4 (&acc)[2][2][4][2], const pg8::Unit& u, int wr, int wc, int fr, int fq) const {
        const int cnt = tab[80 + u.e];
#pragma unroll
        for (int ai = 0; ai < 2; ++ai)
#pragma unroll
            for (int m = 0; m < 4; ++m) { const int rl = ai * 128 + wr * 64 + m * 16 + fr, lr = u.mt * 256 + rl;
                const float q = lr < cnt ? ql[u.e * 8192 + lr] : 0.f;
                f32x4 v0 = acc[ai][0][m][0], v1 = acc[ai][0][m][1]; const f32x4 u0 = acc[ai][1][m][0], u1 = acc[ai][1][m][1];
#pragma unroll
                for (int j = 0; j < 4; ++j) { v0[j] = silu_(v0[j]) * u0[j] * q; v1[j] = silu_(v1[j]) * u1[j] * q; }
                u32x4 w; w.x = pg8::cvt_pk_bf16(v0[0], v0[1]); w.y = pg8::cvt_pk_bf16(v0[2], v0[3]); w.z = pg8::cvt_pk_bf16(v1[0], v1[1]); w.w = pg8::cvt_pk_bf16(v1[2], v1[3]);
                *(u32x4*)(HH + (size_t)(u.pm * 256 + rl) * FF + 128 * u.pn + wc * 32 + 8 * fq) = w; }
    }
};
struct EpiYf {
    static constexpr bool PERM = true;
    bf16_t* YF;
    __device__ __forceinline__ void operator()(const f32x4 (&acc)[2][2][4][2], const pg8::Unit& u, int wr, int wc, int fr, int fq) const {
#pragma unroll
        for (int ai = 0; ai < 2; ++ai)
#pragma unroll
            for (int m = 0; m < 4; ++m) { bf16_t* rowp = YF + (size_t)(u.pm * 256 + ai * 128 + wr * 64 + m * 16 + fr) * D + u.pn * 256 + wc * 32 + 8 * fq;
#pragma unroll
                for (int bj = 0; bj < 2; ++bj) { const f32x4 v0 = acc[ai][bj][m][0], v1 = acc[ai][bj][m][1];
                    u32x4 w; w.x = pg8::cvt_pk_bf16(v0[0], v0[1]); w.y = pg8::cvt_pk_bf16(v0[2], v0[3]); w.z = pg8::cvt_pk_bf16(v1[0], v1[1]); w.w = pg8::cvt_pk_bf16(v1[2], v1[3]);
                    *(u32x4*)(rowp + bj * 128) = w; } }
    }
};

__device__ __forceinline__ void final_phase(Frame& F, const LAS int* tab) {
    const int gw = F.vcu * NWAVES + F.wave, NGW = F.G * NWAVES, lane = F.lane;
    const float* Y1 = (const float*)(F.ws + WS_Y1); const float* stat1 = (const float*)(F.ws + WS_STAT1); const unsigned* route = (const unsigned*)(F.ws + WS_ROUTE);
    const bf16_t* YF = (const bf16_t*)(F.ws + WS_YF); const float* g1 = F.in[16]; const float* b1 = F.in[17]; const float* g2 = F.in[25]; const float* b2 = F.in[26];
    for (int m = gw; m < M; m += NGW) {
        const unsigned* r = route + (size_t)m * 8;
        const int s0 = tab[40 + (int)r[0]] + (int)r[4], s1 = tab[40 + (int)r[1]] + (int)r[5];
        const float mean1 = stat1[2 * m], rstd1 = stat1[2 * m + 1];
        const f32x4* yr = (const f32x4*)(Y1 + (size_t)m * D) + lane;
        const u32x2* f0 = (const u32x2*)(YF + (size_t)s0 * D) + lane; const u32x2* f1 = (const u32x2*)(YF + (size_t)s1 * D) + lane;
        f32x4 v[8]; float s = 0.f;
#pragma unroll
        for (int j = 0; j < 8; ++j) { const f32x4 y = yr[64 * j], g4 = ((const f32x4*)g1)[lane + 64 * j], b4 = ((const f32x4*)b1)[lane + 64 * j];
            const u32x2 a = f0[64 * j], c = f1[64 * j];
            const f32x4 ff = (f32x4){bflo(a.x) + bflo(c.x), bfhi(a.x) + bfhi(c.x), bflo(a.y) + bflo(c.y), bfhi(a.y) + bfhi(c.y)};
            v[j] = (((y - mean1) * rstd1) * g4 + b4) * ALPHA + ff; s += (v[j].x + v[j].y) + (v[j].z + v[j].w); }
        const float mean = wave_sum(s) * (1.f / D); float s2 = 0.f;
#pragma unroll
        for (int j = 0; j < 8; ++j) { v[j] = v[j] - mean; s2 += (v[j].x * v[j].x + v[j].y * v[j].y) + (v[j].z * v[j].z + v[j].w * v[j].w); }
        const float rstd = 1.f / sqrtf(wave_sum(s2) * (1.f / D) + LN_EPS);
        f32x4* o = (f32x4*)(F.out + (size_t)m * D) + lane;
#pragma unroll
        for (int j = 0; j < 8; ++j) { const f32x4 g4 = ((const f32x4*)g2)[lane + 64 * j], b4 = ((const f32x4*)b2)[lane + 64 * j]; o[64 * j] = (v[j] * rstd) * g4 + b4; }
    }
}

#ifndef FAST_MASK
#define FAST_MASK 0xFF
#endif
#ifndef HOST_REP
#define HOST_REP -1
#endif
#ifndef REP_SUB
#define REP_SUB 1
#endif
#ifndef ONE_LAUNCH
#define ONE_LAUNCH 1
#endif
constexpr int NPHASE = 8;
__global__ void __launch_bounds__(NWAVES * 64, 2) mk(Args args) {
    extern __shared__ __attribute__((aligned(16))) unsigned char lds_raw[];
    Frame F;
    F.lds = (LAS unsigned char*)lds_raw; F.MISC = (volatile LAS unsigned*)(F.lds + MISC_OFF);
    F.tid = threadIdx.x; F.lane = F.tid & 63; F.wave = __builtin_amdgcn_readfirstlane(F.tid >> 6);
    F.G = gridDim.x; { const int bx = blockIdx.x; F.vcu = (F.G % 8 == 0) ? (bx % 8) * (F.G / 8) + bx / 8 : bx; }
    F.in = args.in; F.out = args.out; F.ws = args.ws;
    unsigned char* ws = args.ws;
    const int lo = args.ph_lo, hi = args.ph_hi;
    for (int u = F.tid; u < 64; u += NWAVES * 64) F.MISC[u] = 0u;
    __syncthreads();
    XcdBarrier bar; bar.bar = (unsigned*)(ws + WS_CTL) + CW_BAR + lo * XCD_BAR_WORDS; bar.x = 0; bar.st = nullptr;
    if (hi - lo > 1) bar = xcd_barrier_post((unsigned*)(ws + WS_CTL) + CW_BAR + lo * XCD_BAR_WORDS, F.MISC + 8);
#ifndef PH_EN
#define PH_EN 0xFF
#endif
#define IN(k) (((PH_EN >> (k)) & 1) && lo <= (k) && (k) < hi)
#define SEAM(k) do { if (IN(k) && IN((k) + 1)) xcd_barrier(bar); } while (0)

#ifndef REP_PHASE
#define REP_PHASE -1
#endif
#define REPS(k) for (int rep_ = 0; rep_ < ((REP_PHASE == (k)) ? 2 : 1); ++rep_)
#define REP_BAR(k) do { if (REP_PHASE == (k) && rep_ == 0 && hi - lo > 1) xcd_barrier(bar); } while (0)
    if (IN(0)) { REPS(0) { p0_prologue(F); REP_BAR(0); } SEAM(0); }
    if (IN(1)) {
        REPS(1) {
        pg8::DenseOrder S; S.init(ws + WS_H0, ws + WS_BT1, M, 4096, D, F.G, (int)blockIdx.x);
        EpiZ E{(bf16_t*)(ws + WS_ZP)};
        pg8::gemm_phase<EpiZ, pg8::DenseOrder, false, MK_ALIGN, MK_SP2>(F.lds, D, S, E);
        REP_BAR(1); }
        SEAM(1);
    }
    if (IN(2)) {
        REPS(2) {
        if (args.rep != 2) for (int u = F.vcu; u < 256; u += F.G) lru_unit(F, u);
        if (args.rep != 1) for (int u = F.vcu; u < 256; u += F.G) conv31_unit(F, u);
        REP_BAR(2); }
        SEAM(2);
    }
    if (IN(3)) {
        REPS(3) {
        pg8::DenseOrder S; S.init(ws + WS_MIX, ws + WS_BT2, M, D, D, F.G, (int)blockIdx.x);
        EpiY1 E{(float*)(ws + WS_Y1), F.in[0], (const float*)(ws + WS_STAT0), F.in[1], F.in[2]};
        pg8::gemm_phase<EpiY1, pg8::DenseOrder, false, MK_ALIGN, MK_SP2>(F.lds, D, S, E);
        REP_BAR(3); }
        SEAM(3);
    }
    if (IN(4)) {
        REPS(4) {
        for (int u = F.vcu; u < 256; u += F.G) router_unit(F, u, args.rep == 0);
        REP_BAR(4); }
        SEAM(4);
    }
    if (IN(5)) {
        REPS(5) {
        const LAS int* tab = moe_tables(F);
        MoeOrder S{tab, (const char*)(ws + WS_H1), (const char*)(ws + WS_BTU), (const int*)(ws + WS_LIST), 4, F.G, F.vcu, true};
        EpiH E{(bf16_t*)(ws + WS_HH), (const float*)(ws + WS_QL), tab};
        pg8::gemm_phase<EpiH, MoeOrder, true, MK_ALIGN, MK_SP2>(F.lds, D, S, E);
        REP_BAR(5); }
        SEAM(5);
    }
    if (IN(6)) {
        REPS(6) {
        const LAS int* tab = moe_tables(F);
        MoeOrder S{tab, (const char*)(ws + WS_HH), (const char*)(ws + WS_BTD), (const int*)(ws + WS_LIST), 8, F.G, F.vcu, false};
        EpiYf E{(bf16_t*)(ws + WS_YF)};
        pg8::gemm_phase<EpiYf, MoeOrder, false, MK_ALIGN, MK_SP2>(F.lds, FF, S, E);
        REP_BAR(6); }
        SEAM(6);
    }
    if (IN(7)) {
        REPS(7) {
        const LAS int* tab = moe_tables(F);
        final_phase(F, tab);
        REP_BAR(7); }
    }
#undef IN
#undef SEAM
}

extern "C" void kernel_launch(void* const* d_in, const int* in_sizes, int n_in, void* d_out, int out_size, void* d_ws, size_t ws_size, hipStream_t stream) {
    static int grid = 0;
    if (grid == 0) {
        if (n_in != 27 || in_sizes[0] != M * D || out_size != M * D || ws_size < WS_NEED) {
            fprintf(stderr, "kernel_launch: unexpected shapes (n_in %d, in0 %d, out %d, ws %zu); nothing launched\n", n_in, n_in > 0 ? in_sizes[0] : -1, out_size, ws_size); grid = -1; return; }
        int dev = 0, cus = 0, per_cu = 0;
        if (hipGetDevice(&dev) != hipSuccess || hipDeviceGetAttribute(&cus, hipDeviceAttributeMultiprocessorCount, dev) != hipSuccess) { grid = -1; return; }
        if (hipFuncSetAttribute((const void*)mk, hipFuncAttributeMaxDynamicSharedMemorySize, LDS_BYTES) != hipSuccess) { fprintf(stderr, "kernel_launch: hipFuncSetAttribute failed\n"); grid = -1; return; }
        if (hipOccupancyMaxActiveBlocksPerMultiprocessor(&per_cu, (const void*)mk, NWAVES * 64, LDS_BYTES) != hipSuccess || per_cu < 1) { fprintf(stderr, "kernel_launch: occupancy query says %d blocks per CU\n", per_cu); (void)hipGetLastError(); grid = -1; return; }
        grid = cus;
    }
    if (grid < 0) return;
    const float* const* in = (const float* const*)d_in;
    unsigned char* ws = (unsigned char*)d_ws;
    (void)hipMemsetAsync(ws + WS_CTL, 0, CTL_ZERO_BYTES, stream);
    float* stat0 = (float*)(ws + WS_STAT0); float* stat1 = (float*)(ws + WS_STAT1); unsigned* route = (unsigned*)(ws + WS_ROUTE);
    int* list = (int*)(ws + WS_LIST); float* ql = (float*)(ws + WS_QL); unsigned* cnt = (unsigned*)(ws + WS_CTL) + CW_CNT;
    bf16_t* H0 = (bf16_t*)(ws + WS_H0); bf16_t* ZP = (bf16_t*)(ws + WS_ZP); bf16_t* MIX = (bf16_t*)(ws + WS_MIX); float* Y1 = (float*)(ws + WS_Y1);
    bf16_t* H1 = (bf16_t*)(ws + WS_H1); bf16_t* HH = (bf16_t*)(ws + WS_HH); bf16_t* YF = (bf16_t*)(ws + WS_YF);
    float* ZRAW = (float*)(ws + WS_ZRAW); float* AIN = (float*)(ws + WS_AIN); float* ADEC = (float*)(ws + WS_ADEC); float* U = (float*)(ws + WS_U);
    Args a{};
    for (int i = 0; i < 27; ++i) a.in[i] = in[i];
    a.out = (float*)d_out; a.ws = ws;
    for (int p = 0; p < NPHASE;) {
        if ((FAST_MASK >> p) & 1) {
            int q = p + 1;
            if (ONE_LAUNCH) while (q < NPHASE && ((FAST_MASK >> q) & 1) && q != HOST_REP && (q - 1) != HOST_REP) ++q;
            a.ph_lo = p; a.ph_hi = q;
            hipLaunchKernelGGL(mk, dim3(grid), dim3(NWAVES * 64), LDS_BYTES, stream, a);
            if (p == HOST_REP) { a.rep = REP_SUB; hipLaunchKernelGGL(mk, dim3(grid), dim3(NWAVES * 64), LDS_BYTES, stream, a); a.rep = 0; }
            p = q; continue;
        }
        switch (p) {
        case 0:
            nv_ln_in<<<M, 256, 0, stream>>>(in[0], in[1], in[2], H0, stat0);
            break;
        case 1:
            nv_gemm<<<dim3(4096 / 64, M / 64), 256, 0, stream>>>(H0, in[3], ZRAW, M, 4096, D);
            nv_zprime<<<(unsigned)(((size_t)M * NZ + 255) / 256), 256, 0, stream>>>(ZRAW, ZP);
            break;
        case 2:
            nv_lru1<<<(M * DL + 255) / 256, 256, 0, stream>>>(ZP, in[4], in[5], AIN);
            nv_lru2<<<(M * DL + 255) / 256, 256, 0, stream>>>(AIN, in[6], in[7], in[8], in[9], in[10], ADEC, U);
            nv_lru3<<<(2 * DL + 255) / 256, 256, 0, stream>>>(ADEC, U, ZP, MIX);
            nv_conv31<<<M, 256, 0, stream>>>(ZP, in[11], in[12], in[13], in[14], MIX);
            break;
        case 3:
            nv_gemm<<<dim3(D / 64, M / 64), 256, 0, stream>>>(MIX, in[15], Y1, M, D, D);
            nv_y1<<<(unsigned)(((size_t)M * D + 255) / 256), 256, 0, stream>>>(Y1, in[0], stat0, in[1], in[2]);
            break;
        case 4:
            nv_router<<<M, 256, 0, stream>>>(Y1, in[16], in[17], in[18], in[19], in[20], in[21], H1, stat1, route, cnt, list, ql);
            break;
        case 5:
            nv_moe_up<<<2 * M, 512, 0, stream>>>(H1, route, cnt, in[22], in[23], HH);
            break;
        case 6:
            nv_moe_down<<<2 * M, 512, 0, stream>>>(HH, route, cnt, in[24], YF);
            break;
        case 7:
            nv_final<<<M, 256, 0, stream>>>(Y1, stat1, in[16], in[17], route, cnt, YF, in[25], in[26], (float*)d_out);
            break;
        }
        ++p;
    }
}
```

```cpp
#include <hip/hip_runtime.h>
#include <cstdio>
#include <cstdint>

constexpr int D = 2048, SEQ = 4096, M = 8192;
constexpr int DL = 1024, DC = 1024, NH = 16, HDIM = 64;
constexpr int NGRP = 4, NEXPG = 8, NEXP = 32, FF = 512;
constexpr int NZ = 3072;
constexpr float LN_EPS = 1e-5f;
constexpr float ALPHA = 1.189207115002721f;
constexpr int SLOT_ROWS = 24576;

typedef unsigned short bf16_t;
typedef float f32x4 __attribute__((ext_vector_type(4)));
typedef float f32x2 __attribute__((ext_vector_type(2)));
typedef short bf16x8 __attribute__((ext_vector_type(8)));
typedef unsigned u32x4 __attribute__((ext_vector_type(4)));
typedef unsigned u32x2 __attribute__((ext_vector_type(2)));

constexpr size_t MiB = 1u << 20;
constexpr size_t WS_CTL = 0, CTL_ZERO_BYTES = 1 * MiB;
constexpr size_t WS_STAT0 = 1 * MiB;
constexpr size_t WS_STAT1 = 1 * MiB + 65536;
constexpr size_t WS_ROUTE = 1 * MiB + 131072;
constexpr size_t WS_LIST = 2 * MiB;
constexpr size_t WS_QL = 3 * MiB;
constexpr size_t WS_BT1 = 8 * MiB;
constexpr size_t WS_BT2 = 24 * MiB;
constexpr size_t WS_BTU = 32 * MiB;
constexpr size_t WS_BTD = 160 * MiB;
constexpr size_t WS_Y1 = 224 * MiB;
constexpr size_t WS_H0 = 288 * MiB;
constexpr size_t WS_ZP = 320 * MiB;
constexpr size_t WS_MIX = 368 * MiB;
constexpr size_t WS_H1 = 288 * MiB;
constexpr size_t WS_HH = 320 * MiB;
constexpr size_t WS_YF = 344 * MiB;
constexpr size_t WS_ZRAW = 368 * MiB;
constexpr size_t WS_AIN = 400 * MiB;
constexpr size_t WS_ADEC = 440 * MiB;
constexpr size_t WS_U = 472 * MiB;
constexpr size_t WS_NEED = 504 * MiB;
constexpr int CW_CNT = 1024;

struct Args { const float* in[27]; float* out; unsigned char* ws; int ph_lo, ph_hi, rep, pad; };

__device__ __forceinline__ float bf2f(bf16_t v) { return __uint_as_float((unsigned)v << 16); }
__device__ __forceinline__ unsigned f2bf(float f) { unsigned u = __float_as_uint(f); return (u + 0x7fffu + ((u >> 16) & 1u)) >> 16; }
__device__ __forceinline__ float frcp_(float x) { return __builtin_amdgcn_rcpf(x); }
__device__ __forceinline__ float fexp_(float x) { return __builtin_amdgcn_exp2f(1.4426950408889634f * x); }
__device__ __forceinline__ float fsqrt_(float x) { return __builtin_amdgcn_sqrtf(x); }
__device__ __forceinline__ float frsq_(float x) { return __builtin_amdgcn_rsqf(x); }
__device__ __forceinline__ float sigmoidf_(float x) { return frcp_(1.0f + __builtin_amdgcn_exp2f(-1.4426950408889634f * x)); }
__device__ __forceinline__ float gelu_tanh(float x) { const float u = 1.5957691216057308f * (x + 0.044715f * x * x * x); return x * sigmoidf_(u); }
__device__ __forceinline__ float silu_(float x) { return x * sigmoidf_(x); }

__device__ __forceinline__ float block_sum256(float v, float* red) {
    red[threadIdx.x] = v; __syncthreads();
    for (int s = 128; s > 0; s >>= 1) { if ((int)threadIdx.x < s) red[threadIdx.x] += red[threadIdx.x + s]; __syncthreads(); }
    const float r = red[0]; __syncthreads(); return r;
}
__global__ void __launch_bounds__(256) nv_ln_in(const float* x, const float* g, const float* b, bf16_t* H0, float* stat) {
    __shared__ float red[256];
    const int m = blockIdx.x; const float* xr = x + (size_t)m * D;
    float s = 0.f; for (int c = threadIdx.x; c < D; c += 256) s += xr[c];
    const float mean = block_sum256(s, red) * (1.0f / D);
    float q = 0.f; for (int c = threadIdx.x; c < D; c += 256) { const float d = xr[c] - mean; q += d * d; }
    const float rstd = 1.0f / sqrtf(block_sum256(q, red) * (1.0f / D) + LN_EPS);
    for (int c = threadIdx.x; c < D; c += 256) H0[(size_t)m * D + c] = (bf16_t)f2bf((xr[c] - mean) * rstd * g[c] + b[c]);
    if (threadIdx.x == 0) { stat[2 * m] = mean; stat[2 * m + 1] = rstd; }
}
__host__ __device__ __forceinline__ int dst_row(int n, int mode) {
    if (mode == 0) return n;
    if (mode == 1) { if (n < 2048) return n; if (n < 3072) { const int s = n - 2048; return 2048 + 256 * (s >> 7) + (s & 127); } const int s = n - 3072; return 2048 + 256 * (s >> 7) + 128 + (s & 127); }
    if (mode == 2) return 256 * (n >> 7) + (n & 127);
    return 256 * (n >> 7) + 128 + (n & 127);
}
__global__ void __launch_bounds__(256) nv_transpose(const float* W, int K, int N, bf16_t* WT, int mode) {
    const size_t idx = (size_t)blockIdx.x * 256 + threadIdx.x; if (idx >= (size_t)K * N) return;
    const int n = (int)(idx % N), k = (int)(idx / N);
    WT[(size_t)dst_row(n, mode) * K + k] = (bf16_t)f2bf(W[idx]);
}
__global__ void __launch_bounds__(256) nv_gemm(const bf16_t* A, const float* B, float* C, int Mr, int N, int K) {
    __shared__ float As[16][65], Bs[16][65];
    const int tx = threadIdx.x & 15, ty = threadIdx.x >> 4, m0 = blockIdx.y * 64, n0 = blockIdx.x * 64;
    float acc[4][4] = {};
    for (int k0 = 0; k0 < K; k0 += 16) {
        for (int i = threadIdx.x; i < 64 * 16; i += 256) { const int r = i >> 4, kk = i & 15; As[kk][r] = bf2f(A[(size_t)(m0 + r) * K + k0 + kk]); }
        for (int i = threadIdx.x; i < 64 * 16; i += 256) { const int kk = i >> 6, c = i & 63; Bs[kk][c] = B[(size_t)(k0 + kk) * N + n0 + c]; }
        __syncthreads();
#pragma unroll
        for (int kk = 0; kk < 16; ++kk) {
            float a[4], b[4];
#pragma unroll
            for (int i = 0; i < 4; ++i) { a[i] = As[kk][ty * 4 + i]; b[i] = Bs[kk][tx * 4 + i]; }
#pragma unroll
            for (int i = 0; i < 4; ++i)
#pragma unroll
                for (int j = 0; j < 4; ++j) acc[i][j] += a[i] * b[j];
        }
        __syncthreads();
    }
    for (int i = 0; i < 4; ++i) for (int j = 0; j < 4; ++j) C[(size_t)(m0 + ty * 4 + i) * N + n0 + tx * 4 + j] = acc[i][j];
}
__global__ void __launch_bounds__(256) nv_zprime(const float* zraw, bf16_t* ZP) {
    const size_t idx = (size_t)blockIdx.x * 256 + threadIdx.x; if (idx >= (size_t)M * NZ) return;
    const int c = (int)(idx % NZ); const size_t m = idx / NZ; const float* zr = zraw + m * 4096;
    float v;
    if (c < 1024) v = zr[c]; else if (c < 2048) v = gelu_tanh(zr[c]); else v = zr[c] * sigmoidf_(zr[c + 1024]);
    ZP[idx] = (bf16_t)f2bf(v);
}
__global__ void __launch_bounds__(256) nv_lru1(const bf16_t* ZP, const float* w4, const float* b4, float* AIN) {
    const size_t idx = (size_t)blockIdx.x * 256 + threadIdx.x; if (idx >= (size_t)M * DL) return;
    const int c = (int)(idx % DL); const int m = (int)(idx / DL), t = m % SEQ;
    float s = b4[c];
    for (int j = 0; j < 4; ++j) { const int tt = t - 3 + j; if (tt >= 0) s += w4[j * DL + c] * bf2f(ZP[(size_t)(m - 3 + j) * NZ + c]); }
    AIN[idx] = s;
}
__global__ void __launch_bounds__(256) nv_lru2(const float* AIN, const float* wa, const float* ba, const float* wx, const float* bx, const float* lam, float* ADEC, float* U) {
    const size_t idx = (size_t)blockIdx.x * 256 + threadIdx.x; if (idx >= (size_t)M * DL) return;
    const int c = (int)(idx % DL); const size_t m = idx / DL; const int h = c >> 6, j = c & 63;
    const float* ar = AIN + m * DL + h * 64;
    float sr = ba[c], si = bx[c];
    for (int i = 0; i < 64; ++i) { const float a = ar[i]; sr += a * wa[(size_t)(h * 64 + i) * 64 + j]; si += a * wx[(size_t)(h * 64 + i) * 64 + j]; }
    const float r = sigmoidf_(sr), ig = sigmoidf_(si);
    const float l = lam[c]; const float sp = (-l > 20.f) ? -l : log1pf(expf(-l));
    const float log_a = -8.0f * r * sp; const float a = expf(log_a);
    ADEC[idx] = a; U[idx] = sqrtf(-expm1f(2.0f * log_a)) * (ig * ar[j]);
}
__global__ void __launch_bounds__(256) nv_lru3(const float* ADEC, const float* U, const bf16_t* ZP, bf16_t* MIX) {
    const int idx = blockIdx.x * 256 + threadIdx.x; if (idx >= 2 * DL) return;
    const int b = idx / DL, c = idx % DL; float h = 0.f;
    for (int t = 0; t < SEQ; ++t) { const size_t m = (size_t)b * SEQ + t; h = ADEC[m * DL + c] * h + U[m * DL + c]; MIX[m * D + c] = (bf16_t)f2bf(bf2f(ZP[m * NZ + 1024 + c]) * h); }
}
__global__ void __launch_bounds__(256) nv_conv31(const bf16_t* ZP, const float* w, const float* bias, const float* g, const float* b, bf16_t* MIX) {
    __shared__ float red[256];
    const int m = blockIdx.x, t = m % SEQ; float v[4]; float s = 0.f;
    for (int i = 0; i < 4; ++i) { const int c = threadIdx.x + 256 * i; float a = bias[c];
        for (int j = 0; j < 31; ++j) { const int tt = t - 30 + j; if (tt >= 0) a += w[j * DC + c] * bf2f(ZP[(size_t)(m - 30 + j) * NZ + 2048 + c]); }
        v[i] = a; s += a; }
    const float mean = block_sum256(s, red) * (1.0f / DC); float q = 0.f;
    for (int i = 0; i < 4; ++i) { const float d = v[i] - mean; q += d * d; }
    const float rstd = 1.0f / sqrtf(block_sum256(q, red) * (1.0f / DC) + LN_EPS);
    for (int i = 0; i < 4; ++i) { const int c = threadIdx.x + 256 * i; MIX[(size_t)m * D + 1024 + c] = (bf16_t)f2bf(silu_((v[i] - mean) * rstd * g[c] + b[c])); }
}
__global__ void __launch_bounds__(256) nv_y1(float* Y1, const float* x, const float* stat0, const float* g, const float* b) {
    const size_t idx = (size_t)blockIdx.x * 256 + threadIdx.x; if (idx >= (size_t)M * D) return;
    const int c = (int)(idx % D); const size_t m = idx / D;
    Y1[idx] += ALPHA * ((x[idx] - stat0[2 * m]) * stat0[2 * m + 1] * g[c] + b[c]);
}
__global__ void __launch_bounds__(256) nv_router(const float* Y1, const float* g1, const float* b1, const float* wg, const float* bg, const float* we, const float* be,
                                                 bf16_t* H1, float* stat1, unsigned* route, unsigned* cnt, int* list, float* ql) {
    __shared__ float red[256]; __shared__ float lg[36];
    const int m = blockIdx.x; const float* yr = Y1 + (size_t)m * D;
    float s = 0.f; for (int c = threadIdx.x; c < D; c += 256) s += yr[c];
    const float mean = block_sum256(s, red) * (1.0f / D);
    float q = 0.f; for (int c = threadIdx.x; c < D; c += 256) { const float d = yr[c] - mean; q += d * d; }
    const float rstd = 1.0f / sqrtf(block_sum256(q, red) * (1.0f / D) + LN_EPS);
    float hv[8];
    for (int i = 0; i < 8; ++i) { const int c = threadIdx.x + 256 * i; hv[i] = (yr[c] - mean) * rstd * g1[c] + b1[c]; H1[(size_t)m * D + c] = (bf16_t)f2bf(hv[i]); }
    for (int o = 0; o < 36; ++o) { float p = 0.f;
        for (int i = 0; i < 8; ++i) { const int c = threadIdx.x + 256 * i; p += hv[i] * (o < 4 ? wg[c * 4 + o] : we[c * 32 + (o - 4)]); }
        p = block_sum256(p, red); if (threadIdx.x == 0) lg[o] = p + (o < 4 ? bg[o] : be[o - 4]); }
    __syncthreads();
    if (threadIdx.x == 0) {
        stat1[2 * m] = mean; stat1[2 * m + 1] = rstd;
        int gs = 0; for (int j = 1; j < 4; ++j) if (lg[j] > lg[gs]) gs = j;
        float den = 0.f; for (int j = 0; j < 4; ++j) den += expf(lg[j] - lg[gs]);
        const float pg = 1.0f / den;
        const float* le = lg + 4 + 8 * gs; int i0 = 0; for (int j = 1; j < 8; ++j) if (le[j] > le[i0]) i0 = j;
        int i1 = (i0 == 0) ? 1 : 0; for (int j = 0; j < 8; ++j) if (j != i0 && le[j] > le[i1]) i1 = j;
        const float ex = expf(le[i1] - le[i0]); const float q0 = pg / (1.0f + ex), q1 = pg * ex / (1.0f + ex);
        const int e0 = gs * 8 + i0, e1 = gs * 8 + i1;
        const unsigned p0 = atomicAdd(&cnt[e0], 1u), p1 = atomicAdd(&cnt[e1], 1u);
        list[e0 * 8192 + p0] = m; ql[e0 * 8192 + p0] = q0; list[e1 * 8192 + p1] = m; ql[e1 * 8192 + p1] = q1;
        unsigned* r = route + (size_t)m * 8; r[0] = e0; r[1] = e1; r[2] = __float_as_uint(q0); r[3] = __float_as_uint(q1); r[4] = p0; r[5] = p1;
    }
}
__device__ __forceinline__ int slot_off(const unsigned* cnt, int e) { int o = 0; for (int j = 0; j < e; ++j) o += ((int)cnt[j] + 255) & ~255; return o; }
__global__ void __launch_bounds__(512) nv_moe_up(const bf16_t* H1, const unsigned* route, const unsigned* cnt, const float* wgate, const float* wup, bf16_t* HH) {
    __shared__ float xs[D];
    const int m = blockIdx.x >> 1, k = blockIdx.x & 1; const unsigned* r = route + (size_t)m * 8;
    const int e = (int)r[k]; const float q = __uint_as_float(r[2 + k]); const int slot = slot_off(cnt, e) + (int)r[4 + k];
    for (int c = threadIdx.x; c < D; c += 512) xs[c] = bf2f(H1[(size_t)m * D + c]);
    __syncthreads();
    const int f = threadIdx.x; const float* wgp = wgate + (size_t)e * D * FF + f; const float* wup_ = wup + (size_t)e * D * FF + f;
    float g = 0.f, u = 0.f;
    for (int d = 0; d < D; ++d) { g += xs[d] * wgp[(size_t)d * FF]; u += xs[d] * wup_[(size_t)d * FF]; }
    HH[(size_t)slot * FF + f] = (bf16_t)f2bf(silu_(g) * u * q);
}
__global__ void __launch_bounds__(512) nv_moe_down(const bf16_t* HH, const unsigned* route, const unsigned* cnt, const float* wdown, bf16_t* YF) {
    __shared__ float hs[FF];
    const int m = blockIdx.x >> 1, k = blockIdx.x & 1; const unsigned* r = route + (size_t)m * 8;
    const int e = (int)r[k]; const int slot = slot_off(cnt, e) + (int)r[4 + k];
    hs[threadIdx.x] = bf2f(HH[(size_t)slot * FF + threadIdx.x]);
    __syncthreads();
    const float* wd = wdown + (size_t)e * FF * D;
    for (int i = 0; i < 4; ++i) { const int d = threadIdx.x + 512 * i; float y = 0.f;
        for (int f = 0; f < FF; ++f) y += hs[f] * wd[(size_t)f * D + d];
        YF[(size_t)slot * D + d] = (bf16_t)f2bf(y); }
}
__global__ void __launch_bounds__(256) nv_final(const float* Y1, const float* stat1, const float* g1, const float* b1, const unsigned* route, const unsigned* cnt, const bf16_t* YF,
                                                const float* g2, const float* b2, float* out) {
    __shared__ float red[256];
    const int m = blockIdx.x; const unsigned* r = route + (size_t)m * 8;
    const int s0 = slot_off(cnt, (int)r[0]) + (int)r[4], s1 = slot_off(cnt, (int)r[1]) + (int)r[5];
    const float mean1 = stat1[2 * m], rstd1 = stat1[2 * m + 1];
    float v[8]; float s = 0.f;
    for (int i = 0; i < 8; ++i) { const int c = threadIdx.x + 256 * i;
        const float h1 = (Y1[(size_t)m * D + c] - mean1) * rstd1 * g1[c] + b1[c];
        v[i] = ALPHA * h1 + (bf2f(YF[(size_t)s0 * D + c]) + bf2f(YF[(size_t)s1 * D + c])); s += v[i]; }
    const float mean = block_sum256(s, red) * (1.0f / D); float q = 0.f;
    for (int i = 0; i < 8; ++i) { const float d = v[i] - mean; q += d * d; }
    const float rstd = 1.0f / sqrtf(block_sum256(q, red) * (1.0f / D) + LN_EPS);
    for (int i = 0; i < 8; ++i) { const int c = threadIdx.x + 256 * i; out[(size_t)m * D + c] = (v[i] - mean) * rstd * g2[c] + b2[c]; }
}


#define LAS __attribute__((address_space(3)))
#define GAS __attribute__((address_space(1)))
namespace pg8 {
constexpr int BM = 256, BK = 64, HALF = 128, HTB = HALF * BK * 2, STAGE_BYTES = 8 * HTB, NXCD = 8, WGM = 8;
__host__ __device__ __forceinline__ int lds_byte(int r, int c) { const int st = (r >> 4) * 2 + (c >> 5), rr = r & 15, cc = c & 31, ob = rr * 64 + cc * 2; return st * 1024 + (ob ^ (((ob >> 9) & 1) << 5)); }
__host__ __device__ __forceinline__ void stage_rc(int b, int& R, int& C) { const int st = b / 1024, sb = b % 1024, swz = sb ^ (((sb >> 9) & 1) << 5); R = (st >> 1) * 16 + swz / 64; C = (st & 1) * 32 + (swz % 64) / 2; }
__host__ __device__ __forceinline__ int perm32(int rho) { const int n = rho >> 4, i = rho & 15; return 8 * (i >> 2) + 4 * n + (i & 3); }

struct Unit { const char* a; const char* b; int pm, pn, e, mt; };

__device__ __forceinline__ unsigned cvt_pk_bf16(float lo, float hi) { unsigned r; asm volatile("v_cvt_pk_bf16_f32 %0, %1, %2" : "=v"(r) : "v"(lo), "v"(hi)); return r; }

struct DenseOrder {
    const char* A; const char* Bt; int K, nM, nN, nwg, G, c;
    __device__ void init(const void* A_, const void* Bt_, int Mr, int N, int K_, int G_, int c_) { A = (const char*)A_; Bt = (const char*)Bt_; K = K_; nM = Mr / BM; nN = N / BM; nwg = nM * nN; G = G_; c = c_; }
    __device__ bool next(int i, Unit& u) const {
        const long L = (long)i * G + c; if (L >= nwg) return false;
        int wgid = (int)L; { const int q = nwg / NXCD, r = nwg % NXCD, xcd = wgid % NXCD, off = wgid / NXCD; wgid = (xcd < r ? xcd * (q + 1) : r * (q + 1) + (xcd - r) * q) + off; }
        const int nig = WGM * nN, gid = wgid / nig, fm = gid * WGM, gsz = (nM - fm) < WGM ? (nM - fm) : WGM;
        u.pm = fm + ((wgid % nig) % gsz); u.pn = (wgid % nig) / gsz; u.e = 0; u.mt = 0;
        u.a = A + (size_t)u.pm * BM * K * 2; u.b = Bt + (size_t)u.pn * BM * K * 2; return true;
    }
    __device__ __forceinline__ void gather(const Unit&, const int (&)[2], const int (&)[2], unsigned (&)[2][2]) const {}
};

template <class Epi, class Sched, bool GATHER, bool ALIGN_EPI, bool SP2>
__device__ __forceinline__ void gemm_phase(LAS unsigned char* lds, const int K, const Sched& S, const Epi& E) {
    const int tid = threadIdx.x, wid = __builtin_amdgcn_readfirstlane(tid >> 6), lane = tid & 63, wr = wid >> 2, wc = wid & 3, fr = lane & 15, fq = lane >> 4;
    const int nt = K / BK;
    unsigned voffA[2], voffB[2]; int stR[2], stC[2];
#pragma unroll
    for (int i = 0; i < 2; ++i) { int R, C; stage_rc(tid * 16 + i * 8192, R, C); const int Rb = Epi::PERM ? ((R & ~31) + perm32(R & 31)) : R;
        voffA[i] = (unsigned)(R * K + C) * 2u; voffB[i] = (unsigned)(Rb * K + C) * 2u; stR[i] = R; stC[i] = C; }
    unsigned voffG[2][2] = {{0u, 0u}, {0u, 0u}}, voffGn[2][2] = {{0u, 0u}, {0u, 0u}};
    const size_t kstep = (size_t)(BK * 2);
    const size_t hstep = (size_t)HALF * K * 2;
    const unsigned ldsw = (unsigned)wid * 1024u;
    const int aoff = lds_byte(wr * 64 + fr, fq * 8), boff = lds_byte(wc * 32 + fr, fq * 8);
#define PG8_SA(b, h) (((b) * 2 + (h)) * HTB)
#define PG8_SB(b, h) ((4 + (b) * 2 + (h)) * HTB)
#define PG8_STAGE(bufoff, gbase, voff) do { _Pragma("unroll") for (int _i = 0; _i < 2; ++_i) \
        __builtin_amdgcn_global_load_lds((const unsigned*)((const char*)(gbase) + (voff)[_i]), (LAS unsigned*)(lds + (bufoff) + ldsw + _i * 8192), 16, 0, 0); } while (0)
#define PG8_STAGE_A(bufoff, gk, h, og) do { if constexpr (GATHER) { PG8_STAGE(bufoff, gk, (og)[h]); } else { PG8_STAGE(bufoff, (gk) + (h) * hstep, voffA); } } while (0)
#define PG8_LDA(dst, b, h) do { _Pragma("unroll") for (int m = 0; m < 4; ++m) _Pragma("unroll") for (int k = 0; k < 2; ++k) dst[m][k] = *(const LAS bf16x8*)(lds + PG8_SA(b, h) + aoff + m * 2048 + k * 1024); } while (0)
#define PG8_LDB(dst, b, h) do { _Pragma("unroll") for (int n = 0; n < 2; ++n) _Pragma("unroll") for (int k = 0; k < 2; ++k) dst[n][k] = *(const LAS bf16x8*)(lds + PG8_SB(b, h) + boff + n * 2048 + k * 1024); } while (0)
#define PG8_MMA(ai, bj, At, Bt) do { __builtin_amdgcn_s_setprio(1); _Pragma("unroll") for (int m = 0; m < 4; ++m) _Pragma("unroll") for (int n = 0; n < 2; ++n) _Pragma("unroll") for (int k = 0; k < 2; ++k) \
        acc[ai][bj][m][n] = __builtin_amdgcn_mfma_f32_16x16x32_bf16(Bt[n][k], At[m][k], acc[ai][bj][m][n], 0, 0, 0); __builtin_amdgcn_s_setprio(0); } while (0)
#define PG8_WAIT_V(n) asm volatile("s_waitcnt vmcnt(" #n ")" ::: "memory")
#define PG8_WAIT_L(n) asm volatile("s_waitcnt lgkmcnt(" #n ")" ::: "memory")
#define PG8_BAR __builtin_amdgcn_s_barrier()
#define PG8_SCHED __builtin_amdgcn_sched_barrier(0)
    Unit cur, nxt; int ui = 0;
    if (!S.next(0, cur)) return;
    f32x4 acc[2][2][4][2];
#pragma unroll
    for (int a = 0; a < 2; ++a)
#pragma unroll
        for (int b = 0; b < 2; ++b)
#pragma unroll
            for (int m = 0; m < 4; ++m)
#pragma unroll
                for (int n = 0; n < 2; ++n) acc[a][b][m][n] = (f32x4){0.f, 0.f, 0.f, 0.f};
    bf16x8 At[4][2], B0[2][2], B1[2][2];
    const char* cA = cur.a; const char* cB = cur.b;
    if constexpr (GATHER) { S.gather(cur, stR, stC, voffG); asm volatile("s_waitcnt vmcnt(0)" ::: "memory"); }
    if constexpr (SP2) {
        PG8_STAGE(PG8_SB(0, 0), cB, voffB); PG8_STAGE(PG8_SB(0, 1), cB + hstep, voffB); PG8_STAGE_A(PG8_SA(0, 0), cA, 0, voffG); PG8_STAGE_A(PG8_SA(0, 1), cA, 1, voffG);
        if (wr == 1) PG8_BAR;
        PG8_WAIT_V(2); PG8_BAR;
        PG8_STAGE(PG8_SB(1, 0), cB + kstep, voffB); PG8_STAGE_A(PG8_SA(1, 0), cA + kstep, 0, voffG); PG8_STAGE(PG8_SB(1, 1), cB + hstep + kstep, voffB);
        PG8_WAIT_V(6); PG8_BAR;
    } else {
        PG8_STAGE(PG8_SB(0, 0), cB, voffB); PG8_STAGE_A(PG8_SA(0, 0), cA, 0, voffG); PG8_STAGE(PG8_SB(0, 1), cB + hstep, voffB); PG8_STAGE_A(PG8_SA(0, 1), cA, 1, voffG);
        if (wr == 1) PG8_BAR;
        PG8_WAIT_V(4); PG8_BAR;
        PG8_STAGE(PG8_SB(1, 0), cB + kstep, voffB); PG8_STAGE_A(PG8_SA(1, 0), cA + kstep, 0, voffG); PG8_STAGE(PG8_SB(1, 1), cB + hstep + kstep, voffB);
        PG8_WAIT_V(6); PG8_BAR;
    }
    for (;;) {
        const bool has_next = S.next(ui + 1, nxt);
        const char* nA = has_next ? nxt.a : cA; const char* nB = has_next ? nxt.b : cB;
        if constexpr (GATHER) { if (has_next) S.gather(nxt, stR, stC, voffGn); else {
#pragma unroll
            for (int h = 0; h < 2; ++h)
#pragma unroll
                for (int i = 0; i < 2; ++i) voffGn[h][i] = voffG[h][i]; } }
        for (int t = 0; t < nt; t += 2) {
            const bool last = (t == nt - 2);
            const char* a1 = cA + (size_t)(t + 1) * kstep;
            const char* a2 = last ? nA : cA + (size_t)(t + 2) * kstep; const char* b2 = last ? nB : cB + (size_t)(t + 2) * kstep;
            const char* a3 = a2 + kstep; const char* b3 = b2 + kstep;
            unsigned og2[2][2];
            if constexpr (GATHER) {
#pragma unroll
                for (int h = 0; h < 2; ++h)
#pragma unroll
                    for (int i = 0; i < 2; ++i) og2[h][i] = last ? voffGn[h][i] : voffG[h][i]; }
            if constexpr (SP2) {
            PG8_LDB(B0, 0, 0); PG8_LDB(B1, 0, 1); PG8_SCHED; PG8_LDA(At, 0, 0); PG8_STAGE_A(PG8_SA(1, 1), a1, 1, voffG);
            PG8_WAIT_V(8); PG8_WAIT_L(0); PG8_BAR; PG8_MMA(0, 0, At, B0); PG8_MMA(0, 1, At, B1); PG8_BAR; PG8_SCHED;
            PG8_LDA(At, 0, 1); PG8_STAGE(PG8_SB(0, 0), b2, voffB); PG8_STAGE(PG8_SB(0, 1), b2 + hstep, voffB); PG8_STAGE_A(PG8_SA(0, 0), a2, 0, og2);
            PG8_WAIT_V(8); PG8_WAIT_L(0); PG8_BAR; PG8_MMA(1, 0, At, B0); PG8_MMA(1, 1, At, B1); PG8_BAR; PG8_SCHED;
            PG8_LDB(B0, 1, 0); PG8_LDB(B1, 1, 1); PG8_SCHED; PG8_LDA(At, 1, 0); PG8_STAGE_A(PG8_SA(0, 1), a2, 1, og2);
            PG8_WAIT_V(8); PG8_WAIT_L(0); PG8_BAR; PG8_MMA(0, 0, At, B0); PG8_MMA(0, 1, At, B1); PG8_BAR; PG8_SCHED;
            PG8_LDA(At, 1, 1); PG8_STAGE(PG8_SB(1, 0), b3, voffB); PG8_STAGE(PG8_SB(1, 1), b3 + hstep, voffB); PG8_STAGE_A(PG8_SA(1, 0), a3, 0, og2);
            PG8_WAIT_V(8); PG8_WAIT_L(0); PG8_BAR; PG8_MMA(1, 0, At, B0); PG8_MMA(1, 1, At, B1); PG8_BAR; PG8_SCHED;
            } else {
            PG8_LDB(B0, 0, 0); PG8_SCHED; PG8_LDA(At, 0, 0); PG8_STAGE_A(PG8_SA(1, 1), a1, 1, voffG);
            PG8_WAIT_L(8); PG8_BAR; PG8_WAIT_L(0); PG8_MMA(0, 0, At, B0); PG8_BAR; PG8_SCHED;
            PG8_LDB(B1, 0, 1); PG8_STAGE(PG8_SB(0, 0), b2, voffB);
            PG8_BAR; PG8_WAIT_L(0); PG8_MMA(0, 1, At, B1); PG8_BAR;
            PG8_LDA(At, 0, 1); PG8_STAGE_A(PG8_SA(0, 0), a2, 0, og2);
            PG8_BAR; PG8_WAIT_L(0); PG8_MMA(1, 0, At, B0); PG8_BAR; PG8_SCHED;
            PG8_STAGE(PG8_SB(0, 1), b2 + hstep, voffB);
            PG8_WAIT_V(6); PG8_BAR; PG8_MMA(1, 1, At, B1); PG8_BAR;
            PG8_LDB(B0, 1, 0); PG8_SCHED; PG8_LDA(At, 1, 0); PG8_STAGE_A(PG8_SA(0, 1), a2, 1, og2);
            PG8_WAIT_L(8); PG8_BAR; PG8_WAIT_L(0); PG8_MMA(0, 0, At, B0); PG8_BAR; PG8_SCHED;
            PG8_LDB(B1, 1, 1); PG8_STAGE(PG8_SB(1, 0), b3, voffB);
            PG8_BAR; PG8_WAIT_L(0); PG8_MMA(0, 1, At, B1); PG8_BAR;
            PG8_LDA(At, 1, 1); PG8_STAGE_A(PG8_SA(1, 0), a3, 0, og2);
            PG8_BAR; PG8_WAIT_L(0); PG8_MMA(1, 0, At, B0); PG8_BAR; PG8_SCHED;
            PG8_STAGE(PG8_SB(1, 1), b3 + hstep, voffB);
            PG8_WAIT_V(6); PG8_BAR; PG8_MMA(1, 1, At, B1); PG8_BAR;
            }
        }
        if constexpr (ALIGN_EPI) { if (wr == 0) PG8_BAR; }
        E(acc, cur, wr, wc, fr, fq);
        if (!has_next) break;
#pragma unroll
        for (int a = 0; a < 2; ++a)
#pragma unroll
            for (int b = 0; b < 2; ++b)
#pragma unroll
                for (int m = 0; m < 4; ++m)
#pragma unroll
                    for (int n = 0; n < 2; ++n) acc[a][b][m][n] = (f32x4){0.f, 0.f, 0.f, 0.f};
        cur = nxt; cA = nA; cB = nB; ++ui;
        if constexpr (GATHER) {
#pragma unroll
            for (int h = 0; h < 2; ++h)
#pragma unroll
                for (int i = 0; i < 2; ++i) voffG[h][i] = voffGn[h][i]; }
        if constexpr (ALIGN_EPI) { if (wr == 1) PG8_BAR; }
    }
    PG8_WAIT_V(0);
    if constexpr (!ALIGN_EPI) { if (wr == 0) PG8_BAR; }
    PG8_BAR;
    (void)stR; (void)stC;
#undef PG8_SA
#undef PG8_SB
#undef PG8_STAGE
#undef PG8_STAGE_A
#undef PG8_LDA
#undef PG8_LDB
#undef PG8_MMA
#undef PG8_WAIT_V
#undef PG8_WAIT_L
#undef PG8_BAR
#undef PG8_SCHED
}
}
#ifndef MK_SP2
#define MK_SP2 true
#endif
#ifndef MK_ALIGN
#define MK_ALIGN true
#endif

constexpr int NWAVES = 8;
constexpr int RING_BYTES = 131072;
constexpr int MISC_OFF = RING_BYTES;
constexpr int LDS_BYTES = 147456;
constexpr int CW_BAR = 4096;
constexpr size_t WS_WRT = 4 * MiB;

typedef GAS unsigned gu32;
#define RLX_AGENT __ATOMIC_RELAXED, __HIP_MEMORY_SCOPE_AGENT
#define LDS_WAIT() asm volatile("s_waitcnt lgkmcnt(0)" ::: "memory")
#define VM_WAIT() asm volatile("s_waitcnt vmcnt(0)" ::: "memory")
__device__ __forceinline__ unsigned pk2(float lo, float hi) { return f2bf(lo) | (f2bf(hi) << 16); }

#define XB_TMO      128
#define XB_XCNT(j)  (256  + 64 * (j))
#define XB_XSUB(j)  (1280 + 64 * (j))
#define XB_XGEN(j)  (2304 + 64 * (j))
#define XB_TOP      3328
#define XB_TOPGEN   3392
#define XCD_BAR_WORDS 3456
#define XB_SPIN_CAP (1u << 18)
__device__ __forceinline__ unsigned xb_ld(unsigned* p)              { return __hip_atomic_load(p, __ATOMIC_RELAXED, __HIP_MEMORY_SCOPE_AGENT); }
__device__ __forceinline__ unsigned xb_add(unsigned* p, unsigned v) { return __hip_atomic_fetch_add(p, v, __ATOMIC_RELAXED, __HIP_MEMORY_SCOPE_AGENT); }
__device__ __forceinline__ unsigned xb_xcc_id() { return (unsigned)__builtin_amdgcn_s_getreg((3 << 11) | 20) & 0xFu; }
#define XB_SPIN(cond, bar) do { unsigned _sp = 0; while (cond) { __builtin_amdgcn_s_sleep(1); \
    if ((++_sp & 255u) == 0u) { if (xb_ld(&(bar)[XB_TMO])) break; if (_sp > XB_SPIN_CAP) { atomicAdd(&(bar)[XB_TMO], 1u); break; } } } } while (0)
struct XcdBarrier { unsigned* bar; unsigned x; volatile LAS unsigned* st; };
__device__ __forceinline__ XcdBarrier xcd_barrier_post(unsigned* bar, volatile LAS unsigned* st) {
    XcdBarrier b; b.bar = bar; b.x = xb_xcc_id(); b.st = st;
    if (threadIdx.x == 0) (void)xb_add(&bar[XB_XCNT(b.x)], 1u);
    return b;
}
__device__ __forceinline__ void xcd_barrier_complete(unsigned* bar, unsigned x, unsigned& nloc, unsigned& nx) {
    const unsigned G = gridDim.x * gridDim.y * gridDim.z;
    unsigned sum, cnt, mine, sp = 0u;
    for (;;) {
        sum = 0u; cnt = 0u; mine = 0u;
#pragma unroll
        for (unsigned j = 0; j < 16; ++j) { const unsigned c = xb_ld(&bar[XB_XCNT(j)]); sum += c; cnt += (c > 0u) ? 1u : 0u; mine = (j == x) ? c : mine; }
        if (sum == G) break;
        __builtin_amdgcn_s_sleep(1);
        if ((++sp & 255u) == 0u) { if (xb_ld(&bar[XB_TMO])) break; if (sp > XB_SPIN_CAP) { atomicAdd(&bar[XB_TMO], 1u); break; } }
    }
    nloc = mine > 0u ? mine : 1u; nx = cnt > 0u ? cnt : 1u;
}
__device__ __forceinline__ void xcd_barrier(const XcdBarrier& b) {
    asm volatile("s_waitcnt vmcnt(0)" ::: "memory");
    __syncthreads();
    if (threadIdx.x == 0) {
        unsigned* bar = b.bar;
        __builtin_amdgcn_s_waitcnt(0);
        unsigned nloc = b.st[0], nx = b.st[1];
        if (nloc == 0u) { xcd_barrier_complete(bar, b.x, nloc, nx); b.st[0] = nloc; b.st[1] = nx; }
        const unsigned old = xb_add(&bar[XB_XSUB(b.x)], 1u);
        const unsigned gen = old / nloc;
        if (old + 1u == (gen + 1u) * nloc) {
            __builtin_amdgcn_fence(__ATOMIC_RELEASE, "agent");
            asm volatile("s_waitcnt vmcnt(0)" ::: "memory");
            const unsigned og = xb_add(&bar[XB_TOP], 1u);
            const unsigned tg = og / nx;
            if (og + 1u == (tg + 1u) * nx) xb_add(&bar[XB_TOPGEN], 1u);
            else XB_SPIN(xb_ld(&bar[XB_TOPGEN]) == tg, bar);
            __builtin_amdgcn_fence(__ATOMIC_ACQUIRE, "agent");
            xb_add(&bar[XB_XGEN(b.x)], 1u);
            asm volatile("s_waitcnt vmcnt(0)" ::: "memory");
        } else {
            XB_SPIN(xb_ld(&bar[XB_XGEN(b.x)]) == gen, bar);
            __builtin_amdgcn_fence(__ATOMIC_ACQUIRE, "agent");
            asm volatile("s_waitcnt vmcnt(0)" ::: "memory");
        }
    }
    __syncthreads();
}

struct Frame {
    LAS unsigned char* lds; volatile LAS unsigned* MISC;
    int tid, lane, wave, vcu, G;
    const float* const* in; float* out; unsigned char* ws;
};
__device__ __forceinline__ float wave_sum(float v) {
#pragma unroll
    for (int o = 1; o < 64; o <<= 1) v += __shfl_xor(v, o);
    return v;
}

__device__ __forceinline__ void p0_transpose_item(const float* W, int K, int N, bf16_t* WT, int mode, LAS float* scr, int item, int lane) {
    const int nblk = N / 32, kb = item / nblk, nb = item % nblk, k0 = 64 * kb, n0 = 32 * nb;
    { const int r8 = lane >> 3, c4 = (lane & 7) * 4; f32x4 v[8];
#pragma unroll
      for (int i = 0; i < 8; ++i) v[i] = *(const f32x4*)(W + (size_t)(k0 + 8 * i + r8) * N + n0 + c4);
#pragma unroll
      for (int i = 0; i < 8; ++i) { LAS float* d = scr + (8 * i + r8) * 33 + c4; d[0] = v[i].x; d[1] = v[i].y; d[2] = v[i].z; d[3] = v[i].w; } }
    LDS_WAIT(); asm volatile("" ::: "memory");
    const int c = lane & 7; const int d0 = dst_row(n0, mode);
#pragma unroll
    for (int j = 0; j < 4; ++j) { const int n = (lane >> 3) + 8 * j; const LAS float* s = scr + (8 * c) * 33 + n;
        u32x4 o; o.x = pk2(s[0 * 33], s[1 * 33]); o.y = pk2(s[2 * 33], s[3 * 33]); o.z = pk2(s[4 * 33], s[5 * 33]); o.w = pk2(s[6 * 33], s[7 * 33]);
        *(u32x4*)(WT + (size_t)(d0 + n) * K + k0 + 8 * c) = o; }
    LDS_WAIT(); asm volatile("" ::: "memory");
}
__device__ __forceinline__ void p0_prologue(Frame& F) {
    LAS float* scr = (LAS float*)(F.lds + F.wave * 16384);
    const int gw = F.vcu * NWAVES + F.wave, NGW = F.G * NWAVES, lane = F.lane;
    unsigned char* ws = F.ws;
    { const float* g = F.in[1]; const float* b = F.in[2]; bf16_t* H0 = (bf16_t*)(ws + WS_H0); float* stat = (float*)(ws + WS_STAT0);
      for (int m = gw; m < M; m += NGW) {
        const f32x4* xr = (const f32x4*)(F.in[0] + (size_t)m * D) + lane;
        f32x4 v[8]; float s = 0.f;
#pragma unroll
        for (int j = 0; j < 8; ++j) { v[j] = xr[64 * j]; s += (v[j].x + v[j].y) + (v[j].z + v[j].w); }
        const float mean = wave_sum(s) * (1.f / D); float s2 = 0.f;
#pragma unroll
        for (int j = 0; j < 8; ++j) { v[j] = v[j] - mean; s2 += (v[j].x * v[j].x + v[j].y * v[j].y) + (v[j].z * v[j].z + v[j].w * v[j].w); }
        const float rstd = 1.f / sqrtf(wave_sum(s2) * (1.f / D) + LN_EPS);
        u32x2* o8 = (u32x2*)(H0 + (size_t)m * D) + lane;
#pragma unroll
        for (int j = 0; j < 8; ++j) { const f32x4 g4 = ((const f32x4*)g)[lane + 64 * j], b4 = ((const f32x4*)b)[lane + 64 * j]; const f32x4 h = v[j] * rstd * g4 + b4;
            u32x2 w; w.x = pk2(h.x, h.y); w.y = pk2(h.z, h.w); o8[64 * j] = w; }
        if (lane == 0) { stat[2 * m] = mean; stat[2 * m + 1] = rstd; }
      } }
    { float* wrt = (float*)(ws + WS_WRT);
      for (int i = gw * 64 + lane; i < 48 * D; i += NGW * 64) { const int o = i / D, k = i % D; wrt[i] = o < 4 ? F.in[18][k * 4 + o] : (o < 36 ? F.in[20][k * 32 + (o - 4)] : 0.f); } }
    constexpr int I_IN = (D / 64) * (4096 / 32), I_OUT = (D / 64) * (D / 32);
    constexpr int NITEMS = I_IN + I_OUT;
    for (int it = gw; it < NITEMS; it += NGW) {
        int r = it;
        if (r < I_IN) { p0_transpose_item(F.in[3], D, 4096, (bf16_t*)(ws + WS_BT1), 1, scr, r, lane); continue; } r -= I_IN;
        p0_transpose_item(F.in[15], D, D, (bf16_t*)(ws + WS_BT2), 0, scr, r, lane);
    }
}
__device__ __forceinline__ void p0_experts(Frame& F) {
    LAS float* scr = (LAS float*)(F.lds + F.wave * 16384);
    const int gw = F.vcu * NWAVES + F.wave, NGW = F.G * NWAVES, lane = F.lane;
    unsigned char* ws = F.ws;
    constexpr int I_G = (D / 64) * (FF / 32), I_D = (FF / 64) * (D / 32), I_E = 2 * I_G + I_D;
    for (int it = gw; it < NEXP * I_E; it += NGW) {
        const int e = it / I_E; int r = it - e * I_E;
        bf16_t* btu = (bf16_t*)(ws + WS_BTU) + (size_t)e * 1024 * D; bf16_t* btd = (bf16_t*)(ws + WS_BTD) + (size_t)e * D * FF;
        if (r < I_G) { p0_transpose_item(F.in[22] + (size_t)e * D * FF, D, FF, btu, 2, scr, r, lane); continue; } r -= I_G;
        if (r < I_G) { p0_transpose_item(F.in[23] + (size_t)e * D * FF, D, FF, btu, 3, scr, r, lane); continue; } r -= I_G;
        p0_transpose_item(F.in[24] + (size_t)e * FF * D, FF, D, btd, 0, scr, r, lane);
    }
    __syncthreads();
}

struct EpiZ {
    static constexpr bool PERM = true;
    bf16_t* Z;
    __device__ __forceinline__ void operator()(const f32x4 (&acc)[2][2][4][2], const pg8::Unit& u, int wr, int wc, int fr, int fq) const {
        const int row0 = u.pm * 256 + wr * 64 + fr;
        if (u.pn < 8) {
            const int col0 = u.pn * 256 + wc * 32 + 8 * fq; const bool act = u.pn >= 4;
#pragma unroll
            for (int ai = 0; ai < 2; ++ai)
#pragma unroll
                for (int m = 0; m < 4; ++m) { bf16_t* rowp = Z + (size_t)(row0 + ai * 128 + m * 16) * NZ + col0;
#pragma unroll
                    for (int bj = 0; bj < 2; ++bj) { f32x4 v0 = acc[ai][bj][m][0], v1 = acc[ai][bj][m][1];
                        if (act) {
#pragma unroll
                            for (int j = 0; j < 4; ++j) { v0[j] = gelu_tanh(v0[j]); v1[j] = gelu_tanh(v1[j]); } }
                        u32x4 w; w.x = pg8::cvt_pk_bf16(v0[0], v0[1]); w.y = pg8::cvt_pk_bf16(v0[2], v0[3]); w.z = pg8::cvt_pk_bf16(v1[0], v1[1]); w.w = pg8::cvt_pk_bf16(v1[2], v1[3]);
                        *(u32x4*)(rowp + bj * 128) = w; } }
        } else {
            const int col0 = 2048 + 128 * (u.pn - 8) + wc * 32 + 8 * fq;
#pragma unroll
            for (int ai = 0; ai < 2; ++ai)
#pragma unroll
                for (int m = 0; m < 4; ++m) { bf16_t* rowp = Z + (size_t)(row0 + ai * 128 + m * 16) * NZ + col0;
                    f32x4 v0 = acc[ai][0][m][0], v1 = acc[ai][0][m][1]; const f32x4 g0 = acc[ai][1][m][0], g1 = acc[ai][1][m][1];
#pragma unroll
                    for (int j = 0; j < 4; ++j) { v0[j] = v0[j] * sigmoidf_(g0[j]); v1[j] = v1[j] * sigmoidf_(g1[j]); }
                    u32x4 w; w.x = pg8::cvt_pk_bf16(v0[0], v0[1]); w.y = pg8::cvt_pk_bf16(v0[2], v0[3]); w.z = pg8::cvt_pk_bf16(v1[0], v1[1]); w.w = pg8::cvt_pk_bf16(v1[2], v1[3]);
                    *(u32x4*)rowp = w; }
        }
    }
};
struct EpiY1 {
    static constexpr bool PERM = false;
    float* Y1; const float* x; const float* stat0; const float* g; const float* b;
    __device__ __forceinline__ void operator()(const f32x4 (&acc)[2][2][4][2], const pg8::Unit& u, int wr, int wc, int fr, int fq) const {
        const int row0 = u.pm * 256 + wr * 64 + fr, col0 = u.pn * 256 + wc * 32 + 4 * fq;
        f32x4 gv[2][2], bv[2][2];
#pragma unroll
        for (int bj = 0; bj < 2; ++bj)
#pragma unroll
            for (int n = 0; n < 2; ++n) { gv[bj][n] = *(const f32x4*)(g + col0 + bj * 128 + n * 16) * ALPHA; bv[bj][n] = *(const f32x4*)(b + col0 + bj * 128 + n * 16) * ALPHA; }
#pragma unroll
        for (int ai = 0; ai < 2; ++ai)
#pragma unroll
            for (int m = 0; m < 4; ++m) { const int r = row0 + ai * 128 + m * 16; const float mean = stat0[2 * r], rstd = stat0[2 * r + 1]; const size_t off = (size_t)r * D + col0;
#pragma unroll
                for (int bj = 0; bj < 2; ++bj)
#pragma unroll
                    for (int n = 0; n < 2; ++n) { const f32x4 xv = *(const f32x4*)(x + off + bj * 128 + n * 16);
                        *(f32x4*)(Y1 + off + bj * 128 + n * 16) = acc[ai][bj][m][n] + ((xv - mean) * rstd) * gv[bj][n] + bv[bj][n]; }
                asm volatile("" ::: "memory"); }
    }
};


template <int SH> __device__ __forceinline__ float row_shr(float v, float ident) {
    return __int_as_float(__builtin_amdgcn_update_dpp(__float_as_int(ident), __float_as_int(v), 0x110 + SH, 0xF, 0xF, false)); }
__device__ __forceinline__ float bcast15(float v) { return __int_as_float(__builtin_amdgcn_ds_swizzle(__float_as_int(v), 0x1F0)); }
__device__ __forceinline__ float bflo(unsigned x) { return __uint_as_float(x << 16); }
__device__ __forceinline__ float bfhi(unsigned x) { return __uint_as_float(x & 0xffff0000u); }
#define SCAN_STEP(SH) do { const float pp = row_shr<SH>(p, 1.0f), hp = row_shr<SH>(h, 0.0f); h = p * hp + h; p = p * pp; } while (0)
__device__ __forceinline__ void lru_unit(Frame& F, int unit) {
    const int b = unit >> 7, hd = (unit >> 3) & 15, s = unit & 7;
    const int lane = F.lane, wave = F.wave, fr = lane & 15, fq = lane >> 4;
    const float* w4 = F.in[4]; const float* b4 = F.in[5]; const float* wa = F.in[6]; const float* ba = F.in[7]; const float* wx = F.in[8]; const float* bx = F.in[9]; const float* lam = F.in[10];
    const bf16_t* ZP = (const bf16_t*)(F.ws + WS_ZP); bf16_t* MIX = (bf16_t*)(F.ws + WS_MIX);
    bf16x8 Afr[8];
    {
        const int gsel = (fr >> 1) & 1, ch = 2 * (fr >> 2) + (fr & 1);
        const float* Wg = (gsel ? wx : wa) + (size_t)hd * 4096 + 8 * s + ch;
#pragma unroll
        for (int ks = 0; ks < 8; ++ks) { const int j = ks >> 1, cb = 32 * (ks & 1) + 8 * fq; float v[8];
#pragma unroll
            for (int jj = 0; jj < 8; ++jj) { const int c = cb + jj; v[jj] = w4[j * DL + 64 * hd + c] * Wg[c * 64]; }
            u32x4 w; w.x = pk2(v[0], v[1]); w.y = pk2(v[2], v[3]); w.z = pk2(v[4], v[5]); w.w = pk2(v[6], v[7]);
            Afr[ks] = __builtin_bit_cast(bf16x8, w); }
    }
    float gb[4];
#pragma unroll
    for (int reg = 0; reg < 4; ++reg) { const int gsel = reg >> 1, ch = 2 * fq + (reg & 1); const float* Wg = (gsel ? wx : wa) + (size_t)hd * 4096 + 8 * s + ch;
        float a = 0.f;
#pragma unroll
        for (int i = 0; i < 4; ++i) { const int c = 4 * fr + i; a += b4[64 * hd + c] * Wg[c * 64]; }
        a += __shfl_xor(a, 1); a += __shfl_xor(a, 2); a += __shfl_xor(a, 4); a += __shfl_xor(a, 8);
        gb[reg] = a + (gsel ? bx : ba)[64 * hd + 8 * s + ch]; }
    float sp8[2], w4c[4][2], b4c[2];
#pragma unroll
    for (int e = 0; e < 2; ++e) { const int cch = 64 * hd + 8 * s + 2 * fq + e; const float l = lam[cch]; sp8[e] = 8.0f * ((-l > 20.f) ? -l : log1pf(expf(-l))); b4c[e] = b4[cch];
#pragma unroll
        for (int j = 0; j < 4; ++j) w4c[j][e] = w4[j * DL + cch]; }
    float carryH[2] = {0.f, 0.f};
    LAS float* tot = (LAS float*)F.lds;
    LAS unsigned char* tile = F.lds + 1024 + wave * 12544;
    LAS unsigned char* otile = tile + 10368;
    const bf16_t* zx = ZP + (size_t)b * SEQ * NZ + 64 * hd + 8 * (lane & 7);
    const bf16_t* zg = ZP + (size_t)b * SEQ * NZ + 1024 + 64 * hd + 8 * s;
    u32x4 pf[9], pg;
#define LRU_ISSUE(ck_) do { const int tb_ = 512 * (ck_) + 64 * wave; \
        _Pragma("unroll") for (int i = 0; i < 9; ++i) { const int t_ = tb_ - 3 + 8 * i + (lane >> 3); const int tc_ = t_ < 0 ? 0 : (t_ > SEQ - 1 ? SEQ - 1 : t_); \
            const u32x4 v_ = *(const u32x4*)(zx + (size_t)tc_ * NZ); pf[i] = t_ >= 0 ? v_ : (u32x4){0u, 0u, 0u, 0u}; } \
        pg = *(const u32x4*)(zg + (size_t)(tb_ + lane) * NZ); } while (0)
    LRU_ISSUE(0);
#pragma unroll 1
    for (int ck = 0; ck < 8; ++ck) {
        const int tb = 512 * ck + 64 * wave;
#pragma unroll
        for (int i = 0; i < 9; ++i) *(LAS u32x4*)(tile + (8 * i + (lane >> 3)) * 144 + 16 * (lane & 7)) = pf[i];
        const u32x4 gcur = pg;
        if (ck < 7) LRU_ISSUE(ck + 1);
        f32x4 Dm[4];
#pragma unroll
        for (int m = 0; m < 4; ++m) { Dm[m] = (f32x4){0.f, 0.f, 0.f, 0.f};
#pragma unroll
            for (int ks = 0; ks < 8; ++ks) { const bf16x8 bfr = *(const LAS bf16x8*)(tile + (16 * m + fr + (ks >> 1)) * 144 + (32 * (ks & 1) + 8 * fq) * 2);
                Dm[m] = __builtin_amdgcn_mfma_f32_16x16x32_bf16(Afr[ks], bfr, Dm[m], 0, 0, 0); } }
        float P[4][2], Hh[4][2];
#pragma unroll
        for (int m = 0; m < 4; ++m) {
            float ain[2] = {b4c[0], b4c[1]};
#pragma unroll
            for (int j = 0; j < 4; ++j) { const unsigned xw = *(const LAS unsigned*)(tile + (16 * m + fr + j) * 144 + (8 * s + 2 * fq) * 2);
                ain[0] += w4c[j][0] * bflo(xw); ain[1] += w4c[j][1] * bfhi(xw); }
#pragma unroll
            for (int e = 0; e < 2; ++e) { const float r = sigmoidf_(Dm[m][e] + gb[e]), ig = sigmoidf_(Dm[m][2 + e] + gb[2 + e]);
                const float la = -r * sp8[e], a = fexp_(la), x2 = 2.0f * la;
                const float om = (x2 > -0.25f) ? -x2 * (1.0f + x2 * (0.5f + x2 * (0.16666667f + x2 * (0.041666668f + x2 * 0.0083333338f)))) : 1.0f - a * a;
                P[m][e] = a; Hh[m][e] = fsqrt_(om) * (ig * ain[e]); } }
        float cP[2] = {1.f, 1.f}, cH[2] = {0.f, 0.f};
#pragma unroll
        for (int m = 0; m < 4; ++m)
#pragma unroll
            for (int e = 0; e < 2; ++e) { float p = P[m][e], h = Hh[m][e];
                SCAN_STEP(1); SCAN_STEP(2); SCAN_STEP(4); SCAN_STEP(8);
                h = h + p * cH[e]; p = p * cP[e];
                P[m][e] = p; Hh[m][e] = h; cH[e] = bcast15(h); cP[e] = bcast15(p); }
        const int buf = ck & 1;
        if (fr == 0) {
#pragma unroll
            for (int e = 0; e < 2; ++e) { tot[((buf * 8 + wave) * 8 + 2 * fq + e) * 2 + 0] = cP[e]; tot[((buf * 8 + wave) * 8 + 2 * fq + e) * 2 + 1] = cH[e]; } }
        LDS_WAIT(); __syncthreads();
        float hin[2] = {carryH[0], carryH[1]}, hmine[2] = {0.f, 0.f};
#pragma unroll
        for (int w2 = 0; w2 < 8; ++w2) {
#pragma unroll
            for (int e = 0; e < 2; ++e) { if (w2 == wave) hmine[e] = hin[e];
                const float tp = tot[((buf * 8 + w2) * 8 + 2 * fq + e) * 2 + 0], th = tot[((buf * 8 + w2) * 8 + 2 * fq + e) * 2 + 1]; hin[e] = tp * hin[e] + th; } }
        carryH[0] = hin[0]; carryH[1] = hin[1];
#pragma unroll
        for (int m = 0; m < 4; ++m) *(LAS f32x2*)(otile + (16 * m + fr) * 32 + fq * 8) = (f32x2){Hh[m][0] + P[m][0] * hmine[0], Hh[m][1] + P[m][1] * hmine[1]};
        LDS_WAIT();
        const f32x4 h0 = *(const LAS f32x4*)(otile + lane * 32), h1 = *(const LAS f32x4*)(otile + lane * 32 + 16);
        u32x4 o; o.x = pk2(bflo(gcur.x) * h0.x, bfhi(gcur.x) * h0.y); o.y = pk2(bflo(gcur.y) * h0.z, bfhi(gcur.y) * h0.w);
        o.z = pk2(bflo(gcur.z) * h1.x, bfhi(gcur.z) * h1.y); o.w = pk2(bflo(gcur.w) * h1.z, bfhi(gcur.w) * h1.w);
        *(u32x4*)(MIX + ((size_t)b * SEQ + tb + lane) * D + 64 * hd + 8 * s) = o;
    }
#undef LRU_ISSUE
    __syncthreads();
}
#undef SCAN_STEP
__device__ __forceinline__ void conv31_unit(Frame& F, int unit) {
    constexpr int CT = 16;
    const int tid = F.tid, lane = F.lane, wave = F.wave, m0 = unit * 32, c2 = 2 * tid;
    const __amdgpu_buffer_rsrc_t rw = __builtin_amdgcn_make_buffer_rsrc((void*)F.in[11], 0, 31 * DC * 4, 0x00020000);
    const __amdgpu_buffer_rsrc_t rz = __builtin_amdgcn_make_buffer_rsrc((void*)(F.ws + WS_ZP), 0, M * NZ * 2, 0x00020000);
    bf16_t* MIX = (bf16_t*)(F.ws + WS_MIX);
    const f32x2 bs = *(const f32x2*)(F.in[12] + c2), g2 = *(const f32x2*)(F.in[13] + c2), b2 = *(const f32x2*)(F.in[14] + c2);
    LAS float* red = (LAS float*)(F.lds + 4096);
    LAS float* tot2 = (LAS float*)(F.lds + 4096 + 1024);
    f32x2 wj[31];
#pragma unroll
    for (int j = 0; j < 31; ++j) { const u32x2 t = __builtin_amdgcn_raw_buffer_load_b64(rw, c2 * 4, j * DC * 4, 0); wj[j] = __builtin_bit_cast(f32x2, t); }
#pragma unroll 1
    for (int pass = 0; pass < 32 / CT; ++pass) {
        const int tok0 = m0 + CT * pass, t0 = tok0 % SEQ;
        unsigned xin[CT + 30];
#pragma unroll
        for (int i = 0; i < CT + 30; ++i) { const int tt = t0 - 30 + i; const int row = tt >= 0 ? tok0 - 30 + i : tok0;
            const unsigned v = __builtin_amdgcn_raw_buffer_load_b32(rz, (2048 + c2) * 2, row * (NZ * 2), 0); xin[i] = tt >= 0 ? v : 0u; }
        float a0[CT], a1[CT];
#pragma unroll
        for (int o = 0; o < CT; ++o) { float x0 = bs.x, x1 = bs.y;
#pragma unroll
            for (int j = 0; j < 31; ++j) { x0 += wj[j].x * bflo(xin[o + j]); x1 += wj[j].y * bfhi(xin[o + j]); }
            a0[o] = x0; a1[o] = x1; }
#pragma unroll
        for (int o = 0; o < CT; ++o) { const float sm = wave_sum(a0[o] + a1[o]), sq = wave_sum(a0[o] * a0[o] + a1[o] * a1[o]);
            if (lane == 0) { red[(wave * CT + o) * 2] = sm; red[(wave * CT + o) * 2 + 1] = sq; } }
        LDS_WAIT(); __syncthreads();
        if (tid < 2 * CT) { float t = 0.f;
#pragma unroll
            for (int w2 = 0; w2 < 8; ++w2) t += red[w2 * 2 * CT + tid];
            tot2[tid] = t; }
        LDS_WAIT(); __syncthreads();
#pragma unroll
        for (int o = 0; o < CT; ++o) { const float mean = tot2[2 * o] * (1.0f / DC), var = tot2[2 * o + 1] * (1.0f / DC) - mean * mean, rstd = frsq_(var + LN_EPS);
            const float y0 = silu_((a0[o] - mean) * rstd * g2.x + b2.x), y1 = silu_((a1[o] - mean) * rstd * g2.y + b2.y);
            *(unsigned*)(MIX + (size_t)(tok0 + o) * D + 1024 + c2) = pk2(y0, y1); }
        __syncthreads();
    }
}

__device__ __forceinline__ void router_unit(Frame& F, int unit, bool publish) {
    const int tid = F.tid, lane = F.lane, wave = F.wave, m0 = 32 * unit;
    const float* Y1 = (const float*)(F.ws + WS_Y1); const float* g1 = F.in[16]; const float* b1 = F.in[17]; const float* WRT = (const float*)(F.ws + WS_WRT);
    bf16_t* H1 = (bf16_t*)(F.ws + WS_H1); float* stat1 = (float*)(F.ws + WS_STAT1);
    LAS float* st = (LAS float*)F.lds;
    LAS float* part = (LAS float*)(F.lds + 1024);
    LAS float* lgt = (LAS float*)(F.lds + 1024 + 24576);
    for (int i = 0; i < 4; ++i) { const int m = m0 + 4 * wave + i;
        const f32x4* yr = (const f32x4*)(Y1 + (size_t)m * D) + lane;
        f32x4 v[8]; float s = 0.f;
#pragma unroll
        for (int j = 0; j < 8; ++j) { v[j] = yr[64 * j]; s += (v[j].x + v[j].y) + (v[j].z + v[j].w); }
        const float mean = wave_sum(s) * (1.f / D); float s2 = 0.f;
#pragma unroll
        for (int j = 0; j < 8; ++j) { v[j] = v[j] - mean; s2 += (v[j].x * v[j].x + v[j].y * v[j].y) + (v[j].z * v[j].z + v[j].w * v[j].w); }
        const float rstd = 1.f / sqrtf(wave_sum(s2) * (1.f / D) + LN_EPS);
        u32x2* o8 = (u32x2*)(H1 + (size_t)m * D) + lane;
#pragma unroll
        for (int j = 0; j < 8; ++j) { const f32x4 g4 = ((const f32x4*)g1)[lane + 64 * j], b4 = ((const f32x4*)b1)[lane + 64 * j]; const f32x4 h = v[j] * rstd * g4 + b4;
            u32x2 w; w.x = pk2(h.x, h.y); w.y = pk2(h.z, h.w); o8[64 * j] = w; }
        if (lane == 0) { stat1[2 * m] = mean; stat1[2 * m + 1] = rstd; st[(4 * wave + i) * 2] = mean; st[(4 * wave + i) * 2 + 1] = rstd; } }
    LDS_WAIT(); __syncthreads();
    {
        const int mt = wave & 1, kp = wave >> 1, i = lane & 15, q = lane >> 4;
        const float mean = st[(16 * mt + i) * 2], rstd = st[(16 * mt + i) * 2 + 1];
        const float* yr = Y1 + (size_t)(m0 + 16 * mt + i) * D + 512 * kp + 4 * q; const float* gp = g1 + 512 * kp + 4 * q; const float* bp = b1 + 512 * kp + 4 * q;
        const float* wp = WRT + (size_t)i * D + 512 * kp + 4 * q;
        f32x4 acc0 = (f32x4){0.f, 0.f, 0.f, 0.f}, acc1 = acc0, acc2 = acc0;
#pragma unroll 4
        for (int jj = 0; jj < 32; ++jj) {
            const f32x4 y4 = *(const f32x4*)(yr + 16 * jj), g4 = *(const f32x4*)(gp + 16 * jj), b4 = *(const f32x4*)(bp + 16 * jj);
            const f32x4 a4 = ((y4 - mean) * rstd) * g4 + b4;
            const f32x4 w0 = *(const f32x4*)(wp + 16 * jj), w1 = *(const f32x4*)(wp + 16 * D + 16 * jj), w2 = *(const f32x4*)(wp + 32 * D + 16 * jj);
#pragma unroll
            for (int c = 0; c < 4; ++c) { acc0 = __builtin_amdgcn_mfma_f32_16x16x4f32(a4[c], w0[c], acc0, 0, 0, 0); acc1 = __builtin_amdgcn_mfma_f32_16x16x4f32(a4[c], w1[c], acc1, 0, 0, 0);
                acc2 = __builtin_amdgcn_mfma_f32_16x16x4f32(a4[c], w2[c], acc2, 0, 0, 0); }
        }
#pragma unroll
        for (int reg = 0; reg < 4; ++reg) { LAS float* pr = part + ((kp * 32) + 16 * mt + 4 * q + reg) * 48 + i; pr[0] = acc0[reg]; pr[16] = acc1[reg]; pr[32] = acc2[reg]; }
    }
    LDS_WAIT(); __syncthreads();
    for (int idx = tid; idx < 32 * 36; idx += NWAVES * 64) { const int tok = idx / 36, o = idx % 36;
        float v = (o < 4 ? F.in[19][o] : F.in[21][o - 4]);
#pragma unroll
        for (int kp = 0; kp < 4; ++kp) v += part[(kp * 32 + tok) * 48 + o];
        lgt[tok * 36 + o] = v; }
    LDS_WAIT(); __syncthreads();
    if (tid < 32 && publish) {
        const int m = m0 + tid; const LAS float* lg = lgt + tid * 36;
        unsigned* cnt = (unsigned*)(F.ws + WS_CTL) + CW_CNT; int* list = (int*)(F.ws + WS_LIST); float* ql = (float*)(F.ws + WS_QL); unsigned* route = (unsigned*)(F.ws + WS_ROUTE);
        int gs = 0; for (int j = 1; j < 4; ++j) if (lg[j] > lg[gs]) gs = j;
        float den = 0.f; for (int j = 0; j < 4; ++j) den += expf(lg[j] - lg[gs]);
        const float pg = 1.0f / den;
        const LAS float* le = lg + 4 + 8 * gs; int i0 = 0; for (int j = 1; j < 8; ++j) if (le[j] > le[i0]) i0 = j;
        int i1 = (i0 == 0) ? 1 : 0; for (int j = 0; j < 8; ++j) if (j != i0 && le[j] > le[i1]) i1 = j;
        const float ex = expf(le[i1] - le[i0]); const float q0 = pg / (1.0f + ex), q1 = pg * ex / (1.0f + ex);
        const int e0 = gs * 8 + i0, e1 = gs * 8 + i1;
        const unsigned p0 = atomicAdd(&cnt[e0], 1u), p1 = atomicAdd(&cnt[e1], 1u);
        list[e0 * 8192 + p0] = m; ql[e0 * 8192 + p0] = q0; list[e1 * 8192 + p1] = m; ql[e1 * 8192 + p1] = q1;
        unsigned* r = route + (size_t)m * 8; r[0] = e0; r[1] = e1; r[2] = __float_as_uint(q0); r[3] = __float_as_uint(q1); r[4] = p0; r[5] = p1;
    }
    __syncthreads();
}

__device__ __forceinline__ const LAS int* moe_tables(Frame& F) {
    LAS int* tab = (LAS int*)(F.lds + MISC_OFF + 256);
    if (F.tid == 0) { unsigned* cnt = (unsigned*)(F.ws + WS_CTL) + CW_CNT; int run = 0;
        for (int e = 0; e < NEXP; ++e) { const int c = (int)__hip_atomic_load(cnt + e, RLX_AGENT); tab[e] = run; tab[40 + e] = run * 256; tab[80 + e] = c; run += (c + 255) >> 8; }
        tab[32] = run; }
    LDS_WAIT(); __syncthreads();
    return tab;
}
struct MoeOrder {
    const LAS int* tab; const char* A; const char* Bt; const int* list; int npn, G, c; bool up;
    __device__ bool next(int i, pg8::Unit& u) const {
        const int L = i * G + c; if (L >= tab[32] * npn) return false;
        const int tt = L / npn, pn = L % npn; int e = 0; while (tab[e + 1] <= tt) ++e;
        const int mt = tt - tab[e];
        u.e = e; u.mt = mt; u.pn = pn; u.pm = (tab[40 + e] >> 8) + mt;
        if (up) { u.a = A; u.b = Bt + ((size_t)(e * 1024 + pn * 256)) * D * 2; }
        else { u.a = A + (size_t)(tab[40 + e] + mt * 256) * FF * 2; u.b = Bt + ((size_t)(e * D + pn * 256)) * FF * 2; }
        return true;
    }
    __device__ __forceinline__ void gather(const pg8::Unit& u, const int (&stR)[2], const int (&stC)[2], unsigned (&voff)[2][2]) const {
        const int cnt = tab[80 + u.e];
#pragma unroll
        for (int h = 0; h < 2; ++h)
#pragma unroll
            for (int i = 0; i < 2; ++i) { int pos = u.mt * 256 + h * 128 + stR[i]; if (pos >= cnt) pos = 0;
                const int tok = list[u.e * 8192 + pos]; voff[h][i] = (unsigned)(tok * D + stC[i]) * 2u; }
    }
};
struct EpiH {
    static constexpr bool PERM = true;
    bf16_t* HH; const float* ql; const LAS int* tab;
    __device__ __forceinline__ void operator()(const f32x4 (&acc)[2][2][4][2], const pg8::Unit& u, int wr, int wc, int fr, int fq) const {
        const int cnt = tab[80 + u.e];
#pragma unroll
        for (int ai = 0; ai < 2; ++ai)
#pragma unroll
            for (int m = 0; m < 4; ++m) { const int rl = ai * 128 + wr * 64 + m * 16 + fr, lr = u.mt * 256 + rl;
                const float q = lr < cnt ? ql[u.e * 8192 + lr] : 0.f;
                f32x4 v0 = acc[ai][0][m][0], v1 = acc[ai][0][m][1]; const f32x4 u0 = acc[ai][1][m][0], u1 = acc[ai][1][m][1];
#pragma unroll
                for (int j = 0; j < 4; ++j) { v0[j] = silu_(v0[j]) * u0[j] * q; v1[j] = silu_(v1[j]) * u1[j] * q; }
                u32x4 w; w.x = pg8::cvt_pk_bf16(v0[0], v0[1]); w.y = pg8::cvt_pk_bf16(v0[2], v0[3]); w.z = pg8::cvt_pk_bf16(v1[0], v1[1]); w.w = pg8::cvt_pk_bf16(v1[2], v1[3]);
                *(u32x4*)(HH + (size_t)(u.pm * 256 + rl) * FF + 128 * u.pn + wc * 32 + 8 * fq) = w; }
    }
};
struct EpiYf {
    static constexpr bool PERM = true;
    bf16_t* YF;
    __device__ __forceinline__ void operator()(const f32x4 (&acc)[2][2][4][2], const pg8::Unit& u, int wr, int wc, int fr, int fq) const {
#pragma unroll
        for (int ai = 0; ai < 2; ++ai)
#pragma unroll
            for (int m = 0; m < 4; ++m) { bf16_t* rowp = YF + (size_t)(u.pm * 256 + ai * 128 + wr * 64 + m * 16 + fr) * D + u.pn * 256 + wc * 32 + 8 * fq;
#pragma unroll
                for (int bj = 0; bj < 2; ++bj) { const f32x4 v0 = acc[ai][bj][m][0], v1 = acc[ai][bj][m][1];
                    u32x4 w; w.x = pg8::cvt_pk_bf16(v0[0], v0[1]); w.y = pg8::cvt_pk_bf16(v0[2], v0[3]); w.z = pg8::cvt_pk_bf16(v1[0], v1[1]); w.w = pg8::cvt_pk_bf16(v1[2], v1[3]);
                    *(u32x4*)(rowp + bj * 128) = w; } }
    }
};

__device__ __forceinline__ void final_phase(Frame& F, const LAS int* tab) {
    const int gw = F.vcu * NWAVES + F.wave, NGW = F.G * NWAVES, lane = F.lane;
    const float* Y1 = (const float*)(F.ws + WS_Y1); const float* stat1 = (const float*)(F.ws + WS_STAT1); const unsigned* route = (const unsigned*)(F.ws + WS_ROUTE);
    const bf16_t* YF = (const bf16_t*)(F.ws + WS_YF); const float* g1 = F.in[16]; const float* b1 = F.in[17]; const float* g2 = F.in[25]; const float* b2 = F.in[26];
    for (int m = gw; m < M; m += NGW) {
        const unsigned* r = route + (size_t)m * 8;
        const int s0 = tab[40 + (int)r[0]] + (int)r[4], s1 = tab[40 + (int)r[1]] + (int)r[5];
        const float mean1 = stat1[2 * m], rstd1 = stat1[2 * m + 1];
        const f32x4* yr = (const f32x4*)(Y1 + (size_t)m * D) + lane;
        const u32x2* f0 = (const u32x2*)(YF + (size_t)s0 * D) + lane; const u32x2* f1 = (const u32x2*)(YF + (size_t)s1 * D) + lane;
        f32x4 v[8]; float s = 0.f;
#pragma unroll
        for (int j = 0; j < 8; ++j) { const f32x4 y = yr[64 * j], g4 = ((const f32x4*)g1)[lane + 64 * j], b4 = ((const f32x4*)b1)[lane + 64 * j];
            const u32x2 a = f0[64 * j], c = f1[64 * j];
            const f32x4 ff = (f32x4){bflo(a.x) + bflo(c.x), bfhi(a.x) + bfhi(c.x), bflo(a.y) + bflo(c.y), bfhi(a.y) + bfhi(c.y)};
            v[j] = (((y - mean1) * rstd1) * g4 + b4) * ALPHA + ff; s += (v[j].x + v[j].y) + (v[j].z + v[j].w); }
        const float mean = wave_sum(s) * (1.f / D); float s2 = 0.f;
#pragma unroll
        for (int j = 0; j < 8; ++j) { v[j] = v[j] - mean; s2 += (v[j].x * v[j].x + v[j].y * v[j].y) + (v[j].z * v[j].z + v[j].w * v[j].w); }
        const float rstd = 1.f / sqrtf(wave_sum(s2) * (1.f / D) + LN_EPS);
        f32x4* o = (f32x4*)(F.out + (size_t)m * D) + lane;
#pragma unroll
        for (int j = 0; j < 8; ++j) { const f32x4 g4 = ((const f32x4*)g2)[lane + 64 * j], b4 = ((const f32x4*)b2)[lane + 64 * j]; o[64 * j] = (v[j] * rstd) * g4 + b4; }
    }
}

#ifndef FAST_MASK
#define FAST_MASK 0xFF
#endif
#ifndef HOST_REP
#define HOST_REP -1
#endif
#ifndef REP_SUB
#define REP_SUB 1
#endif
#ifndef EXP_IN_P1
#define EXP_IN_P1 1
#endif
#ifndef ONE_LAUNCH
#define ONE_LAUNCH 1
#endif
constexpr int NPHASE = 8;
__global__ void __launch_bounds__(NWAVES * 64, 2) mk(Args args) {
    extern __shared__ __attribute__((aligned(16))) unsigned char lds_raw[];
    Frame F;
    F.lds = (LAS unsigned char*)lds_raw; F.MISC = (volatile LAS unsigned*)(F.lds + MISC_OFF);
    F.tid = threadIdx.x; F.lane = F.tid & 63; F.wave = __builtin_amdgcn_readfirstlane(F.tid >> 6);
    F.G = gridDim.x; { const int bx = blockIdx.x; F.vcu = (F.G % 8 == 0) ? (bx % 8) * (F.G / 8) + bx / 8 : bx; }
    F.in = args.in; F.out = args.out; F.ws = args.ws;
    unsigned char* ws = args.ws;
    const int lo = args.ph_lo, hi = args.ph_hi;
    for (int u = F.tid; u < 64; u += NWAVES * 64) F.MISC[u] = 0u;
    __syncthreads();
    XcdBarrier bar; bar.bar = (unsigned*)(ws + WS_CTL) + CW_BAR + lo * XCD_BAR_WORDS; bar.x = 0; bar.st = nullptr;
    if (hi - lo > 1) bar = xcd_barrier_post((unsigned*)(ws + WS_CTL) + CW_BAR + lo * XCD_BAR_WORDS, F.MISC + 8);
#ifndef PH_EN
#define PH_EN 0xFF
#endif
#define IN(k) (((PH_EN >> (k)) & 1) && lo <= (k) && (k) < hi)
#define SEAM(k) do { if (IN(k) && IN((k) + 1)) xcd_barrier(bar); } while (0)

#ifndef REP_PHASE
#define REP_PHASE -1
#endif
#define REPS(k) for (int rep_ = 0; rep_ < ((REP_PHASE == (k)) ? 2 : 1); ++rep_)
#define REP_BAR(k) do { if (REP_PHASE == (k) && rep_ == 0 && hi - lo > 1) xcd_barrier(bar); } while (0)
    if (IN(0)) { REPS(0) { p0_prologue(F); if (!EXP_IN_P1) p0_experts(F); REP_BAR(0); } SEAM(0); }
    if (IN(1)) {
        REPS(1) {
        if (EXP_IN_P1 && (F.vcu & 1)) p0_experts(F);
        pg8::DenseOrder S; S.init(ws + WS_H0, ws + WS_BT1, M, 4096, D, F.G, (int)blockIdx.x);
        EpiZ E{(bf16_t*)(ws + WS_ZP)};
        pg8::gemm_phase<EpiZ, pg8::DenseOrder, false, MK_ALIGN, MK_SP2>(F.lds, D, S, E);
        if (EXP_IN_P1 && !(F.vcu & 1)) p0_experts(F);
        REP_BAR(1); }
        SEAM(1);
    }
    if (IN(2)) {
        REPS(2) {
        if (args.rep != 2) for (int u = F.vcu; u < 256; u += F.G) lru_unit(F, u);
        if (args.rep != 1) for (int u = F.vcu; u < 256; u += F.G) conv31_unit(F, u);
        REP_BAR(2); }
        SEAM(2);
    }
    if (IN(3)) {
        REPS(3) {
        pg8::DenseOrder S; S.init(ws + WS_MIX, ws + WS_BT2, M, D, D, F.G, (int)blockIdx.x);
        EpiY1 E{(float*)(ws + WS_Y1), F.in[0], (const float*)(ws + WS_STAT0), F.in[1], F.in[2]};
        pg8::gemm_phase<EpiY1, pg8::DenseOrder, false, MK_ALIGN, MK_SP2>(F.lds, D, S, E);
        REP_BAR(3); }
        SEAM(3);
    }
    if (IN(4)) {
        REPS(4) {
        for (int u = F.vcu; u < 256; u += F.G) router_unit(F, u, args.rep == 0);
        REP_BAR(4); }
        SEAM(4);
    }
    if (IN(5)) {
        REPS(5) {
        const LAS int* tab = moe_tables(F);
        MoeOrder S{tab, (const char*)(ws + WS_H1), (const char*)(ws + WS_BTU), (const int*)(ws + WS_LIST), 4, F.G, F.vcu, true};
        EpiH E{(bf16_t*)(ws + WS_HH), (const float*)(ws + WS_QL), tab};
        pg8::gemm_phase<EpiH, MoeOrder, true, MK_ALIGN, MK_SP2>(F.lds, D, S, E);
        REP_BAR(5); }
        SEAM(5);
    }
    if (IN(6)) {
        REPS(6) {
        const LAS int* tab = moe_tables(F);
        MoeOrder S{tab, (const char*)(ws + WS_HH), (const char*)(ws + WS_BTD), (const int*)(ws + WS_LIST), 8, F.G, F.vcu, false};
        EpiYf E{(bf16_t*)(ws + WS_YF)};
        pg8::gemm_phase<EpiYf, MoeOrder, false, MK_ALIGN, MK_SP2>(F.lds, FF, S, E);
        REP_BAR(6); }
        SEAM(6);
    }
    if (IN(7)) {
        REPS(7) {
        const LAS int* tab = moe_tables(F);
        final_phase(F, tab);
        REP_BAR(7); }
    }
#undef IN
#undef SEAM
}

extern "C" void kernel_launch(void* const* d_in, const int* in_sizes, int n_in, void* d_out, int out_size, void* d_ws, size_t ws_size, hipStream_t stream) {
    static int grid = 0;
    if (grid == 0) {
        if (n_in != 27 || in_sizes[0] != M * D || out_size != M * D || ws_size < WS_NEED) {
            fprintf(stderr, "kernel_launch: unexpected shapes (n_in %d, in0 %d, out %d, ws %zu); nothing launched\n", n_in, n_in > 0 ? in_sizes[0] : -1, out_size, ws_size); grid = -1; return; }
        int dev = 0, cus = 0, per_cu = 0;
        if (hipGetDevice(&dev) != hipSuccess || hipDeviceGetAttribute(&cus, hipDeviceAttributeMultiprocessorCount, dev) != hipSuccess) { grid = -1; return; }
        if (hipFuncSetAttribute((const void*)mk, hipFuncAttributeMaxDynamicSharedMemorySize, LDS_BYTES) != hipSuccess) { fprintf(stderr, "kernel_launch: hipFuncSetAttribute failed\n"); grid = -1; return; }
        if (hipOccupancyMaxActiveBlocksPerMultiprocessor(&per_cu, (const void*)mk, NWAVES * 64, LDS_BYTES) != hipSuccess || per_cu < 1) { fprintf(stderr, "kernel_launch: occupancy query says %d blocks per CU\n", per_cu); (void)hipGetLastError(); grid = -1; return; }
        grid = cus;
    }
    if (grid < 0) return;
    const float* const* in = (const float* const*)d_in;
    unsigned char* ws = (unsigned char*)d_ws;
    (void)hipMemsetAsync(ws + WS_CTL, 0, CTL_ZERO_BYTES, stream);
    float* stat0 = (float*)(ws + WS_STAT0); float* stat1 = (float*)(ws + WS_STAT1); unsigned* route = (unsigned*)(ws + WS_ROUTE);
    int* list = (int*)(ws + WS_LIST); float* ql = (float*)(ws + WS_QL); unsigned* cnt = (unsigned*)(ws + WS_CTL) + CW_CNT;
    bf16_t* H0 = (bf16_t*)(ws + WS_H0); bf16_t* ZP = (bf16_t*)(ws + WS_ZP); bf16_t* MIX = (bf16_t*)(ws + WS_MIX); float* Y1 = (float*)(ws + WS_Y1);
    bf16_t* H1 = (bf16_t*)(ws + WS_H1); bf16_t* HH = (bf16_t*)(ws + WS_HH); bf16_t* YF = (bf16_t*)(ws + WS_YF);
    float* ZRAW = (float*)(ws + WS_ZRAW); float* AIN = (float*)(ws + WS_AIN); float* ADEC = (float*)(ws + WS_ADEC); float* U = (float*)(ws + WS_U);
    Args a{};
    for (int i = 0; i < 27; ++i) a.in[i] = in[i];
    a.out = (float*)d_out; a.ws = ws;
    for (int p = 0; p < NPHASE;) {
        if ((FAST_MASK >> p) & 1) {
            int q = p + 1;
            if (ONE_LAUNCH) while (q < NPHASE && ((FAST_MASK >> q) & 1) && q != HOST_REP && (q - 1) != HOST_REP) ++q;
            a.ph_lo = p; a.ph_hi = q;
            hipLaunchKernelGGL(mk, dim3(grid), dim3(NWAVES * 64), LDS_BYTES, stream, a);
            if (p == HOST_REP) { a.rep = REP_SUB; hipLaunchKernelGGL(mk, dim3(grid), dim3(NWAVES * 64), LDS_BYTES, stream, a); a.rep = 0; }
            p = q; continue;
        }
        switch (p) {
        case 0:
            nv_ln_in<<<M, 256, 0, stream>>>(in[0], in[1], in[2], H0, stat0);
            break;
        case 1:
            nv_gemm<<<dim3(4096 / 64, M / 64), 256, 0, stream>>>(H0, in[3], ZRAW, M, 4096, D);
            nv_zprime<<<(unsigned)(((size_t)M * NZ + 255) / 256), 256, 0, stream>>>(ZRAW, ZP);
            break;
        case 2:
            nv_lru1<<<(M * DL + 255) / 256, 256, 0, stream>>>(ZP, in[4], in[5], AIN);
            nv_lru2<<<(M * DL + 255) / 256, 256, 0, stream>>>(AIN, in[6], in[7], in[8], in[9], in[10], ADEC, U);
            nv_lru3<<<(2 * DL + 255) / 256, 256, 0, stream>>>(ADEC, U, ZP, MIX);
            nv_conv31<<<M, 256, 0, stream>>>(ZP, in[11], in[12], in[13], in[14], MIX);
            break;
        case 3:
            nv_gemm<<<dim3(D / 64, M / 64), 256, 0, stream>>>(MIX, in[15], Y1, M, D, D);
            nv_y1<<<(unsigned)(((size_t)M * D + 255) / 256), 256, 0, stream>>>(Y1, in[0], stat0, in[1], in[2]);
            break;
        case 4:
            nv_router<<<M, 256, 0, stream>>>(Y1, in[16], in[17], in[18], in[19], in[20], in[21], H1, stat1, route, cnt, list, ql);
            break;
        case 5:
            nv_moe_up<<<2 * M, 512, 0, stream>>>(H1, route, cnt, in[22], in[23], HH);
            break;
        case 6:
            nv_moe_down<<<2 * M, 512, 0, stream>>>(HH, route, cnt, in[24], YF);
            break;
        case 7:
            nv_final<<<M, 256, 0, stream>>>(Y1, stat1, in[16], in[17], route, cnt, YF, in[25], in[26], (float*)d_out);
            break;
        }
        ++p;
    }
}
```

```cpp
#include <hip/hip_runtime.h>
#include <cstdio>
#include <cstdint>

constexpr int D = 2048, SEQ = 4096, M = 8192;
constexpr int DL = 1024, DC = 1024, NH = 16, HDIM = 64;
constexpr int NGRP = 4, NEXPG = 8, NEXP = 32, FF = 512;
constexpr int NZ = 3072;
constexpr float LN_EPS = 1e-5f;
constexpr float ALPHA = 1.189207115002721f;
constexpr int SLOT_ROWS = 24576;

typedef unsigned short bf16_t;
typedef float f32x4 __attribute__((ext_vector_type(4)));
typedef float f32x2 __attribute__((ext_vector_type(2)));
typedef short bf16x8 __attribute__((ext_vector_type(8)));
typedef unsigned u32x4 __attribute__((ext_vector_type(4)));
typedef unsigned u32x2 __attribute__((ext_vector_type(2)));

constexpr size_t MiB = 1u << 20;
constexpr size_t WS_CTL = 0, CTL_ZERO_BYTES = 1 * MiB;
constexpr size_t WS_STAT0 = 1 * MiB;
constexpr size_t WS_STAT1 = 1 * MiB + 65536;
constexpr size_t WS_ROUTE = 1 * MiB + 131072;
constexpr size_t WS_LIST = 2 * MiB;
constexpr size_t WS_QL = 3 * MiB;
constexpr size_t WS_BT1 = 8 * MiB;
constexpr size_t WS_BT2 = 24 * MiB;
constexpr size_t WS_BTU = 32 * MiB;
constexpr size_t WS_BTD = 160 * MiB;
constexpr size_t WS_Y1 = 224 * MiB;
constexpr size_t WS_H0 = 288 * MiB;
constexpr size_t WS_ZP = 320 * MiB;
constexpr size_t WS_MIX = 368 * MiB;
constexpr size_t WS_H1 = 288 * MiB;
constexpr size_t WS_HH = 320 * MiB;
constexpr size_t WS_YF = 344 * MiB;
constexpr size_t WS_ZRAW = 368 * MiB;
constexpr size_t WS_AIN = 400 * MiB;
constexpr size_t WS_ADEC = 440 * MiB;
constexpr size_t WS_U = 472 * MiB;
constexpr size_t WS_NEED = 504 * MiB;
constexpr int CW_CNT = 1024;

struct Args { const float* in[27]; float* out; unsigned char* ws; int ph_lo, ph_hi, rep, pad; };

__device__ __forceinline__ float bf2f(bf16_t v) { return __uint_as_float((unsigned)v << 16); }
__device__ __forceinline__ unsigned f2bf(float f) { unsigned u = __float_as_uint(f); return (u + 0x7fffu + ((u >> 16) & 1u)) >> 16; }
__device__ __forceinline__ float frcp_(float x) { return __builtin_amdgcn_rcpf(x); }
__device__ __forceinline__ float fexp_(float x) { return __builtin_amdgcn_exp2f(1.4426950408889634f * x); }
__device__ __forceinline__ float fsqrt_(float x) { return __builtin_amdgcn_sqrtf(x); }
__device__ __forceinline__ float frsq_(float x) { return __builtin_amdgcn_rsqf(x); }
__device__ __forceinline__ float sigmoidf_(float x) { return frcp_(1.0f + __builtin_amdgcn_exp2f(-1.4426950408889634f * x)); }
__device__ __forceinline__ float gelu_tanh(float x) { const float u = 1.5957691216057308f * (x + 0.044715f * x * x * x); return x * sigmoidf_(u); }
__device__ __forceinline__ float silu_(float x) { return x * sigmoidf_(x); }

__device__ __forceinline__ float block_sum256(float v, float* red) {
    red[threadIdx.x] = v; __syncthreads();
    for (int s = 128; s > 0; s >>= 1) { if ((int)threadIdx.x < s) red[threadIdx.x] += red[threadIdx.x + s]; __syncthreads(); }
    const float r = red[0]; __syncthreads(); return r;
}
__global__ void __launch_bounds__(256) nv_ln_in(const float* x, const float* g, const float* b, bf16_t* H0, float* stat) {
    __shared__ float red[256];
    const int m = blockIdx.x; const float* xr = x + (size_t)m * D;
    float s = 0.f; for (int c = threadIdx.x; c < D; c += 256) s += xr[c];
    const float mean = block_sum256(s, red) * (1.0f / D);
    float q = 0.f; for (int c = threadIdx.x; c < D; c += 256) { const float d = xr[c] - mean; q += d * d; }
    const float rstd = 1.0f / sqrtf(block_sum256(q, red) * (1.0f / D) + LN_EPS);
    for (int c = threadIdx.x; c < D; c += 256) H0[(size_t)m * D + c] = (bf16_t)f2bf((xr[c] - mean) * rstd * g[c] + b[c]);
    if (threadIdx.x == 0) { stat[2 * m] = mean; stat[2 * m + 1] = rstd; }
}
__host__ __device__ __forceinline__ int dst_row(int n, int mode) {
    if (mode == 0) return n;
    if (mode == 1) { if (n < 2048) return n; if (n < 3072) { const int s = n - 2048; return 2048 + 256 * (s >> 7) + (s & 127); } const int s = n - 3072; return 2048 + 256 * (s >> 7) + 128 + (s & 127); }
    if (mode == 2) return 256 * (n >> 7) + (n & 127);
    return 256 * (n >> 7) + 128 + (n & 127);
}
__global__ void __launch_bounds__(256) nv_transpose(const float* W, int K, int N, bf16_t* WT, int mode) {
    const size_t idx = (size_t)blockIdx.x * 256 + threadIdx.x; if (idx >= (size_t)K * N) return;
    const int n = (int)(idx % N), k = (int)(idx / N);
    WT[(size_t)dst_row(n, mode) * K + k] = (bf16_t)f2bf(W[idx]);
}
__global__ void __launch_bounds__(256) nv_gemm(const bf16_t* A, const float* B, float* C, int Mr, int N, int K) {
    __shared__ float As[16][65], Bs[16][65];
    const int tx = threadIdx.x & 15, ty = threadIdx.x >> 4, m0 = blockIdx.y * 64, n0 = blockIdx.x * 64;
    float acc[4][4] = {};
    for (int k0 = 0; k0 < K; k0 += 16) {
        for (int i = threadIdx.x; i < 64 * 16; i += 256) { const int r = i >> 4, kk = i & 15; As[kk][r] = bf2f(A[(size_t)(m0 + r) * K + k0 + kk]); }
        for (int i = threadIdx.x; i < 64 * 16; i += 256) { const int kk = i >> 6, c = i & 63; Bs[kk][c] = B[(size_t)(k0 + kk) * N + n0 + c]; }
        __syncthreads();
#pragma unroll
        for (int kk = 0; kk < 16; ++kk) {
            float a[4], b[4];
#pragma unroll
            for (int i = 0; i < 4; ++i) { a[i] = As[kk][ty * 4 + i]; b[i] = Bs[kk][tx * 4 + i]; }
#pragma unroll
            for (int i = 0; i < 4; ++i)
#pragma unroll
                for (int j = 0; j < 4; ++j) acc[i][j] += a[i] * b[j];
        }
        __syncthreads();
    }
    for (int i = 0; i < 4; ++i) for (int j = 0; j < 4; ++j) C[(size_t)(m0 + ty * 4 + i) * N + n0 + tx * 4 + j] = acc[i][j];
}
__global__ void __launch_bounds__(256) nv_zprime(const float* zraw, bf16_t* ZP) {
    const size_t idx = (size_t)blockIdx.x * 256 + threadIdx.x; if (idx >= (size_t)M * NZ) return;
    const int c = (int)(idx % NZ); const size_t m = idx / NZ; const float* zr = zraw + m * 4096;
    float v;
    if (c < 1024) v = zr[c]; else if (c < 2048) v = gelu_tanh(zr[c]); else v = zr[c] * sigmoidf_(zr[c + 1024]);
    ZP[idx] = (bf16_t)f2bf(v);
}
__global__ void __launch_bounds__(256) nv_lru1(const bf16_t* ZP, const float* w4, const float* b4, float* AIN) {
    const size_t idx = (size_t)blockIdx.x * 256 + threadIdx.x; if (idx >= (size_t)M * DL) return;
    const int c = (int)(idx % DL); const int m = (int)(idx / DL), t = m % SEQ;
    float s = b4[c];
    for (int j = 0; j < 4; ++j) { const int tt = t - 3 + j; if (tt >= 0) s += w4[j * DL + c] * bf2f(ZP[(size_t)(m - 3 + j) * NZ + c]); }
    AIN[idx] = s;
}
__global__ void __launch_bounds__(256) nv_lru2(const float* AIN, const float* wa, const float* ba, const float* wx, const float* bx, const float* lam, float* ADEC, float* U) {
    const size_t idx = (size_t)blockIdx.x * 256 + threadIdx.x; if (idx >= (size_t)M * DL) return;
    const int c = (int)(idx % DL); const size_t m = idx / DL; const int h = c >> 6, j = c & 63;
    const float* ar = AIN + m * DL + h * 64;
    float sr = ba[c], si = bx[c];
    for (int i = 0; i < 64; ++i) { const float a = ar[i]; sr += a * wa[(size_t)(h * 64 + i) * 64 + j]; si += a * wx[(size_t)(h * 64 + i) * 64 + j]; }
    const float r = sigmoidf_(sr), ig = sigmoidf_(si);
    const float l = lam[c]; const float sp = (-l > 20.f) ? -l : log1pf(expf(-l));
    const float log_a = -8.0f * r * sp; const float a = expf(log_a);
    ADEC[idx] = a; U[idx] = sqrtf(-expm1f(2.0f * log_a)) * (ig * ar[j]);
}
__global__ void __launch_bounds__(256) nv_lru3(const float* ADEC, const float* U, const bf16_t* ZP, bf16_t* MIX) {
    const int idx = blockIdx.x * 256 + threadIdx.x; if (idx >= 2 * DL) return;
    const int b = idx / DL, c = idx % DL; float h = 0.f;
    for (int t = 0; t < SEQ; ++t) { const size_t m = (size_t)b * SEQ + t; h = ADEC[m * DL + c] * h + U[m * DL + c]; MIX[m * D + c] = (bf16_t)f2bf(bf2f(ZP[m * NZ + 1024 + c]) * h); }
}
__global__ void __launch_bounds__(256) nv_conv31(const bf16_t* ZP, const float* w, const float* bias, const float* g, const float* b, bf16_t* MIX) {
    __shared__ float red[256];
    const int m = blockIdx.x, t = m % SEQ; float v[4]; float s = 0.f;
    for (int i = 0; i < 4; ++i) { const int c = threadIdx.x + 256 * i; float a = bias[c];
        for (int j = 0; j < 31; ++j) { const int tt = t - 30 + j; if (tt >= 0) a += w[j * DC + c] * bf2f(ZP[(size_t)(m - 30 + j) * NZ + 2048 + c]); }
        v[i] = a; s += a; }
    const float mean = block_sum256(s, red) * (1.0f / DC); float q = 0.f;
    for (int i = 0; i < 4; ++i) { const float d = v[i] - mean; q += d * d; }
    const float rstd = 1.0f / sqrtf(block_sum256(q, red) * (1.0f / DC) + LN_EPS);
    for (int i = 0; i < 4; ++i) { const int c = threadIdx.x + 256 * i; MIX[(size_t)m * D + 1024 + c] = (bf16_t)f2bf(silu_((v[i] - mean) * rstd * g[c] + b[c])); }
}
__global__ void __launch_bounds__(256) nv_y1(float* Y1, const float* x, const float* stat0, const float* g, const float* b) {
    const size_t idx = (size_t)blockIdx.x * 256 + threadIdx.x; if (idx >= (size_t)M * D) return;
    const int c = (int)(idx % D); const size_t m = idx / D;
    Y1[idx] += ALPHA * ((x[idx] - stat0[2 * m]) * stat0[2 * m + 1] * g[c] + b[c]);
}
__global__ void __launch_bounds__(256) nv_router(const float* Y1, const float* g1, const float* b1, const float* wg, const float* bg, const float* we, const float* be,
                                                 bf16_t* H1, float* stat1, unsigned* route, unsigned* cnt, int* list, float* ql) {
    __shared__ float red[256]; __shared__ float lg[36];
    const int m = blockIdx.x; const float* yr = Y1 + (size_t)m * D;
    float s = 0.f; for (int c = threadIdx.x; c < D; c += 256) s += yr[c];
    const float mean = block_sum256(s, red) * (1.0f / D);
    float q = 0.f; for (int c = threadIdx.x; c < D; c += 256) { const float d = yr[c] - mean; q += d * d; }
    const float rstd = 1.0f / sqrtf(block_sum256(q, red) * (1.0f / D) + LN_EPS);
    float hv[8];
    for (int i = 0; i < 8; ++i) { const int c = threadIdx.x + 256 * i; hv[i] = (yr[c] - mean) * rstd * g1[c] + b1[c]; H1[(size_t)m * D + c] = (bf16_t)f2bf(hv[i]); }
    for (int o = 0; o < 36; ++o) { float p = 0.f;
        for (int i = 0; i < 8; ++i) { const int c = threadIdx.x + 256 * i; p += hv[i] * (o < 4 ? wg[c * 4 + o] : we[c * 32 + (o - 4)]); }
        p = block_sum256(p, red); if (threadIdx.x == 0) lg[o] = p + (o < 4 ? bg[o] : be[o - 4]); }
    __syncthreads();
    if (threadIdx.x == 0) {
        stat1[2 * m] = mean; stat1[2 * m + 1] = rstd;
        int gs = 0; for (int j = 1; j < 4; ++j) if (lg[j] > lg[gs]) gs = j;
        float den = 0.f; for (int j = 0; j < 4; ++j) den += expf(lg[j] - lg[gs]);
        const float pg = 1.0f / den;
        const float* le = lg + 4 + 8 * gs; int i0 = 0; for (int j = 1; j < 8; ++j) if (le[j] > le[i0]) i0 = j;
        int i1 = (i0 == 0) ? 1 : 0; for (int j = 0; j < 8; ++j) if (j != i0 && le[j] > le[i1]) i1 = j;
        const float ex = expf(le[i1] - le[i0]); const float q0 = pg / (1.0f + ex), q1 = pg * ex / (1.0f + ex);
        const int e0 = gs * 8 + i0, e1 = gs * 8 + i1;
        const unsigned p0 = atomicAdd(&cnt[e0], 1u), p1 = atomicAdd(&cnt[e1], 1u);
        list[e0 * 8192 + p0] = m; ql[e0 * 8192 + p0] = q0; list[e1 * 8192 + p1] = m; ql[e1 * 8192 + p1] = q1;
        unsigned* r = route + (size_t)m * 8; r[0] = e0; r[1] = e1; r[2] = __float_as_uint(q0); r[3] = __float_as_uint(q1); r[4] = p0; r[5] = p1;
    }
}
__device__ __forceinline__ int slot_off(const unsigned* cnt, int e) { int o = 0; for (int j = 0; j < e; ++j) o += ((int)cnt[j] + 255) & ~255; return o; }
__global__ void __launch_bounds__(512) nv_moe_up(const bf16_t* H1, const unsigned* route, const unsigned* cnt, const float* wgate, const float* wup, bf16_t* HH) {
    __shared__ float xs[D];
    const int m = blockIdx.x >> 1, k = blockIdx.x & 1; const unsigned* r = route + (size_t)m * 8;
    const int e = (int)r[k]; const float q = __uint_as_float(r[2 + k]); const int slot = slot_off(cnt, e) + (int)r[4 + k];
    for (int c = threadIdx.x; c < D; c += 512) xs[c] = bf2f(H1[(size_t)m * D + c]);
    __syncthreads();
    const int f = threadIdx.x; const float* wgp = wgate + (size_t)e * D * FF + f; const float* wup_ = wup + (size_t)e * D * FF + f;
    float g = 0.f, u = 0.f;
    for (int d = 0; d < D; ++d) { g += xs[d] * wgp[(size_t)d * FF]; u += xs[d] * wup_[(size_t)d * FF]; }
    HH[(size_t)slot * FF + f] = (bf16_t)f2bf(silu_(g) * u * q);
}
__global__ void __launch_bounds__(512) nv_moe_down(const bf16_t* HH, const unsigned* route, const unsigned* cnt, const float* wdown, bf16_t* YF) {
    __shared__ float hs[FF];
    const int m = blockIdx.x >> 1, k = blockIdx.x & 1; const unsigned* r = route + (size_t)m * 8;
    const int e = (int)r[k]; const int slot = slot_off(cnt, e) + (int)r[4 + k];
    hs[threadIdx.x] = bf2f(HH[(size_t)slot * FF + threadIdx.x]);
    __syncthreads();
    const float* wd = wdown + (size_t)e * FF * D;
    for (int i = 0; i < 4; ++i) { const int d = threadIdx.x + 512 * i; float y = 0.f;
        for (int f = 0; f < FF; ++f) y += hs[f] * wd[(size_t)f * D + d];
        YF[(size_t)slot * D + d] = (bf16_t)f2bf(y); }
}
__global__ void __launch_bounds__(256) nv_final(const float* Y1, const float* stat1, const float* g1, const float* b1, const unsigned* route, const unsigned* cnt, const bf16_t* YF,
                                                const float* g2, const float* b2, float* out) {
    __shared__ float red[256];
    const int m = blockIdx.x; const unsigned* r = route + (size_t)m * 8;
    const int s0 = slot_off(cnt, (int)r[0]) + (int)r[4], s1 = slot_off(cnt, (int)r[1]) + (int)r[5];
    const float mean1 = stat1[2 * m], rstd1 = stat1[2 * m + 1];
    float v[8]; float s = 0.f;
    for (int i = 0; i < 8; ++i) { const int c = threadIdx.x + 256 * i;
        const float h1 = (Y1[(size_t)m * D + c] - mean1) * rstd1 * g1[c] + b1[c];
        v[i] = ALPHA * h1 + (bf2f(YF[(size_t)s0 * D + c]) + bf2f(YF[(size_t)s1 * D + c])); s += v[i]; }
    const float mean = block_sum256(s, red) * (1.0f / D); float q = 0.f;
    for (int i = 0; i < 8; ++i) { const float d = v[i] - mean; q += d * d; }
    const float rstd = 1.0f / sqrtf(block_sum256(q, red) * (1.0f / D) + LN_EPS);
    for (int i = 0; i < 8; ++i) { const int c = threadIdx.x + 256 * i; out[(size_t)m * D + c] = (v[i] - mean) * rstd * g2[c] + b2[c]; }
}


#define LAS __attribute__((address_space(3)))
#define GAS __attribute__((address_space(1)))
namespace pg8 {
constexpr int BM = 256, BK = 64, HALF = 128, HTB = HALF * BK * 2, STAGE_BYTES = 8 * HTB, NXCD = 8, WGM = 8;
__host__ __device__ __forceinline__ int lds_byte(int r, int c) { const int st = (r >> 4) * 2 + (c >> 5), rr = r & 15, cc = c & 31, ob = rr * 64 + cc * 2; return st * 1024 + (ob ^ (((ob >> 9) & 1) << 5)); }
__host__ __device__ __forceinline__ void stage_rc(int b, int& R, int& C) { const int st = b / 1024, sb = b % 1024, swz = sb ^ (((sb >> 9) & 1) << 5); R = (st >> 1) * 16 + swz / 64; C = (st & 1) * 32 + (swz % 64) / 2; }
__host__ __device__ __forceinline__ int perm32(int rho) { const int n = rho >> 4, i = rho & 15; return 8 * (i >> 2) + 4 * n + (i & 3); }

struct Unit { const char* a; const char* b; int pm, pn, e, mt; };

__device__ __forceinline__ unsigned cvt_pk_bf16(float lo, float hi) { unsigned r; asm volatile("v_cvt_pk_bf16_f32 %0, %1, %2" : "=v"(r) : "v"(lo), "v"(hi)); return r; }

struct DenseOrder {
    const char* A; const char* Bt; int K, nM, nN, nwg, G, c;
    __device__ void init(const void* A_, const void* Bt_, int Mr, int N, int K_, int G_, int c_) { A = (const char*)A_; Bt = (const char*)Bt_; K = K_; nM = Mr / BM; nN = N / BM; nwg = nM * nN; G = G_; c = c_; }
    __device__ bool next(int i, Unit& u) const {
        const long L = (long)i * G + c; if (L >= nwg) return false;
        int wgid = (int)L; { const int q = nwg / NXCD, r = nwg % NXCD, xcd = wgid % NXCD, off = wgid / NXCD; wgid = (xcd < r ? xcd * (q + 1) : r * (q + 1) + (xcd - r) * q) + off; }
        const int nig = WGM * nN, gid = wgid / nig, fm = gid * WGM, gsz = (nM - fm) < WGM ? (nM - fm) : WGM;
        u.pm = fm + ((wgid % nig) % gsz); u.pn = (wgid % nig) / gsz; u.e = 0; u.mt = 0;
        u.a = A + (size_t)u.pm * BM * K * 2; u.b = Bt + (size_t)u.pn * BM * K * 2; return true;
    }
    __device__ __forceinline__ void gather(const Unit&, const int (&)[2], const int (&)[2], unsigned (&)[2][2]) const {}
};

template <class Epi, class Sched, bool GATHER, bool ALIGN_EPI, bool SP2>
__device__ __forceinline__ void gemm_phase(LAS unsigned char* lds, const int K, const Sched& S, const Epi& E) {
    const int tid = threadIdx.x, wid = __builtin_amdgcn_readfirstlane(tid >> 6), lane = tid & 63, wr = wid >> 2, wc = wid & 3, fr = lane & 15, fq = lane >> 4;
    const int nt = K / BK;
    unsigned voffA[2], voffB[2]; int stR[2], stC[2];
#pragma unroll
    for (int i = 0; i < 2; ++i) { int R, C; stage_rc(tid * 16 + i * 8192, R, C); const int Rb = Epi::PERM ? ((R & ~31) + perm32(R & 31)) : R;
        voffA[i] = (unsigned)(R * K + C) * 2u; voffB[i] = (unsigned)(Rb * K + C) * 2u; stR[i] = R; stC[i] = C; }
    unsigned voffG[2][2] = {{0u, 0u}, {0u, 0u}}, voffGn[2][2] = {{0u, 0u}, {0u, 0u}};
    const size_t kstep = (size_t)(BK * 2);
    const size_t hstep = (size_t)HALF * K * 2;
    const unsigned ldsw = (unsigned)wid * 1024u;
    const int aoff = lds_byte(wr * 64 + fr, fq * 8), boff = lds_byte(wc * 32 + fr, fq * 8);
#define PG8_SA(b, h) (((b) * 2 + (h)) * HTB)
#define PG8_SB(b, h) ((4 + (b) * 2 + (h)) * HTB)
#define PG8_STAGE(bufoff, gbase, voff) do { _Pragma("unroll") for (int _i = 0; _i < 2; ++_i) \
        __builtin_amdgcn_global_load_lds((const unsigned*)((const char*)(gbase) + (voff)[_i]), (LAS unsigned*)(lds + (bufoff) + ldsw + _i * 8192), 16, 0, 0); } while (0)
#define PG8_STAGE_A(bufoff, gk, h, og) do { if constexpr (GATHER) { PG8_STAGE(bufoff, gk, (og)[h]); } else { PG8_STAGE(bufoff, (gk) + (h) * hstep, voffA); } } while (0)
#define PG8_LDA(dst, b, h) do { _Pragma("unroll") for (int m = 0; m < 4; ++m) _Pragma("unroll") for (int k = 0; k < 2; ++k) dst[m][k] = *(const LAS bf16x8*)(lds + PG8_SA(b, h) + aoff + m * 2048 + k * 1024); } while (0)
#define PG8_LDB(dst, b, h) do { _Pragma("unroll") for (int n = 0; n < 2; ++n) _Pragma("unroll") for (int k = 0; k < 2; ++k) dst[n][k] = *(const LAS bf16x8*)(lds + PG8_SB(b, h) + boff + n * 2048 + k * 1024); } while (0)
#define PG8_MMA(ai, bj, At, Bt) do { __builtin_amdgcn_s_setprio(1); _Pragma("unroll") for (int m = 0; m < 4; ++m) _Pragma("unroll") for (int n = 0; n < 2; ++n) _Pragma("unroll") for (int k = 0; k < 2; ++k) \
        acc[ai][bj][m][n] = __builtin_amdgcn_mfma_f32_16x16x32_bf16(Bt[n][k], At[m][k], acc[ai][bj][m][n], 0, 0, 0); __builtin_amdgcn_s_setprio(0); } while (0)
#define PG8_WAIT_V(n) asm volatile("s_waitcnt vmcnt(" #n ")" ::: "memory")
#define PG8_WAIT_L(n) asm volatile("s_waitcnt lgkmcnt(" #n ")" ::: "memory")
#define PG8_BAR __builtin_amdgcn_s_barrier()
#define PG8_SCHED __builtin_amdgcn_sched_barrier(0)
    Unit cur, nxt; int ui = 0;
    if (!S.next(0, cur)) return;
    f32x4 acc[2][2][4][2];
#pragma unroll
    for (int a = 0; a < 2; ++a)
#pragma unroll
        for (int b = 0; b < 2; ++b)
#pragma unroll
            for (int m = 0; m < 4; ++m)
#pragma unroll
                for (int n = 0; n < 2; ++n) acc[a][b][m][n] = (f32x4){0.f, 0.f, 0.f, 0.f};
    bf16x8 At[4][2], B0[2][2], B1[2][2];
    const char* cA = cur.a; const char* cB = cur.b;
    if constexpr (GATHER) { S.gather(cur, stR, stC, voffG); asm volatile("s_waitcnt vmcnt(0)" ::: "memory"); }
    if constexpr (SP2) {
        PG8_STAGE(PG8_SB(0, 0), cB, voffB); PG8_STAGE(PG8_SB(0, 1), cB + hstep, voffB); PG8_STAGE_A(PG8_SA(0, 0), cA, 0, voffG); PG8_STAGE_A(PG8_SA(0, 1), cA, 1, voffG);
        if (wr == 1) PG8_BAR;
        PG8_WAIT_V(2); PG8_BAR;
        PG8_STAGE(PG8_SB(1, 0), cB + kstep, voffB); PG8_STAGE_A(PG8_SA(1, 0), cA + kstep, 0, voffG); PG8_STAGE(PG8_SB(1, 1), cB + hstep + kstep, voffB);
        PG8_WAIT_V(6); PG8_BAR;
    } else {
        PG8_STAGE(PG8_SB(0, 0), cB, voffB); PG8_STAGE_A(PG8_SA(0, 0), cA, 0, voffG); PG8_STAGE(PG8_SB(0, 1), cB + hstep, voffB); PG8_STAGE_A(PG8_SA(0, 1), cA, 1, voffG);
        if (wr == 1) PG8_BAR;
        PG8_WAIT_V(4); PG8_BAR;
        PG8_STAGE(PG8_SB(1, 0), cB + kstep, voffB); PG8_STAGE_A(PG8_SA(1, 0), cA + kstep, 0, voffG); PG8_STAGE(PG8_SB(1, 1), cB + hstep + kstep, voffB);
        PG8_WAIT_V(6); PG8_BAR;
    }
    for (;;) {
        const bool has_next = S.next(ui + 1, nxt);
        const char* nA = has_next ? nxt.a : cA; const char* nB = has_next ? nxt.b : cB;
        if constexpr (GATHER) { if (has_next) S.gather(nxt, stR, stC, voffGn); else {
#pragma unroll
            for (int h = 0; h < 2; ++h)
#pragma unroll
                for (int i = 0; i < 2; ++i) voffGn[h][i] = voffG[h][i]; } }
        for (int t = 0; t < nt; t += 2) {
            const bool last = (t == nt - 2);
            const char* a1 = cA + (size_t)(t + 1) * kstep;
            const char* a2 = last ? nA : cA + (size_t)(t + 2) * kstep; const char* b2 = last ? nB : cB + (size_t)(t + 2) * kstep;
            const char* a3 = a2 + kstep; const char* b3 = b2 + kstep;
            unsigned og2[2][2];
            if constexpr (GATHER) {
#pragma unroll
                for (int h = 0; h < 2; ++h)
#pragma unroll
                    for (int i = 0; i < 2; ++i) og2[h][i] = last ? voffGn[h][i] : voffG[h][i]; }
            if constexpr (SP2) {
            PG8_LDB(B0, 0, 0); PG8_LDB(B1, 0, 1); PG8_SCHED; PG8_LDA(At, 0, 0); PG8_STAGE_A(PG8_SA(1, 1), a1, 1, voffG);
            PG8_WAIT_V(8); PG8_WAIT_L(0); PG8_BAR; PG8_MMA(0, 0, At, B0); PG8_MMA(0, 1, At, B1); PG8_BAR; PG8_SCHED;
            PG8_LDA(At, 0, 1); PG8_STAGE(PG8_SB(0, 0), b2, voffB); PG8_STAGE(PG8_SB(0, 1), b2 + hstep, voffB); PG8_STAGE_A(PG8_SA(0, 0), a2, 0, og2);
            PG8_WAIT_V(8); PG8_WAIT_L(0); PG8_BAR; PG8_MMA(1, 0, At, B0); PG8_MMA(1, 1, At, B1); PG8_BAR; PG8_SCHED;
            PG8_LDB(B0, 1, 0); PG8_LDB(B1, 1, 1); PG8_SCHED; PG8_LDA(At, 1, 0); PG8_STAGE_A(PG8_SA(0, 1), a2, 1, og2);
            PG8_WAIT_V(8); PG8_WAIT_L(0); PG8_BAR; PG8_MMA(0, 0, At, B0); PG8_MMA(0, 1, At, B1); PG8_BAR; PG8_SCHED;
            PG8_LDA(At, 1, 1); PG8_STAGE(PG8_SB(1, 0), b3, voffB); PG8_STAGE(PG8_SB(1, 1), b3 + hstep, voffB); PG8_STAGE_A(PG8_SA(1, 0), a3, 0, og2);
            PG8_WAIT_V(8); PG8_WAIT_L(0); PG8_BAR; PG8_MMA(1, 0, At, B0); PG8_MMA(1, 1, At, B1); PG8_BAR; PG8_SCHED;
            } else {
            PG8_LDB(B0, 0, 0); PG8_SCHED; PG8_LDA(At, 0, 0); PG8_STAGE_A(PG8_SA(1, 1), a1, 1, voffG);
            PG8_WAIT_L(8); PG8_BAR; PG8_WAIT_L(0); PG8_MMA(0, 0, At, B0); PG8_BAR; PG8_SCHED;
            PG8_LDB(B1, 0, 1); PG8_STAGE(PG8_SB(0, 0), b2, voffB);
            PG8_BAR; PG8_WAIT_L(0); PG8_MMA(0, 1, At, B1); PG8_BAR;
            PG8_LDA(At, 0, 1); PG8_STAGE_A(PG8_SA(0, 0), a2, 0, og2);
            PG8_BAR; PG8_WAIT_L(0); PG8_MMA(1, 0, At, B0); PG8_BAR; PG8_SCHED;
            PG8_STAGE(PG8_SB(0, 1), b2 + hstep, voffB);
            PG8_WAIT_V(6); PG8_BAR; PG8_MMA(1, 1, At, B1); PG8_BAR;
            PG8_LDB(B0, 1, 0); PG8_SCHED; PG8_LDA(At, 1, 0); PG8_STAGE_A(PG8_SA(0, 1), a2, 1, og2);
            PG8_WAIT_L(8); PG8_BAR; PG8_WAIT_L(0); PG8_MMA(0, 0, At, B0); PG8_BAR; PG8_SCHED;
            PG8_LDB(B1, 1, 1); PG8_STAGE(PG8_SB(1, 0), b3, voffB);
            PG8_BAR; PG8_WAIT_L(0); PG8_MMA(0, 1, At, B1); PG8_BAR;
            PG8_LDA(At, 1, 1); PG8_STAGE_A(PG8_SA(1, 0), a3, 0, og2);
            PG8_BAR; PG8_WAIT_L(0); PG8_MMA(1, 0, At, B0); PG8_BAR; PG8_SCHED;
            PG8_STAGE(PG8_SB(1, 1), b3 + hstep, voffB);
            PG8_WAIT_V(6); PG8_BAR; PG8_MMA(1, 1, At, B1); PG8_BAR;
            }
        }
        if constexpr (ALIGN_EPI) { if (wr == 0) PG8_BAR; }
        E(acc, cur, wr, wc, fr, fq);
        if (!has_next) break;
#pragma unroll
        for (int a = 0; a < 2; ++a)
#pragma unroll
            for (int b = 0; b < 2; ++b)
#pragma unroll
                for (int m = 0; m < 4; ++m)
#pragma unroll
                    for (int n = 0; n < 2; ++n) acc[a][b][m][n] = (f32x4){0.f, 0.f, 0.f, 0.f};
        cur = nxt; cA = nA; cB = nB; ++ui;
        if constexpr (GATHER) {
#pragma unroll
            for (int h = 0; h < 2; ++h)
#pragma unroll
                for (int i = 0; i < 2; ++i) voffG[h][i] = voffGn[h][i]; }
        if constexpr (ALIGN_EPI) { if (wr == 1) PG8_BAR; }
    }
    PG8_WAIT_V(0);
    if constexpr (!ALIGN_EPI) { if (wr == 0) PG8_BAR; }
    PG8_BAR;
    (void)stR; (void)stC;
#undef PG8_SA
#undef PG8_SB
#undef PG8_STAGE
#undef PG8_STAGE_A
#undef PG8_LDA
#undef PG8_LDB
#undef PG8_MMA
#undef PG8_WAIT_V
#undef PG8_WAIT_L
#undef PG8_BAR
#undef PG8_SCHED
}
}
#ifndef MK_SP2
#define MK_SP2 true
#endif
#ifndef MK_ALIGN
#define MK_ALIGN true
#endif

constexpr int NWAVES = 8;
constexpr int RING_BYTES = 131072;
constexpr int MISC_OFF = RING_BYTES;
constexpr int LDS_BYTES = 147456;
constexpr int CW_BAR = 4096;
constexpr size_t WS_WRT = 4 * MiB;

typedef GAS unsigned gu32;
#define RLX_AGENT __ATOMIC_RELAXED, __HIP_MEMORY_SCOPE_AGENT
#define LDS_WAIT() asm volatile("s_waitcnt lgkmcnt(0)" ::: "memory")
#define VM_WAIT() asm volatile("s_waitcnt vmcnt(0)" ::: "memory")
__device__ __forceinline__ unsigned pk2(float lo, float hi) { return f2bf(lo) | (f2bf(hi) << 16); }

#define XB_TMO      128
#define XB_XCNT(j)  (256  + 64 * (j))
#define XB_XSUB(j)  (1280 + 64 * (j))
#define XB_XGEN(j)  (2304 + 64 * (j))
#define XB_TOP      3328
#define XB_TOPGEN   3392
#define XCD_BAR_WORDS 3456
#define XB_SPIN_CAP (1u << 18)
__device__ __forceinline__ unsigned xb_ld(unsigned* p)              { return __hip_atomic_load(p, __ATOMIC_RELAXED, __HIP_MEMORY_SCOPE_AGENT); }
__device__ __forceinline__ unsigned xb_add(unsigned* p, unsigned v) { return __hip_atomic_fetch_add(p, v, __ATOMIC_RELAXED, __HIP_MEMORY_SCOPE_AGENT); }
__device__ __forceinline__ unsigned xb_xcc_id() { return (unsigned)__builtin_amdgcn_s_getreg((3 << 11) | 20) & 0xFu; }
#define XB_SPIN(cond, bar) do { unsigned _sp = 0; while (cond) { __builtin_amdgcn_s_sleep(1); \
    if ((++_sp & 255u) == 0u) { if (xb_ld(&(bar)[XB_TMO])) break; if (_sp > XB_SPIN_CAP) { atomicAdd(&(bar)[XB_TMO], 1u); break; } } } } while (0)
struct XcdBarrier { unsigned* bar; unsigned x; volatile LAS unsigned* st; };
__device__ __forceinline__ XcdBarrier xcd_barrier_post(unsigned* bar, volatile LAS unsigned* st) {
    XcdBarrier b; b.bar = bar; b.x = xb_xcc_id(); b.st = st;
    if (threadIdx.x == 0) (void)xb_add(&bar[XB_XCNT(b.x)], 1u);
    return b;
}
__device__ __forceinline__ void xcd_barrier_complete(unsigned* bar, unsigned x, unsigned& nloc, unsigned& nx) {
    const unsigned G = gridDim.x * gridDim.y * gridDim.z;
    unsigned sum, cnt, mine, sp = 0u;
    for (;;) {
        sum = 0u; cnt = 0u; mine = 0u;
#pragma unroll
        for (unsigned j = 0; j < 16; ++j) { const unsigned c = xb_ld(&bar[XB_XCNT(j)]); sum += c; cnt += (c > 0u) ? 1u : 0u; mine = (j == x) ? c : mine; }
        if (sum == G) break;
        __builtin_amdgcn_s_sleep(1);
        if ((++sp & 255u) == 0u) { if (xb_ld(&bar[XB_TMO])) break; if (sp > XB_SPIN_CAP) { atomicAdd(&bar[XB_TMO], 1u); break; } }
    }
    nloc = mine > 0u ? mine : 1u; nx = cnt > 0u ? cnt : 1u;
}
__device__ __forceinline__ void xcd_barrier(const XcdBarrier& b) {
    asm volatile("s_waitcnt vmcnt(0)" ::: "memory");
    __syncthreads();
    if (threadIdx.x == 0) {
        unsigned* bar = b.bar;
        __builtin_amdgcn_s_waitcnt(0);
        unsigned nloc = b.st[0], nx = b.st[1];
        if (nloc == 0u) { xcd_barrier_complete(bar, b.x, nloc, nx); b.st[0] = nloc; b.st[1] = nx; }
        const unsigned old = xb_add(&bar[XB_XSUB(b.x)], 1u);
        const unsigned gen = old / nloc;
        if (old + 1u == (gen + 1u) * nloc) {
            __builtin_amdgcn_fence(__ATOMIC_RELEASE, "agent");
            asm volatile("s_waitcnt vmcnt(0)" ::: "memory");
            const unsigned og = xb_add(&bar[XB_TOP], 1u);
            const unsigned tg = og / nx;
            if (og + 1u == (tg + 1u) * nx) xb_add(&bar[XB_TOPGEN], 1u);
            else XB_SPIN(xb_ld(&bar[XB_TOPGEN]) == tg, bar);
            __builtin_amdgcn_fence(__ATOMIC_ACQUIRE, "agent");
            xb_add(&bar[XB_XGEN(b.x)], 1u);
            asm volatile("s_waitcnt vmcnt(0)" ::: "memory");
        } else {
            XB_SPIN(xb_ld(&bar[XB_XGEN(b.x)]) == gen, bar);
            __builtin_amdgcn_fence(__ATOMIC_ACQUIRE, "agent");
            asm volatile("s_waitcnt vmcnt(0)" ::: "memory");
        }
    }
    __syncthreads();
}

struct Frame {
    LAS unsigned char* lds; volatile LAS unsigned* MISC;
    int tid, lane, wave, vcu, G;
    const float* const* in; float* out; unsigned char* ws;
};
__device__ __forceinline__ float wave_sum(float v) {
#pragma unroll
    for (int o = 1; o < 64; o <<= 1) v += __shfl_xor(v, o);
    return v;
}

struct TrItem { const float* W; bf16_t* WT; int K, N, mode, k0, n0; };
__device__ __forceinline__ void tr_load(const TrItem& it, int lane, f32x4 (&v)[8]) {
    const int r8 = lane >> 3, c4 = (lane & 7) * 4;
#pragma unroll
    for (int i = 0; i < 8; ++i) v[i] = __builtin_nontemporal_load((const f32x4*)(it.W + (size_t)(it.k0 + 8 * i + r8) * it.N + it.n0 + c4));
}
__device__ __forceinline__ void tr_finish(const TrItem& it, int lane, const f32x4 (&v)[8], LAS float* scr) {
    const int r8 = lane >> 3, c4 = (lane & 7) * 4;
#pragma unroll
    for (int i = 0; i < 8; ++i) { LAS float* d = scr + (8 * i + r8) * 33 + c4; d[0] = v[i].x; d[1] = v[i].y; d[2] = v[i].z; d[3] = v[i].w; }
    LDS_WAIT(); asm volatile("" ::: "memory");
    const int c = lane & 7; const int d0 = dst_row(it.n0, it.mode);
#pragma unroll
    for (int j = 0; j < 4; ++j) { const int n = (lane >> 3) + 8 * j; const LAS float* s = scr + (8 * c) * 33 + n;
        u32x4 o; o.x = pk2(s[0 * 33], s[1 * 33]); o.y = pk2(s[2 * 33], s[3 * 33]); o.z = pk2(s[4 * 33], s[5 * 33]); o.w = pk2(s[6 * 33], s[7 * 33]);
        *(u32x4*)(it.WT + (size_t)(d0 + n) * it.K + it.k0 + 8 * c) = o; }
    LDS_WAIT(); asm volatile("" ::: "memory");
}
__device__ __forceinline__ void p0_transpose_item(const float* W, int K, int N, bf16_t* WT, int mode, LAS float* scr, int item, int lane) {
    const int nblk = N / 32; TrItem it{W, WT, K, N, mode, 64 * (item / nblk), 32 * (item % nblk)};
    f32x4 v[8]; tr_load(it, lane, v); tr_finish(it, lane, v, scr);
}
__device__ __forceinline__ void p0_prologue(Frame& F) {
    LAS float* scr = (LAS float*)(F.lds + F.wave * 16384);
    const int gw = F.vcu * NWAVES + F.wave, NGW = F.G * NWAVES, lane = F.lane;
    unsigned char* ws = F.ws;
    { const float* g = F.in[1]; const float* b = F.in[2]; bf16_t* H0 = (bf16_t*)(ws + WS_H0); float* stat = (float*)(ws + WS_STAT0);
      for (int m = gw; m < M; m += NGW) {
        const f32x4* xr = (const f32x4*)(F.in[0] + (size_t)m * D) + lane;
        f32x4 v[8]; float s = 0.f;
#pragma unroll
        for (int j = 0; j < 8; ++j) { v[j] = xr[64 * j]; s += (v[j].x + v[j].y) + (v[j].z + v[j].w); }
        const float mean = wave_sum(s) * (1.f / D); float s2 = 0.f;
#pragma unroll
        for (int j = 0; j < 8; ++j) { v[j] = v[j] - mean; s2 += (v[j].x * v[j].x + v[j].y * v[j].y) + (v[j].z * v[j].z + v[j].w * v[j].w); }
        const float rstd = 1.f / sqrtf(wave_sum(s2) * (1.f / D) + LN_EPS);
        u32x2* o8 = (u32x2*)(H0 + (size_t)m * D) + lane;
#pragma unroll
        for (int j = 0; j < 8; ++j) { const f32x4 g4 = ((const f32x4*)g)[lane + 64 * j], b4 = ((const f32x4*)b)[lane + 64 * j]; const f32x4 h = v[j] * rstd * g4 + b4;
            u32x2 w; w.x = pk2(h.x, h.y); w.y = pk2(h.z, h.w); o8[64 * j] = w; }
        if (lane == 0) { stat[2 * m] = mean; stat[2 * m + 1] = rstd; }
      } }
    { bf16_t* wrh = (bf16_t*)(ws + WS_WRT); bf16_t* wrl = (bf16_t*)(ws + WS_WRT + 262144); float* sw = (float*)(ws + WS_WRT + 524288); float* cb = sw + 64;
      const float* g1 = F.in[16]; const float* b1 = F.in[17];
      for (int i = gw * 64 + lane; i < 48 * D; i += NGW * 64) { const int o = i / D, k = i % D; const float w = (o < 4 ? F.in[18][k * 4 + o] : (o < 36 ? F.in[20][k * 32 + (o - 4)] : 0.f)) * g1[k];
          const unsigned hi = f2bf(w); wrh[i] = (bf16_t)hi; wrl[i] = (bf16_t)f2bf(w - __uint_as_float(hi << 16)); }
      if (gw < 48) { const int o = gw; float s = 0.f, c = 0.f;
          if (o < 36) for (int k = lane; k < D; k += 64) { const float w = o < 4 ? F.in[18][k * 4 + o] : F.in[20][k * 32 + (o - 4)]; s += g1[k] * w; c += b1[k] * w; }
          s = wave_sum(s); c = wave_sum(c);
          if (lane == 0) { sw[o] = s; cb[o] = o < 36 ? c + (o < 4 ? F.in[19][o] : F.in[21][o - 4]) : 0.f; } } }
    constexpr int I_IN = (D / 64) * (4096 / 32), I_OUT = (D / 64) * (D / 32);
    constexpr int NITEMS = I_IN + I_OUT;
    for (int it = gw; it < NITEMS; it += NGW) {
        int r = it;
        if (r < I_IN) { p0_transpose_item(F.in[3], D, 4096, (bf16_t*)(ws + WS_BT1), 1, scr, r, lane); continue; } r -= I_IN;
        p0_transpose_item(F.in[15], D, D, (bf16_t*)(ws + WS_BT2), 0, scr, r, lane);
    }
}
__device__ __forceinline__ TrItem expert_item(Frame& F, int it) {
    constexpr int I_G = (D / 64) * (FF / 32), I_D = (FF / 64) * (D / 32), I_E = 2 * I_G + I_D;
    const int e = it / I_E; int r = it - e * I_E;
    bf16_t* btu = (bf16_t*)(F.ws + WS_BTU) + (size_t)e * 1024 * D; bf16_t* btd = (bf16_t*)(F.ws + WS_BTD) + (size_t)e * D * FF;
    if (r < I_G) return TrItem{F.in[22] + (size_t)e * D * FF, btu, D, FF, 2, 64 * (r / (FF / 32)), 32 * (r % (FF / 32))};
    r -= I_G;
    if (r < I_G) return TrItem{F.in[23] + (size_t)e * D * FF, btu, D, FF, 3, 64 * (r / (FF / 32)), 32 * (r % (FF / 32))};
    r -= I_G;
    return TrItem{F.in[24] + (size_t)e * FF * D, btd, FF, D, 0, 64 * (r / (D / 32)), 32 * (r % (D / 32))};
}
__device__ __forceinline__ void p0_experts(Frame& F) {
    LAS float* scr = (LAS float*)(F.lds + F.wave * 16384);
    const int gw = F.vcu * NWAVES + F.wave, NGW = F.G * NWAVES, lane = F.lane;
    constexpr int I_E = 2 * (D / 64) * (FF / 32) + (FF / 64) * (D / 32), NIT = NEXP * I_E;
    int it = gw; if (it >= NIT) { __syncthreads(); return; }
    TrItem cur = expert_item(F, it); f32x4 va[8], vb[8];
    tr_load(cur, lane, va);
    for (;;) {
        int nx = it + NGW; TrItem nxt = cur; const bool more = nx < NIT;
        if (more) { nxt = expert_item(F, nx); tr_load(nxt, lane, vb); }
        tr_finish(cur, lane, va, scr);
        if (!more) break;
        it = nx + NGW; cur = nxt; const bool more2 = it < NIT; TrItem n2 = cur;
        if (more2) { n2 = expert_item(F, it); tr_load(n2, lane, va); }
        tr_finish(cur, lane, vb, scr);
        if (!more2) break;
        cur = n2;
    }
    __syncthreads();
}

struct EpiZ {
    static constexpr bool PERM = true;
    bf16_t* Z;
    __device__ __forceinline__ void operator()(const f32x4 (&acc)[2][2][4][2], const pg8::Unit& u, int wr, int wc, int fr, int fq) const {
        const int row0 = u.pm * 256 + wr * 64 + fr;
        if (u.pn < 8) {
            const int col0 = u.pn * 256 + wc * 32 + 8 * fq; const bool act = u.pn >= 4;
#pragma unroll
            for (int ai = 0; ai < 2; ++ai)
#pragma unroll
                for (int m = 0; m < 4; ++m) { bf16_t* rowp = Z + (size_t)(row0 + ai * 128 + m * 16) * NZ + col0;
#pragma unroll
                    for (int bj = 0; bj < 2; ++bj) { f32x4 v0 = acc[ai][bj][m][0], v1 = acc[ai][bj][m][1];
                        if (act) {
#pragma unroll
                            for (int j = 0; j < 4; ++j) { v0[j] = gelu_tanh(v0[j]); v1[j] = gelu_tanh(v1[j]); } }
                        u32x4 w; w.x = pg8::cvt_pk_bf16(v0[0], v0[1]); w.y = pg8::cvt_pk_bf16(v0[2], v0[3]); w.z = pg8::cvt_pk_bf16(v1[0], v1[1]); w.w = pg8::cvt_pk_bf16(v1[2], v1[3]);
                        *(u32x4*)(rowp + bj * 128) = w; } }
        } else {
            const int col0 = 2048 + 128 * (u.pn - 8) + wc * 32 + 8 * fq;
#pragma unroll
            for (int ai = 0; ai < 2; ++ai)
#pragma unroll
                for (int m = 0; m < 4; ++m) { bf16_t* rowp = Z + (size_t)(row0 + ai * 128 + m * 16) * NZ + col0;
                    f32x4 v0 = acc[ai][0][m][0], v1 = acc[ai][0][m][1]; const f32x4 g0 = acc[ai][1][m][0], g1 = acc[ai][1][m][1];
#pragma unroll
                    for (int j = 0; j < 4; ++j) { v0[j] = v0[j] * sigmoidf_(g0[j]); v1[j] = v1[j] * sigmoidf_(g1[j]); }
                    u32x4 w; w.x = pg8::cvt_pk_bf16(v0[0], v0[1]); w.y = pg8::cvt_pk_bf16(v0[2], v0[3]); w.z = pg8::cvt_pk_bf16(v1[0], v1[1]); w.w = pg8::cvt_pk_bf16(v1[2], v1[3]);
                    *(u32x4*)rowp = w; }
        }
    }
};
struct EpiY1 {
    static constexpr bool PERM = false;
    float* Y1; const float* x; const float* stat0; const float* g; const float* b;
    __device__ __forceinline__ void operator()(const f32x4 (&acc)[2][2][4][2], const pg8::Unit& u, int wr, int wc, int fr, int fq) const {
        const int row0 = u.pm * 256 + wr * 64 + fr, col0 = u.pn * 256 + wc * 32 + 4 * fq;
        f32x4 gv[2][2], bv[2][2];
#pragma unroll
        for (int bj = 0; bj < 2; ++bj)
#pragma unroll
            for (int n = 0; n < 2; ++n) { gv[bj][n] = *(const f32x4*)(g + col0 + bj * 128 + n * 16) * ALPHA; bv[bj][n] = *(const f32x4*)(b + col0 + bj * 128 + n * 16) * ALPHA; }
#pragma unroll
        for (int ai = 0; ai < 2; ++ai)
#pragma unroll
            for (int m = 0; m < 4; ++m) { const int r = row0 + ai * 128 + m * 16; const float mean = stat0[2 * r], rstd = stat0[2 * r + 1]; const size_t off = (size_t)r * D + col0;
#pragma unroll
                for (int bj = 0; bj < 2; ++bj)
#pragma unroll
                    for (int n = 0; n < 2; ++n) { const f32x4 xv = *(const f32x4*)(x + off + bj * 128 + n * 16);
                        *(f32x4*)(Y1 + off + bj * 128 + n * 16) = acc[ai][bj][m][n] + ((xv - mean) * rstd) * gv[bj][n] + bv[bj][n]; }
                asm volatile("" ::: "memory"); }
    }
};


template <int SH> __device__ __forceinline__ float row_shr(float v, float ident) {
    return __int_as_float(__builtin_amdgcn_update_dpp(__float_as_int(ident), __float_as_int(v), 0x110 + SH, 0xF, 0xF, false)); }
__device__ __forceinline__ float bcast15(float v) { return __int_as_float(__builtin_amdgcn_ds_swizzle(__float_as_int(v), 0x1F0)); }
__device__ __forceinline__ float bflo(unsigned x) { return __uint_as_float(x << 16); }
__device__ __forceinline__ float bfhi(unsigned x) { return __uint_as_float(x & 0xffff0000u); }
#define SCAN_STEP(SH) do { const float pp = row_shr<SH>(p, 1.0f), hp = row_shr<SH>(h, 0.0f); h = p * hp + h; p = p * pp; } while (0)
__device__ __forceinline__ void lru_unit(Frame& F, int unit) {
    const int b = unit >> 7, hd = (unit >> 3) & 15, s = unit & 7;
    const int lane = F.lane, wave = F.wave, fr = lane & 15, fq = lane >> 4;
    const float* w4 = F.in[4]; const float* b4 = F.in[5]; const float* wa = F.in[6]; const float* ba = F.in[7]; const float* wx = F.in[8]; const float* bx = F.in[9]; const float* lam = F.in[10];
    const bf16_t* ZP = (const bf16_t*)(F.ws + WS_ZP); bf16_t* MIX = (bf16_t*)(F.ws + WS_MIX);
    bf16x8 Afr[8];
    {
        const int gsel = (fr >> 1) & 1, ch = 2 * (fr >> 2) + (fr & 1);
        const float* Wg = (gsel ? wx : wa) + (size_t)hd * 4096 + 8 * s + ch;
#pragma unroll
        for (int ks = 0; ks < 8; ++ks) { const int j = ks >> 1, cb = 32 * (ks & 1) + 8 * fq; float v[8];
#pragma unroll
            for (int jj = 0; jj < 8; ++jj) { const int c = cb + jj; v[jj] = w4[j * DL + 64 * hd + c] * Wg[c * 64]; }
            u32x4 w; w.x = pk2(v[0], v[1]); w.y = pk2(v[2], v[3]); w.z = pk2(v[4], v[5]); w.w = pk2(v[6], v[7]);
            Afr[ks] = __builtin_bit_cast(bf16x8, w); }
    }
    float gb[4];
#pragma unroll
    for (int reg = 0; reg < 4; ++reg) { const int gsel = reg >> 1, ch = 2 * fq + (reg & 1); const float* Wg = (gsel ? wx : wa) + (size_t)hd * 4096 + 8 * s + ch;
        float a = 0.f;
#pragma unroll
        for (int i = 0; i < 4; ++i) { const int c = 4 * fr + i; a += b4[64 * hd + c] * Wg[c * 64]; }
        a += __shfl_xor(a, 1); a += __shfl_xor(a, 2); a += __shfl_xor(a, 4); a += __shfl_xor(a, 8);
        gb[reg] = a + (gsel ? bx : ba)[64 * hd + 8 * s + ch]; }
    float sp8[2], w4c[4][2], b4c[2];
#pragma unroll
    for (int e = 0; e < 2; ++e) { const int cch = 64 * hd + 8 * s + 2 * fq + e; const float l = lam[cch]; sp8[e] = 8.0f * ((-l > 20.f) ? -l : log1pf(expf(-l))); b4c[e] = b4[cch];
#pragma unroll
        for (int j = 0; j < 4; ++j) w4c[j][e] = w4[j * DL + cch]; }
    float carryH[2] = {0.f, 0.f};
    LAS float* tot = (LAS float*)F.lds;
    LAS unsigned char* tile = F.lds + 1024 + wave * 12544;
    LAS unsigned char* otile = tile + 10368;
    const bf16_t* zx = ZP + (size_t)b * SEQ * NZ + 64 * hd + 8 * (lane & 7);
    const bf16_t* zg = ZP + (size_t)b * SEQ * NZ + 1024 + 64 * hd + 8 * s;
    u32x4 pf[9], pg;
#define LRU_ISSUE(ck_) do { const int tb_ = 512 * (ck_) + 64 * wave; \
        _Pragma("unroll") for (int i = 0; i < 9; ++i) { const int t_ = tb_ - 3 + 8 * i + (lane >> 3); const int tc_ = t_ < 0 ? 0 : (t_ > SEQ - 1 ? SEQ - 1 : t_); \
            const u32x4 v_ = *(const u32x4*)(zx + (size_t)tc_ * NZ); pf[i] = t_ >= 0 ? v_ : (u32x4){0u, 0u, 0u, 0u}; } \
        pg = *(const u32x4*)(zg + (size_t)(tb_ + lane) * NZ); } while (0)
    LRU_ISSUE(0);
#pragma unroll 1
    for (int ck = 0; ck < 8; ++ck) {
        const int tb = 512 * ck + 64 * wave;
#pragma unroll
        for (int i = 0; i < 9; ++i) *(LAS u32x4*)(tile + (8 * i + (lane >> 3)) * 144 + 16 * (lane & 7)) = pf[i];
        const u32x4 gcur = pg;
        if (ck < 7) LRU_ISSUE(ck + 1);
        f32x4 Dm[4];
#pragma unroll
        for (int m = 0; m < 4; ++m) { Dm[m] = (f32x4){0.f, 0.f, 0.f, 0.f};
#pragma unroll
            for (int ks = 0; ks < 8; ++ks) { const bf16x8 bfr = *(const LAS bf16x8*)(tile + (16 * m + fr + (ks >> 1)) * 144 + (32 * (ks & 1) + 8 * fq) * 2);
                Dm[m] = __builtin_amdgcn_mfma_f32_16x16x32_bf16(Afr[ks], bfr, Dm[m], 0, 0, 0); } }
        float P[4][2], Hh[4][2];
#pragma unroll
        for (int m = 0; m < 4; ++m) {
            float ain[2] = {b4c[0], b4c[1]};
#pragma unroll
            for (int j = 0; j < 4; ++j) { const unsigned xw = *(const LAS unsigned*)(tile + (16 * m + fr + j) * 144 + (8 * s + 2 * fq) * 2);
                ain[0] += w4c[j][0] * bflo(xw); ain[1] += w4c[j][1] * bfhi(xw); }
#pragma unroll
            for (int e = 0; e < 2; ++e) { const float r = sigmoidf_(Dm[m][e] + gb[e]), ig = sigmoidf_(Dm[m][2 + e] + gb[2 + e]);
                const float la = -r * sp8[e], a = fexp_(la), x2 = 2.0f * la;
                const float om = (x2 > -0.25f) ? -x2 * (1.0f + x2 * (0.5f + x2 * (0.16666667f + x2 * (0.041666668f + x2 * 0.0083333338f)))) : 1.0f - a * a;
                P[m][e] = a; Hh[m][e] = fsqrt_(om) * (ig * ain[e]); } }
        float cP[2] = {1.f, 1.f}, cH[2] = {0.f, 0.f};
#pragma unroll
        for (int m = 0; m < 4; ++m)
#pragma unroll
            for (int e = 0; e < 2; ++e) { float p = P[m][e], h = Hh[m][e];
                SCAN_STEP(1); SCAN_STEP(2); SCAN_STEP(4); SCAN_STEP(8);
                h = h + p * cH[e]; p = p * cP[e];
                P[m][e] = p; Hh[m][e] = h; cH[e] = bcast15(h); cP[e] = bcast15(p); }
        const int buf = ck & 1;
        if (fr == 0) {
#pragma unroll
            for (int e = 0; e < 2; ++e) { tot[((buf * 8 + wave) * 8 + 2 * fq + e) * 2 + 0] = cP[e]; tot[((buf * 8 + wave) * 8 + 2 * fq + e) * 2 + 1] = cH[e]; } }
        LDS_WAIT(); __syncthreads();
        float hin[2] = {carryH[0], carryH[1]}, hmine[2] = {0.f, 0.f};
#pragma unroll
        for (int w2 = 0; w2 < 8; ++w2) {
#pragma unroll
            for (int e = 0; e < 2; ++e) { if (w2 == wave) hmine[e] = hin[e];
                const float tp = tot[((buf * 8 + w2) * 8 + 2 * fq + e) * 2 + 0], th = tot[((buf * 8 + w2) * 8 + 2 * fq + e) * 2 + 1]; hin[e] = tp * hin[e] + th; } }
        carryH[0] = hin[0]; carryH[1] = hin[1];
#pragma unroll
        for (int m = 0; m < 4; ++m) *(LAS f32x2*)(otile + (16 * m + fr) * 32 + fq * 8) = (f32x2){Hh[m][0] + P[m][0] * hmine[0], Hh[m][1] + P[m][1] * hmine[1]};
        LDS_WAIT();
        const f32x4 h0 = *(const LAS f32x4*)(otile + lane * 32), h1 = *(const LAS f32x4*)(otile + lane * 32 + 16);
        u32x4 o; o.x = pk2(bflo(gcur.x) * h0.x, bfhi(gcur.x) * h0.y); o.y = pk2(bflo(gcur.y) * h0.z, bfhi(gcur.y) * h0.w);
        o.z = pk2(bflo(gcur.z) * h1.x, bfhi(gcur.z) * h1.y); o.w = pk2(bflo(gcur.w) * h1.z, bfhi(gcur.w) * h1.w);
        *(u32x4*)(MIX + ((size_t)b * SEQ + tb + lane) * D + 64 * hd + 8 * s) = o;
    }
#undef LRU_ISSUE
    __syncthreads();
}
#undef SCAN_STEP
__device__ __forceinline__ void conv31_unit(Frame& F, int unit) {
    constexpr int CT = 16;
    const int tid = F.tid, lane = F.lane, wave = F.wave, m0 = unit * 32, c2 = 2 * tid;
    const __amdgpu_buffer_rsrc_t rw = __builtin_amdgcn_make_buffer_rsrc((void*)F.in[11], 0, 31 * DC * 4, 0x00020000);
    const __amdgpu_buffer_rsrc_t rz = __builtin_amdgcn_make_buffer_rsrc((void*)(F.ws + WS_ZP), 0, M * NZ * 2, 0x00020000);
    bf16_t* MIX = (bf16_t*)(F.ws + WS_MIX);
    const f32x2 bs = *(const f32x2*)(F.in[12] + c2), g2 = *(const f32x2*)(F.in[13] + c2), b2 = *(const f32x2*)(F.in[14] + c2);
    LAS float* red = (LAS float*)(F.lds + 4096);
    LAS float* tot2 = (LAS float*)(F.lds + 4096 + 1024);
    f32x2 wj[31];
#pragma unroll
    for (int j = 0; j < 31; ++j) { const u32x2 t = __builtin_amdgcn_raw_buffer_load_b64(rw, c2 * 4, j * DC * 4, 0); wj[j] = __builtin_bit_cast(f32x2, t); }
#pragma unroll 1
    for (int pass = 0; pass < 32 / CT; ++pass) {
        const int tok0 = m0 + CT * pass, t0 = tok0 % SEQ;
        unsigned xin[CT + 30];
#pragma unroll
        for (int i = 0; i < CT + 30; ++i) { const int tt = t0 - 30 + i; const int row = tt >= 0 ? tok0 - 30 + i : tok0;
            const unsigned v = __builtin_amdgcn_raw_buffer_load_b32(rz, (2048 + c2) * 2, row * (NZ * 2), 0); xin[i] = tt >= 0 ? v : 0u; }
        float a0[CT], a1[CT];
#pragma unroll
        for (int o = 0; o < CT; ++o) { float x0 = bs.x, x1 = bs.y;
#pragma unroll
            for (int j = 0; j < 31; ++j) { x0 += wj[j].x * bflo(xin[o + j]); x1 += wj[j].y * bfhi(xin[o + j]); }
            a0[o] = x0; a1[o] = x1; }
#pragma unroll
        for (int o = 0; o < CT; ++o) { const float sm = wave_sum(a0[o] + a1[o]), sq = wave_sum(a0[o] * a0[o] + a1[o] * a1[o]);
            if (lane == 0) { red[(wave * CT + o) * 2] = sm; red[(wave * CT + o) * 2 + 1] = sq; } }
        LDS_WAIT(); __syncthreads();
        if (tid < 2 * CT) { float t = 0.f;
#pragma unroll
            for (int w2 = 0; w2 < 8; ++w2) t += red[w2 * 2 * CT + tid];
            tot2[tid] = t; }
        LDS_WAIT(); __syncthreads();
#pragma unroll
        for (int o = 0; o < CT; ++o) { const float mean = tot2[2 * o] * (1.0f / DC), var = tot2[2 * o + 1] * (1.0f / DC) - mean * mean, rstd = frsq_(var + LN_EPS);
            const float y0 = silu_((a0[o] - mean) * rstd * g2.x + b2.x), y1 = silu_((a1[o] - mean) * rstd * g2.y + b2.y);
            *(unsigned*)(MIX + (size_t)(tok0 + o) * D + 1024 + c2) = pk2(y0, y1); }
        __syncthreads();
    }
}

__device__ __forceinline__ void router_unit(Frame& F, int unit, bool publish) {
    const int tid = F.tid, lane = F.lane, wave = F.wave, m0 = 32 * unit;
    const float* Y1 = (const float*)(F.ws + WS_Y1); const float* g1 = F.in[16]; const float* b1 = F.in[17];
    const bf16_t* WRH = (const bf16_t*)(F.ws + WS_WRT); const bf16_t* WRL = (const bf16_t*)(F.ws + WS_WRT + 262144); const float* SW = (const float*)(F.ws + WS_WRT + 524288); const float* CB = SW + 64;
    bf16_t* H1 = (bf16_t*)(F.ws + WS_H1); float* stat1 = (float*)(F.ws + WS_STAT1);
    LAS float* st = (LAS float*)F.lds;
    LAS float* pst = (LAS float*)(F.lds + 256);
    LAS float* part = (LAS float*)(F.lds + 2048);
    LAS float* lgt = (LAS float*)(F.lds + 2048 + 24576);
    {
        const int mt = wave & 1, kp = wave >> 1, i = lane & 15, q = lane >> 4;
        const float* yr = Y1 + (size_t)(m0 + 16 * mt + i) * D + 512 * kp + 8 * q;
        const bf16_t* wh = WRH + (size_t)i * D + 512 * kp + 8 * q; const bf16_t* wl = WRL + (size_t)i * D + 512 * kp + 8 * q;
        f32x4 acc0 = (f32x4){0.f, 0.f, 0.f, 0.f}, acc1 = acc0, acc2 = acc0; float s = 0.f, sq = 0.f;
#pragma unroll 4
        for (int ks = 0; ks < 16; ++ks) {
            const f32x4 ya = *(const f32x4*)(yr + 32 * ks), yb = *(const f32x4*)(yr + 32 * ks + 4);
            const bf16x8 bh0 = *(const bf16x8*)(wh + 32 * ks), bh1 = *(const bf16x8*)(wh + 16 * D + 32 * ks), bh2 = *(const bf16x8*)(wh + 32 * D + 32 * ks);
            const bf16x8 bl0 = *(const bf16x8*)(wl + 32 * ks), bl1 = *(const bf16x8*)(wl + 16 * D + 32 * ks), bl2 = *(const bf16x8*)(wl + 32 * D + 32 * ks);
            s += ((ya.x + ya.y) + (ya.z + ya.w)) + ((yb.x + yb.y) + (yb.z + yb.w));
            sq += ((ya.x * ya.x + ya.y * ya.y) + (ya.z * ya.z + ya.w * ya.w)) + ((yb.x * yb.x + yb.y * yb.y) + (yb.z * yb.z + yb.w * yb.w));
            u32x4 h; h.x = pg8::cvt_pk_bf16(ya.x, ya.y); h.y = pg8::cvt_pk_bf16(ya.z, ya.w); h.z = pg8::cvt_pk_bf16(yb.x, yb.y); h.w = pg8::cvt_pk_bf16(yb.z, yb.w);
            u32x4 l; l.x = pg8::cvt_pk_bf16(ya.x - bflo(h.x), ya.y - bfhi(h.x)); l.y = pg8::cvt_pk_bf16(ya.z - bflo(h.y), ya.w - bfhi(h.y));
            l.z = pg8::cvt_pk_bf16(yb.x - bflo(h.z), yb.y - bfhi(h.z)); l.w = pg8::cvt_pk_bf16(yb.z - bflo(h.w), yb.w - bfhi(h.w));
            const bf16x8 ah = __builtin_bit_cast(bf16x8, h), al = __builtin_bit_cast(bf16x8, l);
            acc0 = __builtin_amdgcn_mfma_f32_16x16x32_bf16(ah, bh0, acc0, 0, 0, 0); acc1 = __builtin_amdgcn_mfma_f32_16x16x32_bf16(ah, bh1, acc1, 0, 0, 0); acc2 = __builtin_amdgcn_mfma_f32_16x16x32_bf16(ah, bh2, acc2, 0, 0, 0);
            acc0 = __builtin_amdgcn_mfma_f32_16x16x32_bf16(ah, bl0, acc0, 0, 0, 0); acc1 = __builtin_amdgcn_mfma_f32_16x16x32_bf16(ah, bl1, acc1, 0, 0, 0); acc2 = __builtin_amdgcn_mfma_f32_16x16x32_bf16(ah, bl2, acc2, 0, 0, 0);
            acc0 = __builtin_amdgcn_mfma_f32_16x16x32_bf16(al, bh0, acc0, 0, 0, 0); acc1 = __builtin_amdgcn_mfma_f32_16x16x32_bf16(al, bh1, acc1, 0, 0, 0); acc2 = __builtin_amdgcn_mfma_f32_16x16x32_bf16(al, bh2, acc2, 0, 0, 0);
        }
        s += __shfl_xor(s, 16); s += __shfl_xor(s, 32); sq += __shfl_xor(sq, 16); sq += __shfl_xor(sq, 32);
        if (q == 0) { pst[(kp * 32 + 16 * mt + i) * 2] = s; pst[(kp * 32 + 16 * mt + i) * 2 + 1] = sq; }
#pragma unroll
        for (int reg = 0; reg < 4; ++reg) { LAS float* pr = part + ((kp * 32) + 16 * mt + 4 * q + reg) * 48 + i; pr[0] = acc0[reg]; pr[16] = acc1[reg]; pr[32] = acc2[reg]; }
    }
    LDS_WAIT(); __syncthreads();
    if (tid < 32) { float s = 0.f, sq = 0.f;
#pragma unroll
        for (int kp = 0; kp < 4; ++kp) { s += pst[(kp * 32 + tid) * 2]; sq += pst[(kp * 32 + tid) * 2 + 1]; }
        const float mean = s * (1.f / D), var = sq * (1.f / D) - mean * mean, rstd = frsq_(var + LN_EPS);
        st[2 * tid] = mean; st[2 * tid + 1] = rstd; stat1[2 * (m0 + tid)] = mean; stat1[2 * (m0 + tid) + 1] = rstd; }
    LDS_WAIT(); __syncthreads();
    for (int idx = tid; idx < 32 * 36; idx += NWAVES * 64) { const int tok = idx / 36, o = idx % 36;
        float v = 0.f;
#pragma unroll
        for (int kp = 0; kp < 4; ++kp) v += part[(kp * 32 + tok) * 48 + o];
        lgt[tok * 36 + o] = st[2 * tok + 1] * (v - st[2 * tok] * SW[o]) + CB[o]; }
#pragma unroll 1
    for (int pr = 0; pr < 2; ++pr) {
        f32x4 v[2][8];
#pragma unroll
        for (int r = 0; r < 2; ++r) { const f32x4* yr = (const f32x4*)(Y1 + (size_t)(m0 + 4 * wave + 2 * pr + r) * D) + lane;
#pragma unroll
            for (int j = 0; j < 8; ++j) v[r][j] = yr[64 * j]; }
#pragma unroll
        for (int r = 0; r < 2; ++r) { const int rl = 4 * wave + 2 * pr + r; const float mean = st[2 * rl], rstd = st[2 * rl + 1];
            u32x2* o8 = (u32x2*)(H1 + (size_t)(m0 + rl) * D) + lane;
#pragma unroll
            for (int j = 0; j < 8; ++j) { const f32x4 g4 = ((const f32x4*)g1)[lane + 64 * j], b4 = ((const f32x4*)b1)[lane + 64 * j]; const f32x4 h = ((v[r][j] - mean) * rstd) * g4 + b4;
                u32x2 w; w.x = pk2(h.x, h.y); w.y = pk2(h.z, h.w); o8[64 * j] = w; } }
    }
    LDS_WAIT(); __syncthreads();
    if (tid < 32 && publish) {
        const int m = m0 + tid; const LAS float* lg = lgt + tid * 36;
        unsigned* cnt = (unsigned*)(F.ws + WS_CTL) + CW_CNT; int* list = (int*)(F.ws + WS_LIST); float* ql = (float*)(F.ws + WS_QL); unsigned* route = (unsigned*)(F.ws + WS_ROUTE);
        int gs = 0; for (int j = 1; j < 4; ++j) if (lg[j] > lg[gs]) gs = j;
        float den = 0.f; for (int j = 0; j < 4; ++j) den += expf(lg[j] - lg[gs]);
        const float pg = 1.0f / den;
        const LAS float* le = lg + 4 + 8 * gs; int i0 = 0; for (int j = 1; j < 8; ++j) if (le[j] > le[i0]) i0 = j;
        int i1 = (i0 == 0) ? 1 : 0; for (int j = 0; j < 8; ++j) if (j != i0 && le[j] > le[i1]) i1 = j;
        const float ex = expf(le[i1] - le[i0]); const float q0 = pg / (1.0f + ex), q1 = pg * ex / (1.0f + ex);
        const int e0 = gs * 8 + i0, e1 = gs * 8 + i1;
        const unsigned p0 = atomicAdd(&cnt[e0], 1u), p1 = atomicAdd(&cnt[e1], 1u);
        list[e0 * 8192 + p0] = m; ql[e0 * 8192 + p0] = q0; list[e1 * 8192 + p1] = m; ql[e1 * 8192 + p1] = q1;
        unsigned* r = route + (size_t)m * 8; r[0] = e0; r[1] = e1; r[2] = __float_as_uint(q0); r[3] = __float_as_uint(q1); r[4] = p0; r[5] = p1;
    }
    __syncthreads();
}

__device__ __forceinline__ const LAS int* moe_tables(Frame& F) {
    LAS int* tab = (LAS int*)(F.lds + MISC_OFF + 256);
    if (F.tid == 0) { unsigned* cnt = (unsigned*)(F.ws + WS_CTL) + CW_CNT; int run = 0;
        for (int e = 0; e < NEXP; ++e) { const int c = (int)__hip_atomic_load(cnt + e, RLX_AGENT); tab[e] = run; tab[40 + e] = run * 256; tab[80 + e] = c; run += (c + 255) >> 8; }
        tab[32] = run; }
    LDS_WAIT(); __syncthreads();
    return tab;
}
struct MoeOrder {
    const LAS int* tab; const char* A; const char* Bt; const int* list; int npn, G, c; bool up;
    __device__ bool next(int i, pg8::Unit& u) const {
        const int L = i * G + c; if (L >= tab[32] * npn) return false;
        const int tt = L / npn, pn = L % npn; int e = 0; while (tab[e + 1] <= tt) ++e;
        const int mt = tt - tab[e];
        u.e = e; u.mt = mt; u.pn = pn; u.pm = (tab[40 + e] >> 8) + mt;
        if (up) { u.a = A; u.b = Bt + ((size_t)(e * 1024 + pn * 256)) * D * 2; }
        else { u.a = A + (size_t)(tab[40 + e] + mt * 256) * FF * 2; u.b = Bt + ((size_t)(e * D + pn * 256)) * FF * 2; }
        return true;
    }
    __device__ __forceinline__ void gather(const pg8::Unit& u, const int (&stR)[2], const int (&stC)[2], unsigned (&voff)[2][2]) const {
        const int cnt = tab[80 + u.e];
#pragma unroll
        for (int h = 0; h < 2; ++h)
#pragma unroll
            for (int i = 0; i < 2; ++i) { int pos = u.mt * 256 + h * 128 + stR[i]; if (pos >= cnt) pos = 0;
                const int tok = list[u.e * 8192 + pos]; voff[h][i] = (unsigned)(tok * D + stC[i]) * 2u; }
    }
};
struct EpiH {
    static constexpr bool PERM = true;
    bf16_t* HH; const float* ql; const LAS int* tab;
    __device__ __forceinline__ void operator()(const f32x4 (&acc)[2][2][4][2], const pg8::Unit& u, int wr, int wc, int fr, int fq) const {
        const int cnt = tab[80 + u.e];
#pragma unroll
        for (int ai = 0; ai < 2; ++ai)
#pragma unroll
            for (int m = 0; m < 4; ++m) { const int rl = ai * 128 + wr * 64 + m * 16 + fr, lr = u.mt * 256 + rl;
                const float q = lr < cnt ? ql[u.e * 8192 + lr] : 0.f;
                f32x4 v0 = acc[ai][0][m][0], v1 = acc[ai][0][m][1]; const f32x4 u0 = acc[ai][1][m][0], u1 = acc[ai][1][m][1];
#pragma unroll
                for (int j = 0; j < 4; ++j) { v0[j] = silu_(v0[j]) * u0[j] * q; v1[j] = silu_(v1[j]) * u1[j] * q; }
                u32x4 w; w.x = pg8::cvt_pk_bf16(v0[0], v0[1]); w.y = pg8::cvt_pk_bf16(v0[2], v0[3]); w.z = pg8::cvt_pk_bf16(v1[0], v1[1]); w.w = pg8::cvt_pk_bf16(v1[2], v1[3]);
                *(u32x4*)(HH + (size_t)(u.pm * 256 + rl) * FF + 128 * u.pn + wc * 32 + 8 * fq) = w; }
    }
};
struct EpiYf {
    static constexpr bool PERM = true;
    bf16_t* YF;
    __device__ __forceinline__ void operator()(const f32x4 (&acc)[2][2][4][2], const pg8::Unit& u, int wr, int wc, int fr, int fq) const {
#pragma unroll
        for (int ai = 0; ai < 2; ++ai)
#pragma unroll
            for (int m = 0; m < 4; ++m) { bf16_t* rowp = YF + (size_t)(u.pm * 256 + ai * 128 + wr * 64 + m * 16 + fr) * D + u.pn * 256 + wc * 32 + 8 * fq;
#pragma unroll
                for (int bj = 0; bj < 2; ++bj) { const f32x4 v0 = acc[ai][bj][m][0], v1 = acc[ai][bj][m][1];
                    u32x4 w; w.x = pg8::cvt_pk_bf16(v0[0], v0[1]); w.y = pg8::cvt_pk_bf16(v0[2], v0[3]); w.z = pg8::cvt_pk_bf16(v1[0], v1[1]); w.w = pg8::cvt_pk_bf16(v1[2], v1[3]);
                    *(u32x4*)(rowp + bj * 128) = w; } }
    }
};

__device__ __forceinline__ void final_phase(Frame& F, const LAS int* tab) {
    const int gw = F.vcu * NWAVES + F.wave, NGW = F.G * NWAVES, lane = F.lane;
    const float* Y1 = (const float*)(F.ws + WS_Y1); const float* stat1 = (const float*)(F.ws + WS_STAT1); const unsigned* route = (const unsigned*)(F.ws + WS_ROUTE);
    const bf16_t* YF = (const bf16_t*)(F.ws + WS_YF); const float* g1 = F.in[16]; const float* b1 = F.in[17]; const float* g2 = F.in[25]; const float* b2 = F.in[26];
    for (int m = gw; m < M; m += NGW) {
        const unsigned* r = route + (size_t)m * 8;
        const int s0 = tab[40 + (int)r[0]] + (int)r[4], s1 = tab[40 + (int)r[1]] + (int)r[5];
        const float mean1 = stat1[2 * m], rstd1 = stat1[2 * m + 1];
        const f32x4* yr = (const f32x4*)(Y1 + (size_t)m * D) + lane;
        const u32x2* f0 = (const u32x2*)(YF + (size_t)s0 * D) + lane; const u32x2* f1 = (const u32x2*)(YF + (size_t)s1 * D) + lane;
        f32x4 v[8]; float s = 0.f;
#pragma unroll
        for (int j = 0; j < 8; ++j) { const f32x4 y = yr[64 * j], g4 = ((const f32x4*)g1)[lane + 64 * j], b4 = ((const f32x4*)b1)[lane + 64 * j];
            const u32x2 a = f0[64 * j], c = f1[64 * j];
            const f32x4 ff = (f32x4){bflo(a.x) + bflo(c.x), bfhi(a.x) + bfhi(c.x), bflo(a.y) + bflo(c.y), bfhi(a.y) + bfhi(c.y)};
            v[j] = (((y - mean1) * rstd1) * g4 + b4) * ALPHA + ff; s += (v[j].x + v[j].y) + (v[j].z + v[j].w); }
        const float mean = wave_sum(s) * (1.f / D); float s2 = 0.f;
#pragma unroll
        for (int j = 0; j < 8; ++j) { v[j] = v[j] - mean; s2 += (v[j].x * v[j].x + v[j].y * v[j].y) + (v[j].z * v[j].z + v[j].w * v[j].w); }
        const float rstd = 1.f / sqrtf(wave_sum(s2) * (1.f / D) + LN_EPS);
        f32x4* o = (f32x4*)(F.out + (size_t)m * D) + lane;
#pragma unroll
        for (int j = 0; j < 8; ++j) { const f32x4 g4 = ((const f32x4*)g2)[lane + 64 * j], b4 = ((const f32x4*)b2)[lane + 64 * j]; o[64 * j] = (v[j] * rstd) * g4 + b4; }
    }
}

#ifndef FAST_MASK
#define FAST_MASK 0xFF
#endif
#ifndef HOST_REP
#define HOST_REP -1
#endif
#ifndef REP_SUB
#define REP_SUB 1
#endif
#ifndef EXP_IN_P1
#define EXP_IN_P1 1
#endif
#ifndef ONE_LAUNCH
#define ONE_LAUNCH 1
#endif
constexpr int NPHASE = 8;
__global__ void __launch_bounds__(NWAVES * 64, 2) mk(Args args) {
    extern __shared__ __attribute__((aligned(16))) unsigned char lds_raw[];
    Frame F;
    F.lds = (LAS unsigned char*)lds_raw; F.MISC = (volatile LAS unsigned*)(F.lds + MISC_OFF);
    F.tid = threadIdx.x; F.lane = F.tid & 63; F.wave = __builtin_amdgcn_readfirstlane(F.tid >> 6);
    F.G = gridDim.x; { const int bx = blockIdx.x; F.vcu = (F.G % 8 == 0) ? (bx % 8) * (F.G / 8) + bx / 8 : bx; }
    F.in = args.in; F.out = args.out; F.ws = args.ws;
    unsigned char* ws = args.ws;
    const int lo = args.ph_lo, hi = args.ph_hi;
    for (int u = F.tid; u < 64; u += NWAVES * 64) F.MISC[u] = 0u;
    __syncthreads();
    XcdBarrier bar; bar.bar = (unsigned*)(ws + WS_CTL) + CW_BAR + lo * XCD_BAR_WORDS; bar.x = 0; bar.st = nullptr;
    if (hi - lo > 1) bar = xcd_barrier_post((unsigned*)(ws + WS_CTL) + CW_BAR + lo * XCD_BAR_WORDS, F.MISC + 8);
#ifndef PH_EN
#define PH_EN 0xFF
#endif
#define IN(k) (((PH_EN >> (k)) & 1) && lo <= (k) && (k) < hi)
#define SEAM(k) do { if (IN(k) && IN((k) + 1)) xcd_barrier(bar); } while (0)

#ifndef REP_PHASE
#define REP_PHASE -1
#endif
#define REPS(k) for (int rep_ = 0; rep_ < ((REP_PHASE == (k)) ? 2 : 1); ++rep_)
#define REP_BAR(k) do { if (REP_PHASE == (k) && rep_ == 0 && hi - lo > 1) xcd_barrier(bar); } while (0)
    if (IN(0)) { REPS(0) { p0_prologue(F); if (!EXP_IN_P1) p0_experts(F); REP_BAR(0); } SEAM(0); }
    if (IN(1)) {
        REPS(1) {
        if (EXP_IN_P1 && (F.vcu & 1)) p0_experts(F);
        pg8::DenseOrder S; S.init(ws + WS_H0, ws + WS_BT1, M, 4096, D, F.G, (int)blockIdx.x);
        EpiZ E{(bf16_t*)(ws + WS_ZP)};
        pg8::gemm_phase<EpiZ, pg8::DenseOrder, false, MK_ALIGN, MK_SP2>(F.lds, D, S, E);
        if (EXP_IN_P1 && !(F.vcu & 1)) p0_experts(F);
        REP_BAR(1); }
        SEAM(1);
    }
    if (IN(2)) {
        REPS(2) {
        if (args.rep != 2) for (int u = F.vcu; u < 256; u += F.G) lru_unit(F, u);
        if (args.rep != 1) for (int u = F.vcu; u < 256; u += F.G) conv31_unit(F, u);
        REP_BAR(2); }
        SEAM(2);
    }
    if (IN(3)) {
        REPS(3) {
        pg8::DenseOrder S; S.init(ws + WS_MIX, ws + WS_BT2, M, D, D, F.G, (int)blockIdx.x);
        EpiY1 E{(float*)(ws + WS_Y1), F.in[0], (const float*)(ws + WS_STAT0), F.in[1], F.in[2]};
        pg8::gemm_phase<EpiY1, pg8::DenseOrder, false, MK_ALIGN, MK_SP2>(F.lds, D, S, E);
        REP_BAR(3); }
        SEAM(3);
    }
    if (IN(4)) {
        REPS(4) {
        for (int u = F.vcu; u < 256; u += F.G) router_unit(F, u, args.rep == 0);
        REP_BAR(4); }
        SEAM(4);
    }
    if (IN(5)) {
        REPS(5) {
        const LAS int* tab = moe_tables(F);
        MoeOrder S{tab, (const char*)(ws + WS_H1), (const char*)(ws + WS_BTU), (const int*)(ws + WS_LIST), 4, F.G, F.vcu, true};
        EpiH E{(bf16_t*)(ws + WS_HH), (const float*)(ws + WS_QL), tab};
        pg8::gemm_phase<EpiH, MoeOrder, true, MK_ALIGN, MK_SP2>(F.lds, D, S, E);
        REP_BAR(5); }
        SEAM(5);
    }
    if (IN(6)) {
        REPS(6) {
        const LAS int* tab = moe_tables(F);
        MoeOrder S{tab, (const char*)(ws + WS_HH), (const char*)(ws + WS_BTD), (const int*)(ws + WS_LIST), 8, F.G, F.vcu, false};
        EpiYf E{(bf16_t*)(ws + WS_YF)};
        pg8::gemm_phase<EpiYf, MoeOrder, false, MK_ALIGN, MK_SP2>(F.lds, FF, S, E);
        REP_BAR(6); }
        SEAM(6);
    }
    if (IN(7)) {
        REPS(7) {
        const LAS int* tab = moe_tables(F);
        final_phase(F, tab);
        REP_BAR(7); }
    }
#undef IN
#undef SEAM
}

extern "C" void kernel_launch(void* const* d_in, const int* in_sizes, int n_in, void* d_out, int out_size, void* d_ws, size_t ws_size, hipStream_t stream) {
    static int grid = 0;
    if (grid == 0) {
        if (n_in != 27 || in_sizes[0] != M * D || out_size != M * D || ws_size < WS_NEED) {
            fprintf(stderr, "kernel_launch: unexpected shapes (n_in %d, in0 %d, out %d, ws %zu); nothing launched\n", n_in, n_in > 0 ? in_sizes[0] : -1, out_size, ws_size); grid = -1; return; }
        int dev = 0, cus = 0, per_cu = 0;
        if (hipGetDevice(&dev) != hipSuccess || hipDeviceGetAttribute(&cus, hipDeviceAttributeMultiprocessorCount, dev) != hipSuccess) { grid = -1; return; }
        if (hipFuncSetAttribute((const void*)mk, hipFuncAttributeMaxDynamicSharedMemorySize, LDS_BYTES) != hipSuccess) { fprintf(stderr, "kernel_launch: hipFuncSetAttribute failed\n"); grid = -1; return; }
        if (hipOccupancyMaxActiveBlocksPerMultiprocessor(&per_cu, (const void*)mk, NWAVES * 64, LDS_BYTES) != hipSuccess || per_cu < 1) { fprintf(stderr, "kernel_launch: occupancy query says %d blocks per CU\n", per_cu); (void)hipGetLastError(); grid = -1; return; }
        grid = cus;
    }
    if (grid < 0) return;
    const float* const* in = (const float* const*)d_in;
    unsigned char* ws = (unsigned char*)d_ws;
    (void)hipMemsetAsync(ws + WS_CTL, 0, CTL_ZERO_BYTES, stream);
    float* stat0 = (float*)(ws + WS_STAT0); float* stat1 = (float*)(ws + WS_STAT1); unsigned* route = (unsigned*)(ws + WS_ROUTE);
    int* list = (int*)(ws + WS_LIST); float* ql = (float*)(ws + WS_QL); unsigned* cnt = (unsigned*)(ws + WS_CTL) + CW_CNT;
    bf16_t* H0 = (bf16_t*)(ws + WS_H0); bf16_t* ZP = (bf16_t*)(ws + WS_ZP); bf16_t* MIX = (bf16_t*)(ws + WS_MIX); float* Y1 = (float*)(ws + WS_Y1);
    bf16_t* H1 = (bf16_t*)(ws + WS_H1); bf16_t* HH = (bf16_t*)(ws + WS_HH); bf16_t* YF = (bf16_t*)(ws + WS_YF);
    float* ZRAW = (float*)(ws + WS_ZRAW); float* AIN = (float*)(ws + WS_AIN); float* ADEC = (float*)(ws + WS_ADEC); float* U = (float*)(ws + WS_U);
    Args a{};
    for (int i = 0; i < 27; ++i) a.in[i] = in[i];
    a.out = (float*)d_out; a.ws = ws;
    for (int p = 0; p < NPHASE;) {
        if ((FAST_MASK >> p) & 1) {
            int q = p + 1;
            if (ONE_LAUNCH) while (q < NPHASE && ((FAST_MASK >> q) & 1) && q != HOST_REP && (q - 1) != HOST_REP) ++q;
            a.ph_lo = p; a.ph_hi = q;
            hipLaunchKernelGGL(mk, dim3(grid), dim3(NWAVES * 64), LDS_BYTES, stream, a);
            if (p == HOST_REP) { a.rep = REP_SUB; hipLaunchKernelGGL(mk, dim3(grid), dim3(NWAVES * 64), LDS_BYTES, stream, a); a.rep = 0; }
            p = q; continue;
        }
        switch (p) {
        case 0:
            nv_ln_in<<<M, 256, 0, stream>>>(in[0], in[1], in[2], H0, stat0);
            break;
        case 1:
            nv_gemm<<<dim3(4096 / 64, M / 64), 256, 0, stream>>>(H0, in[3], ZRAW, M, 4096, D);
            nv_zprime<<<(unsigned)(((size_t)M * NZ + 255) / 256), 256, 0, stream>>>(ZRAW, ZP);
            break;
        case 2:
            nv_lru1<<<(M * DL + 255) / 256, 256, 0, stream>>>(ZP, in[4], in[5], AIN);
            nv_lru2<<<(M * DL + 255) / 256, 256, 0, stream>>>(AIN, in[6], in[7], in[8], in[9], in[10], ADEC, U);
            nv_lru3<<<(2 * DL + 255) / 256, 256, 0, stream>>>(ADEC, U, ZP, MIX);
            nv_conv31<<<M, 256, 0, stream>>>(ZP, in[11], in[12], in[13], in[14], MIX);
            break;
        case 3:
            nv_gemm<<<dim3(D / 64, M / 64), 256, 0, stream>>>(MIX, in[15], Y1, M, D, D);
            nv_y1<<<(unsigned)(((size_t)M * D + 255) / 256), 256, 0, stream>>>(Y1, in[0], stat0, in[1], in[2]);
            break;
        case 4:
            nv_router<<<M, 256, 0, stream>>>(Y1, in[16], in[17], in[18], in[19], in[20], in[21], H1, stat1, route, cnt, list, ql);
            break;
        case 5:
            nv_moe_up<<<2 * M, 512, 0, stream>>>(H1, route, cnt, in[22], in[23], HH);
            break;
        case 6:
            nv_moe_down<<<2 * M, 512, 0, stream>>>(HH, route, cnt, in[24], YF);
            break;
        case 7:
            nv_final<<<M, 256, 0, stream>>>(Y1, stat1, in[16], in[17], route, cnt, YF, in[25], in[26], (float*)d_out);
            break;
        }
        ++p;
    }
}
```
